# Optimizing an MI355X kernel written in HIP

```python
import jax, jax.numpy as jnp
from jax import lax
import numpy as np

D_MODEL = 2048
BATCH = 8
SEQ = 2048
DEPTH = 2

D_MIX = D_MODEL
D_RNN = D_MIX // 2
D_RET = D_MIX - D_RNN
LRU_BLOCKS = 8
LRU_BLOCK = D_RNN // LRU_BLOCKS
CONV_WIDTH = 4
LRU_C = 8.0
RET_HEADS = 8
RET_DV = D_RET // RET_HEADS
RET_DK = RET_DV // 2
RET_CHUNK = 128
ROPE_BASE = 10000.0
D_FF = 256 * ((8 * D_MODEL // 3 + 255) // 256)
N_EXPERTS = 8
TOP_K = 2
N_DENSE = (DEPTH + 1) // 2
N_MOE = DEPTH // 2
EPS = 1e-6
IN_SIZES = (D_RNN, D_RNN, RET_HEADS * RET_DK, RET_HEADS * RET_DK, D_RET, D_RET)
D_IN = sum(IN_SIZES)
IN_OFFSETS = tuple(int(o) for o in np.cumsum(IN_SIZES)[:-1])

kernel_name = 'hymba_style_rglru_retention_moe_trunk'


def rmsnorm(x, g):
    xf = x.astype(jnp.float32)
    y = xf * lax.rsqrt(jnp.mean(xf * xf, axis=-1, keepdims=True) + EPS)
    return (y * g.astype(jnp.float32)).astype(x.dtype)


def causal_depthwise_conv(x, w, b):
    S = x.shape[1]
    xp = jnp.pad(x, ((0, 0), (CONV_WIDTH - 1, 0), (0, 0)))
    y = b
    for tap in range(CONV_WIDTH):
        y = y + xp[:, tap:tap + S] * w[tap]
    return y


def block_diag_linear(x, w, b):
    B, S, C = x.shape
    y = jnp.einsum('bsni,nij->bsnj', x.reshape(B, S, LRU_BLOCKS, LRU_BLOCK), w)
    return y.reshape(B, S, C) + b


def _linear_recurrence_op(left, right):
    a_l, b_l = left
    a_r, b_r = right
    return a_l * a_r, a_r * b_l + b_r


def rg_lru(x, wa, ba, wx, bx, lam):
    f32 = jnp.float32
    xf = x.astype(f32)
    r = jax.nn.sigmoid(block_diag_linear(xf, wa.astype(f32), ba.astype(f32)))
    i = jax.nn.sigmoid(block_diag_linear(xf, wx.astype(f32), bx.astype(f32)))
    log_a = -LRU_C * r * jax.nn.softplus(-lam.astype(f32))
    a = jnp.exp(log_a)
    mult = jnp.sqrt(-jnp.expm1(2.0 * log_a))
    is_start = (jnp.arange(x.shape[1]) == 0)[None, :, None]
    mult = jnp.where(is_start, 1.0, mult)
    _, h = lax.associative_scan(_linear_recurrence_op, (a, mult * i * xf), axis=1)
    return h


def apply_rope(x, cos, sin):
    x1, x2 = jnp.split(x, 2, axis=-1)
    return jnp.concatenate([x1 * cos - x2 * sin, x1 * sin + x2 * cos], axis=-1)


def chunkwise_retention(q, k, v):
    B, S, H, DK = q.shape
    DV = v.shape[-1]
    C = RET_CHUNK
    N = S // C
    f32 = jnp.float32
    log_g = jnp.log(1.0 - 2.0 ** (-5.0 - jnp.arange(H, dtype=f32)))
    idx = jnp.arange(C, dtype=f32)
    rel = idx[:, None] - idx[None, :]
    decay = jnp.where(rel >= 0, jnp.exp(jnp.maximum(rel, 0.0)[None] * log_g[:, None, None]), 0.0)
    qc = q.reshape(B, N, C, H, DK)
    kc = k.reshape(B, N, C, H, DK)
    vc = v.reshape(B, N, C, H, DV)
    scores = jnp.einsum('bnihd,bnjhd->bnhij', qc, kc) * decay
    inner = jnp.einsum('bnhij,bnjhe->bnihe', scores, vc)
    zeta = jnp.exp((C - 1.0 - idx)[None, :] * log_g[:, None])
    kv = jnp.einsum('bnjhd,hj,bnjhe->nbhde', kc, zeta, vc)
    chunk_decay = jnp.exp(C * log_g)[None, :, None, None]

    def step(state, kv_n):
        return chunk_decay * state + kv_n, state

    _, prev = lax.scan(step, jnp.zeros((B, H, DK, DV), f32), kv)
    xi = jnp.exp((idx + 1.0)[None, :] * log_g[:, None])
    cross = jnp.einsum('bnihd,hi,nbhde->bnihe', qc, xi, prev)
    return (inner + cross).reshape(B, S, H, DV)


def head_groupnorm(o, g):
    B, S, H, DV = o.shape
    mu = jnp.mean(o, axis=-1, keepdims=True)
    var = jnp.mean(jnp.square(o - mu), axis=-1, keepdims=True)
    y = ((o - mu) * lax.rsqrt(var + EPS)).reshape(B, S, H * DV)
    return y * g.astype(jnp.float32)


def hybrid_mixer(h, w_in, conv_w, conv_b, lru_wa, lru_ba, lru_wx, lru_bx, lru_lambda,
                 lru_norm_g, ret_norm_g, w_out, cos, sin):
    B, S, _ = h.shape
    f32 = jnp.float32
    proj = h @ w_in
    x_rnn, gate_rnn, q, k, v, g = jnp.split(proj, IN_OFFSETS, axis=-1)
    xc = causal_depthwise_conv(x_rnn, conv_w, conv_b)
    h_lru = rg_lru(xc, lru_wa, lru_ba, lru_wx, lru_bx, lru_lambda)
    y_lru = rmsnorm(h_lru, lru_norm_g) * jax.nn.gelu(gate_rnn.astype(f32))
    qf = apply_rope(q.astype(f32).reshape(B, S, RET_HEADS, RET_DK), cos, sin)
    kf = apply_rope(k.astype(f32).reshape(B, S, RET_HEADS, RET_DK), cos, sin) * (RET_DK ** -0.5)
    vf = v.astype(f32).reshape(B, S, RET_HEADS, RET_DV)
    o = chunkwise_retention(qf, kf, vf)
    y_ret = head_groupnorm(o, ret_norm_g) * jax.nn.silu(g.astype(f32))
    y = jnp.concatenate([y_lru, y_ret], axis=-1).astype(h.dtype)
    return y @ w_out


def swiglu(h, w_gate, w_up, w_down):
    return (jax.nn.silu(h @ w_gate) * (h @ w_up)) @ w_down


def moe_swiglu(h, router, w_gate, w_up, w_down):
    shape = h.shape
    hf = h.reshape(-1, shape[-1])
    logits = (hf @ router).astype(jnp.float32)
    top_vals, top_idx = lax.top_k(logits, TOP_K)
    gates = jax.nn.softmax(top_vals, axis=-1)
    combine = jnp.einsum('tk,tke->te', gates, jax.nn.one_hot(top_idx, N_EXPERTS, dtype=jnp.float32))
    y = jnp.zeros(hf.shape, jnp.float32)
    for e in range(N_EXPERTS):
        y = y + combine[:, e:e + 1] * swiglu(hf, w_gate[e], w_up[e], w_down[e]).astype(jnp.float32)
    return y.reshape(shape).astype(h.dtype)


def setup_inputs(seed: int = 0) -> dict:
    key = jax.random.key(seed)
    ks = jax.random.split(key, 22)
    f32 = jnp.float32

    def nrm(k, shape, scale):
        return jax.random.normal(k, shape, f32) * scale

    a_c = jax.random.uniform(ks[9], (DEPTH, D_RNN), f32, 0.9, 0.999)
    s = a_c ** (1.0 / LRU_C)
    return {
        'x': nrm(ks[0], (BATCH, SEQ, D_MODEL), 1.0),
        'norm1_g': 1.0 + nrm(ks[1], (DEPTH, D_MODEL), 0.02),
        'w_in': nrm(ks[2], (DEPTH, D_MODEL, D_IN), D_MODEL ** -0.5),
        'conv_w': nrm(ks[3], (DEPTH, CONV_WIDTH, D_RNN), CONV_WIDTH ** -0.5),
        'conv_b': nrm(ks[4], (DEPTH, D_RNN), 0.01),
        'lru_wa': nrm(ks[5], (DEPTH, LRU_BLOCKS, LRU_BLOCK, LRU_BLOCK), LRU_BLOCK ** -0.5),
        'lru_ba': nrm(ks[6], (DEPTH, D_RNN), 0.01),
        'lru_wx': nrm(ks[7], (DEPTH, LRU_BLOCKS, LRU_BLOCK, LRU_BLOCK), LRU_BLOCK ** -0.5),
        'lru_bx': nrm(ks[8], (DEPTH, D_RNN), 0.01),
        'lru_lambda': jnp.log(s) - jnp.log1p(-s),
        'lru_norm_g': 1.0 + nrm(ks[10], (DEPTH, D_RNN), 0.02),
        'ret_norm_g': 1.0 + nrm(ks[11], (DEPTH, D_RET), 0.02),
        'w_out': nrm(ks[12], (DEPTH, D_MIX, D_MODEL), D_MIX ** -0.5),
        'norm2_g': 1.0 + nrm(ks[13], (DEPTH, D_MODEL), 0.02),
        'ffn_w_gate': nrm(ks[14], (N_DENSE, D_MODEL, D_FF), D_MODEL ** -0.5),
        'ffn_w_up': nrm(ks[15], (N_DENSE, D_MODEL, D_FF), D_MODEL ** -0.5),
        'ffn_w_down': nrm(ks[16], (N_DENSE, D_FF, D_MODEL), D_FF ** -0.5),
        'moe_router': nrm(ks[17], (N_MOE, D_MODEL, N_EXPERTS), D_MODEL ** -0.5),
        'moe_w_gate': nrm(ks[18], (N_MOE, N_EXPERTS, D_MODEL, D_FF), D_MODEL ** -0.5),
        'moe_w_up': nrm(ks[19], (N_MOE, N_EXPERTS, D_MODEL, D_FF), D_MODEL ** -0.5),
        'moe_w_down': nrm(ks[20], (N_MOE, N_EXPERTS, D_FF, D_MODEL), D_FF ** -0.5),
        'final_norm_g': 1.0 + nrm(ks[21], (D_MODEL,), 0.02),
    }


def reference(x, norm1_g, w_in, conv_w, conv_b, lru_wa, lru_ba, lru_wx, lru_bx, lru_lambda,
              lru_norm_g, ret_norm_g, w_out, norm2_g, ffn_w_gate, ffn_w_up, ffn_w_down,
              moe_router, moe_w_gate, moe_w_up, moe_w_down, final_norm_g):
    f32 = jnp.float32
    S = x.shape[1]
    inv_freq = ROPE_BASE ** (-jnp.arange(0, RET_DK, 2, dtype=f32) / RET_DK)
    ang = jnp.arange(S, dtype=f32)[:, None] * inv_freq[None, :]
    cos = jnp.cos(ang)[:, None, :]
    sin = jnp.sin(ang)[:, None, :]
    for layer in range(DEPTH):
        h = rmsnorm(x, norm1_g[layer])
        x = x + hybrid_mixer(h, w_in[layer], conv_w[layer], conv_b[layer], lru_wa[layer],
                             lru_ba[layer], lru_wx[layer], lru_bx[layer], lru_lambda[layer],
                             lru_norm_g[layer], ret_norm_g[layer], w_out[layer], cos, sin)
        h = rmsnorm(x, norm2_g[layer])
        j = layer // 2
        if layer % 2 == 0:
            x = x + swiglu(h, ffn_w_gate[j], ffn_w_up[j], ffn_w_down[j])
        else:
            x = x + moe_swiglu(h, moe_router[j], moe_w_gate[j], moe_w_up[j], moe_w_down[j])
    return rmsnorm(x, final_norm_g)
```

```cpp
#include <hip/hip_runtime.h>
#include <cstdio>
#include <cstdint>

#ifndef MK_ONE_LAUNCH
#define MK_ONE_LAUNCH 1
#endif

#ifndef REP_P0
#define REP_P0 1
#endif
#ifndef REP_NORM
#define REP_NORM 1
#endif
#ifndef REP_GIN
#define REP_GIN 1
#endif
#ifndef REP_MIX
#define REP_MIX 1
#endif
#ifndef REP_YLRU
#define REP_YLRU 1
#endif
#ifndef REP_GATHER
#define REP_GATHER 1
#endif
#ifndef REP_GGU
#define REP_GGU 1
#endif
#ifndef REP_RET
#define REP_RET 1
#endif
#ifndef REP_LRU
#define REP_LRU 1
#endif
#define REPEAT(n) for (int rep_ = 0; rep_ < (n); ++rep_)
#ifndef GIN0_NC
#define GIN0_NC 20
#endif
#define LAS __attribute__((address_space(3)))
#define GAS __attribute__((address_space(1)))
typedef unsigned short bf16;
typedef short bf16x8 __attribute__((ext_vector_type(8)));
typedef float f32x4 __attribute__((ext_vector_type(4)));
typedef float f32x2 __attribute__((ext_vector_type(2)));
typedef unsigned u32x4 __attribute__((ext_vector_type(4)));
typedef unsigned u32x2 __attribute__((ext_vector_type(2)));

constexpr int BATCH = 8, SEQ = 2048, T = BATCH * SEQ, D = 2048, D_IN = 5120, D_RNN = 1024, NH = 8, DK = 64, DV = 128, D_FF = 5632, NE = 8;
constexpr int OFF_GATE = 1024, OFF_Q = 2048, OFF_K = 2560, OFF_V = 3072, OFF_G = 4096;
constexpr float EPS = 1e-6f;
constexpr int MAXMT = 136;
constexpr int MPAD = MAXMT * 256;

constexpr size_t MiB = 1u << 20;
constexpr size_t WS_CTL = 0, CTL_ZERO_BYTES = 1 * MiB;
constexpr size_t WS_ROPE = 1 * MiB;
constexpr size_t WS_WLRU = 2 * MiB;
constexpr size_t WS_SSP = 3 * MiB;
constexpr size_t WS_ROUTE = 4 * MiB;
constexpr size_t RT_TOPE = 0, RT_TOPG = 65536, RT_TOPR = 65536 * 3, RT_SLOT = 65536 * 5, RT_CNTB = 65536 * 7;
constexpr size_t WS_SA = 5 * MiB;
constexpr size_t WS_SW = 6 * MiB;
constexpr size_t WS_WIN = 8 * MiB;
constexpr size_t WS_WOUT = 48 * MiB;
constexpr size_t WS_WGU_D = 64 * MiB;
constexpr size_t WS_WDN_D = 108 * MiB;
constexpr size_t WS_WGU_M = 130 * MiB;
constexpr size_t WS_WDN_M = 482 * MiB;
constexpr size_t WS_H = 658 * MiB;
constexpr size_t WS_PROJ = 722 * MiB;
constexpr size_t WS_HID = 882 * MiB;
constexpr size_t WS_END = 1256 * MiB;
static_assert(WS_WIN + (size_t)2 * D_IN * D * 2 <= WS_WOUT && WS_WOUT + (size_t)2 * D * D * 2 <= WS_WGU_D && WS_WGU_D + (size_t)2 * D_FF * D * 2 <= WS_WDN_D &&
              WS_WDN_D + (size_t)D * D_FF * 2 <= WS_WGU_M && WS_WGU_M + (size_t)NE * 2 * D_FF * D * 2 <= WS_WDN_M && WS_WDN_M + (size_t)NE * D * D_FF * 2 <= WS_H &&
              WS_H + (size_t)T * D * 2 <= WS_PROJ && WS_PROJ + (size_t)T * D_IN * 2 <= WS_HID && WS_PROJ + (size_t)MPAD * D * 2 <= WS_HID && WS_HID + (size_t)MPAD * D_FF * 2 <= WS_END, "d_ws map");
constexpr int CW_TMO = 0;
constexpr int CW_BAR = 4096;

constexpr int RING_BYTES = 131072;
constexpr int LDSCTL_OFF = 140 * 1024;
constexpr int LDS_BYTES = 147456;
constexpr int LC_BAR = 0, LC_TB = 16, LC_PRE = 32, LC_TOT = 40, LC_NMT = 48, LC_TEXP = 64, LC_SPLIT = 256;

#define RLX_AGENT __ATOMIC_RELAXED, __HIP_MEMORY_SCOPE_AGENT
__device__ __forceinline__ unsigned f2bf(float f) { unsigned u = __builtin_bit_cast(unsigned, f); return (u + 0x7fffu + ((u >> 16) & 1u)) >> 16; }
__device__ __forceinline__ unsigned pk2(float lo, float hi) { return f2bf(lo) | (f2bf(hi) << 16); }
__device__ __forceinline__ float bflo(unsigned w) { return __builtin_bit_cast(float, w << 16); }
__device__ __forceinline__ float bfhi(unsigned w) { return __builtin_bit_cast(float, w & 0xffff0000u); }
__device__ __forceinline__ float shfl_idx(float v, int src) { return __builtin_bit_cast(float, __builtin_amdgcn_ds_bpermute(src << 2, __builtin_bit_cast(int, v))); }
__device__ __forceinline__ float shfl_x(float v, int o, int lane) { return shfl_idx(v, lane ^ o); }
__device__ __forceinline__ unsigned shfl_u(unsigned v, int src) { return (unsigned)__builtin_amdgcn_ds_bpermute(src << 2, (int)v); }
__device__ __forceinline__ float wave_sum(float v, int lane) {
#pragma unroll
    for (int o = 1; o < 64; o <<= 1) v += shfl_x(v, o, lane);
    return v;
}
__device__ __forceinline__ float sigmoidf_(float x) { return __builtin_amdgcn_rcpf(1.0f + __expf(-x)); }
__device__ __forceinline__ int tile_off(int r, int c, int kc32) { const int ob = (r & 15) * 64 + (c & 31) * 2; return ((r >> 4) * kc32 + (c >> 5)) * 1024 + (ob ^ (((ob >> 9) & 1) << 5)); }
__device__ __forceinline__ bf16x8 lds_frag(LAS unsigned char* base, int off) { return *(const LAS bf16x8*)(base + off); }
#define MFMA16(a, b, c) __builtin_amdgcn_mfma_f32_16x16x32_bf16((a), (b), (c), 0, 0, 0)

namespace pg8 {
constexpr int BM = 256, BK = 64, HALF = 128, HTB = HALF * BK * 2, STAGE_BYTES = 8 * HTB, NXCD = 8, WGM = 8;
__host__ __device__ __forceinline__ int lds_byte(int r, int c) { const int st = (r >> 4) * 2 + (c >> 5), rr = r & 15, cc = c & 31, ob = rr * 64 + cc * 2; return st * 1024 + (ob ^ (((ob >> 9) & 1) << 5)); }
__host__ __device__ __forceinline__ void stage_rc(int b, int& R, int& C) { const int st = b / 1024, sb = b % 1024, swz = sb ^ (((sb >> 9) & 1) << 5); R = (st >> 1) * 16 + swz / 64; C = (st & 1) * 32 + (swz % 64) / 2; }
__host__ __device__ __forceinline__ int perm32(int rho) { const int n = rho >> 4, i = rho & 15; return 8 * (i >> 2) + 4 * n + (i & 3); }

struct Unit { int pm, pn, pb, kh; };
struct Gemm { const void* A; const void* Bt; int Kb; };

struct GroupOrder {
    int nM, nN, nwg, G, c; const LAS int* texp;
    __device__ void init(int nM_, int nN_, int G_, int c_, const LAS int* texp_) { nM = nM_; nN = nN_; nwg = nM * nN; G = G_; c = c_; texp = texp_; }
    __device__ bool next(int i, Unit& u) const { return unit_at((long)i * G + c, u); }
    __device__ bool unit_at(long L, Unit& u) const {
        if (L >= nwg) return false;
        int wgid = (int)L; { const int q = nwg / NXCD, r = nwg % NXCD, xcd = wgid % NXCD, off = wgid / NXCD; wgid = (xcd < r ? xcd * (q + 1) : r * (q + 1) + (xcd - r) * q) + off; }
        const int nig = WGM * nN, gid = wgid / nig, fm = gid * WGM, gsz = (nM - fm) < WGM ? (nM - fm) : WGM;
        u.pm = fm + ((wgid % nig) % gsz); u.pn = (wgid % nig) / gsz;
        u.pb = (texp ? __builtin_amdgcn_readfirstlane(texp[u.pm]) : 0) * nN + u.pn; return true;
    }
    struct Pre {};
    __device__ __forceinline__ void a_issue(const Unit&, Pre&) const {}
    __device__ __forceinline__ void a_finish(const Unit&, int, const Pre&) const {}
    __device__ __forceinline__ void done(const Unit&) const {}
};
struct SplitOrder : GroupOrder {
    int R, rem;
    __device__ void init2() { R = nwg / G; rem = nwg - R * G; if (2 * rem > G) rem = 0; }
    __device__ bool next(int i, Unit& u) const {
        if (rem == 0 || i < R) { const bool ok = GroupOrder::next(i, u); u.kh = 0; return ok; }
        if (i > R || c >= 2 * rem) return false;
        const bool ok = unit_at((long)R * G + (c >> 1), u); u.kh = ((c >> 1) << 2) | (1 + (c & 1)); return ok;
    }
};
constexpr int RS_OFF = 131072;
struct RowScaleOrder : GroupOrder {
    const float* ssp; LAS float* rs; int tid;
    struct Pre { f32x4 a, b; };
    __device__ __forceinline__ void a_issue(const Unit& u, Pre& p) const {
        const int r = tid & 255, h = tid >> 8; const f32x4* q = (const f32x4*)(ssp + (size_t)(u.pm * BM + r) * 16 + h * 8);
        p.a = q[0]; p.b = q[1];
    }
    __device__ __forceinline__ void a_finish(const Unit&, int par, const Pre& p) const {
        const int r = tid & 255, h = tid >> 8; const f32x4 t4 = p.a + p.b;
        rs[(par * 2 + h) * 256 + r] = (t4[0] + t4[1]) + (t4[2] + t4[3]);
    }
};
__device__ __forceinline__ float rs_scale(const LAS float* rs, int par, int r, float inv) { return 1.0f / sqrtf((rs[(par * 2) * 256 + r] + rs[(par * 2 + 1) * 256 + r]) * inv + EPS); }

__device__ __forceinline__ unsigned cvt_pk_bf16(float lo, float hi) { unsigned r; asm volatile("v_cvt_pk_bf16_f32 %0, %1, %2" : "=v"(r) : "v"(lo), "v"(hi)); return r; }

template <bool INI8 = false, bool KS = false> struct EpiOut {
    static constexpr bool PERM = true;
    const float* base; float* C; bf16* O; int ldc; int mode; const float* SA; const float* SW;
    bf16* O2;
    __device__ __forceinline__ void operator()(const f32x4 (&acc)[2][2][4][2], const Unit& u, int wr, int wc, int fr, int fq) const {
        int row0 = u.pm * BM + wr * 64 + fr, col0 = u.pn * BM + wc * 32 + 8 * fq;
        if (mode == 1) {
            bf16* O = this->O; int ldc = this->ldc;
            if constexpr (KS) { if ((u.kh & 3) == 2) { O = O2 + (size_t)(u.kh >> 2) * (BM * BM); ldc = BM; row0 = wr * 64 + fr; col0 = wc * 32 + 8 * fq; } }
            float sw[2][8];
            if constexpr (INI8) {
#pragma unroll
                for (int bj = 0; bj < 2; ++bj)
#pragma unroll
                    for (int j = 0; j < 8; ++j) sw[bj][j] = SW[col0 + bj * HALF + j]; }
#pragma unroll
            for (int ai = 0; ai < 2; ++ai)
#pragma unroll
                for (int m = 0; m < 4; ++m) {
                    const size_t off = (size_t)(row0 + ai * HALF + m * 16) * ldc + col0;
                    float sa = 1.0f; if constexpr (INI8) sa = SA[row0 + ai * HALF + m * 16];
#pragma unroll
                    for (int bj = 0; bj < 2; ++bj) { float f[8];
#pragma unroll
                        for (int j = 0; j < 4; ++j) { const float a0 = acc[ai][bj][m][0][j], a1 = acc[ai][bj][m][1][j];
                            if constexpr (INI8) { f[j] = (float)__builtin_bit_cast(int, a0) * (sa * sw[bj][j]); f[4 + j] = (float)__builtin_bit_cast(int, a1) * (sa * sw[bj][4 + j]); }
                            else { f[j] = a0; f[4 + j] = a1; } }
                        u32x4 w; w.x = cvt_pk_bf16(f[0], f[1]); w.y = cvt_pk_bf16(f[2], f[3]); w.z = cvt_pk_bf16(f[4], f[5]); w.w = cvt_pk_bf16(f[6], f[7]);
                        *(u32x4*)(O + off + bj * HALF) = w; }
                }
        } else {
#pragma unroll
            for (int ai = 0; ai < 2; ++ai) {
                f32x4 bb[4][2][2];
#pragma unroll
                for (int m = 0; m < 4; ++m) { const size_t off = (size_t)(row0 + ai * HALF + m * 16) * ldc + col0;
#pragma unroll
                    for (int bj = 0; bj < 2; ++bj) { bb[m][bj][0] = *(const f32x4*)(base + off + bj * HALF); bb[m][bj][1] = *(const f32x4*)(base + off + bj * HALF + 4); } }
#pragma unroll
                for (int m = 0; m < 4; ++m) { const size_t off = (size_t)(row0 + ai * HALF + m * 16) * ldc + col0;
#pragma unroll
                    for (int bj = 0; bj < 2; ++bj) { *(f32x4*)(C + off + bj * HALF) = bb[m][bj][0] + acc[ai][bj][m][0]; *(f32x4*)(C + off + bj * HALF + 4) = bb[m][bj][1] + acc[ai][bj][m][1]; } }
                asm volatile("" ::: "memory");
            }
        }
    }
};
__device__ __forceinline__ float clamp448(float x) { return __builtin_amdgcn_fmed3f(x, -448.0f, 448.0f); }
__device__ __forceinline__ unsigned pk4_fp8(float a, float b, float c, float d) { unsigned w = 0; w = __builtin_amdgcn_cvt_pk_fp8_f32(clamp448(a), clamp448(b), w, false); w = __builtin_amdgcn_cvt_pk_fp8_f32(clamp448(c), clamp448(d), w, true); return w; }
template <bool OUT8, bool INI8 = false> struct EpiSwiglu {
    static constexpr bool PERM = true;
    void* O; int ldc; const float* SA; const float* SW;
    __device__ __forceinline__ void operator()(const f32x4 (&acc)[2][2][4][2], const Unit& u, int wr, int wc, int fr, int fq) const {
        const int row0 = u.pm * BM + wr * 64 + fr, col0 = u.pn * HALF + wc * 32 + 8 * fq;
        float swg[8], swu[8];
        if constexpr (INI8) {
#pragma unroll
            for (int j = 0; j < 8; ++j) { swg[j] = SW[col0 + j]; swu[j] = SW[ldc + col0 + j]; } }
#pragma unroll
        for (int ai = 0; ai < 2; ++ai)
#pragma unroll
            for (int m = 0; m < 4; ++m) {
                float h[8]; float sa = 1.0f; if constexpr (INI8) sa = SA[row0 + ai * HALF + m * 16];
#pragma unroll
                for (int n = 0; n < 2; ++n)
#pragma unroll
                    for (int j = 0; j < 4; ++j) { float g = acc[ai][0][m][n][j], up = acc[ai][1][m][n][j];
                        if constexpr (INI8) { g = (float)__builtin_bit_cast(int, g) * (sa * swg[4 * n + j]); up = (float)__builtin_bit_cast(int, up) * (sa * swu[4 * n + j]); } h[n * 4 + j] = g * __builtin_amdgcn_rcpf(1.0f + __builtin_amdgcn_exp2f(-1.44269504f * g)) * up; }
                if constexpr (OUT8) { *(u32x2*)((unsigned char*)O + (size_t)(row0 + ai * HALF + m * 16) * ldc + col0) = (u32x2){pk4_fp8(h[0], h[1], h[2], h[3]), pk4_fp8(h[4], h[5], h[6], h[7])}; }
                else { u32x4 w; w.x = cvt_pk_bf16(h[0], h[1]); w.y = cvt_pk_bf16(h[2], h[3]); w.z = cvt_pk_bf16(h[4], h[5]); w.w = cvt_pk_bf16(h[6], h[7]);
                    *(u32x4*)((bf16*)O + (size_t)(row0 + ai * HALF + m * 16) * ldc + col0) = w; }
            }
    }
};

typedef int i32x4 __attribute__((ext_vector_type(4)));
typedef int i32x8 __attribute__((ext_vector_type(8)));
template <class Epi, class Sched, bool ALIGN_EPI, bool SP2, int KIND  , bool MIDK = false, bool KSPLIT = false>
__device__ __forceinline__ void gemm_phase(LAS unsigned char* lds, const int tid, const Gemm g, const Sched& S, const Epi& E) {
    const int wid = __builtin_amdgcn_readfirstlane(tid >> 6), lane = tid & 63, wr = wid >> 2, wc = wid & 3, fr = lane & 15, fq = lane >> 4;
    const int K = g.Kb, nt = K / 128;
    unsigned voffA[2], voffB[2];
#pragma unroll
    for (int i = 0; i < 2; ++i) { int R, C; stage_rc(tid * 16 + i * 8192, R, C); const int Rb = Epi::PERM ? ((R & ~31) + perm32(R & 31)) : R;
        voffA[i] = (unsigned)(R * K + C * 2); voffB[i] = (unsigned)(Rb * K + C * 2); }
    const size_t kstep = (size_t)(BK * 2);
    const size_t hstep = (size_t)HALF * K;
    const size_t tstep = 2 * hstep;
    const unsigned ldsw = (unsigned)wid * 1024u;
    const int aoff = lds_byte(wr * 64 + fr, fq * 8), boff = lds_byte(wc * 32 + fr, fq * 8);
#define PG8_SA(b, h) (((b) * 2 + (h)) * HTB)
#define PG8_SB(b, h) ((4 + (b) * 2 + (h)) * HTB)
#define PG8_STAGE(bufoff, gbase, voff) do { _Pragma("unroll") for (int _i = 0; _i < 2; ++_i) \
        __builtin_amdgcn_global_load_lds((const unsigned*)((const char*)(gbase) + (voff)[_i]), (LAS unsigned*)(lds + (bufoff) + ldsw + _i * 8192), 16, 0, 0); } while (0)
#define PG8_LDA(dst, b, h) do { _Pragma("unroll") for (int m = 0; m < 4; ++m) _Pragma("unroll") for (int k = 0; k < 2; ++k) dst[m][k] = *(const LAS bf16x8*)(lds + PG8_SA(b, h) + aoff + m * 2048 + k * 1024); } while (0)
#define PG8_LDB(dst, b, h) do { _Pragma("unroll") for (int n = 0; n < 2; ++n) _Pragma("unroll") for (int k = 0; k < 2; ++k) dst[n][k] = *(const LAS bf16x8*)(lds + PG8_SB(b, h) + boff + n * 2048 + k * 1024); } while (0)
#define PG8_CAT(x) __builtin_shufflevector(__builtin_bit_cast(i32x4, (x)[0]), __builtin_bit_cast(i32x4, (x)[1]), 0, 1, 2, 3, 4, 5, 6, 7)
#define PG8_MMA(ai, bj, At, Bt) do { __builtin_amdgcn_s_setprio(1); _Pragma("unroll") for (int m = 0; m < 4; ++m) _Pragma("unroll") for (int n = 0; n < 2; ++n) { \
        if constexpr (KIND == 1) { const i32x8 bw_ = PG8_CAT(Bt[n]), aw_ = PG8_CAT(At[m]); \
            asm volatile("v_mfma_scale_f32_16x16x128_f8f6f4 %0, %1, %2, %0, %3, %4 op_sel_hi:[0,0,0]" : "+v"(acc[ai][bj][m][n]) : "v"(bw_), "v"(aw_), "v"(sc_w), "v"(sc_a)); } \
        else if constexpr (KIND == 2) { _Pragma("unroll") for (int k = 0; k < 2; ++k) acc[ai][bj][m][n] = __builtin_bit_cast(f32x4, __builtin_amdgcn_mfma_i32_16x16x64_i8( \
            __builtin_bit_cast(i32x4, Bt[n][k]), __builtin_bit_cast(i32x4, At[m][k]), __builtin_bit_cast(i32x4, acc[ai][bj][m][n]), 0, 0, 0)); } \
        else { _Pragma("unroll") for (int k = 0; k < 2; ++k) acc[ai][bj][m][n] = __builtin_amdgcn_mfma_f32_16x16x32_bf16(Bt[n][k], At[m][k], acc[ai][bj][m][n], 0, 0, 0); } } \
        __builtin_amdgcn_s_setprio(0); } while (0)
#define PG8_WAIT_V(n) asm volatile("s_waitcnt vmcnt(" #n ")" ::: "memory")
#define PG8_WAIT_L(n) asm volatile("s_waitcnt lgkmcnt(" #n ")" ::: "memory")
#define PG8_BAR __builtin_amdgcn_s_barrier()
#define PG8_SCHED __builtin_amdgcn_sched_barrier(0)
    Unit cur, nxt; int ui = 0;
    if (!S.next(0, cur)) return;
    const int sc_w = 0x79797979, sc_a = 0x7f7f7f7f; (void)sc_w; (void)sc_a;
    f32x4 acc[2][2][4][2];
#pragma unroll
    for (int a = 0; a < 2; ++a)
#pragma unroll
        for (int b = 0; b < 2; ++b)
#pragma unroll
            for (int m = 0; m < 4; ++m)
#pragma unroll
                for (int n = 0; n < 2; ++n) acc[a][b][m][n] = (f32x4){0.f, 0.f, 0.f, 0.f};
    bf16x8 At[4][2], B0[2][2], B1[2][2];
    const char* cA = (const char*)g.A + (size_t)cur.pm * tstep; const char* cB = (const char*)g.Bt + (size_t)cur.pb * tstep;
    if constexpr (KSPLIT) { if ((cur.kh & 3) == 2) { cA += (size_t)(nt / 2) * kstep; cB += (size_t)(nt / 2) * kstep; } }
    { typename Sched::Pre pre0; S.a_issue(cur, pre0); S.a_finish(cur, 0, pre0); }
    if constexpr (SP2) {
        PG8_STAGE(PG8_SB(0, 0), cB, voffB); PG8_STAGE(PG8_SB(0, 1), cB + hstep, voffB); PG8_STAGE(PG8_SA(0, 0), cA, voffA); PG8_STAGE(PG8_SA(0, 1), cA + hstep, voffA);
        if (wr == 1) PG8_BAR;
        PG8_WAIT_V(2); PG8_BAR;
        PG8_STAGE(PG8_SB(1, 0), cB + kstep, voffB); PG8_STAGE(PG8_SA(1, 0), cA + kstep, voffA); PG8_STAGE(PG8_SB(1, 1), cB + hstep + kstep, voffB);
        PG8_WAIT_V(6); PG8_BAR;
    } else {
        PG8_STAGE(PG8_SB(0, 0), cB, voffB); PG8_STAGE(PG8_SA(0, 0), cA, voffA); PG8_STAGE(PG8_SB(0, 1), cB + hstep, voffB); PG8_STAGE(PG8_SA(0, 1), cA + hstep, voffA);
        if (wr == 1) PG8_BAR;
        PG8_WAIT_V(4); PG8_BAR;
        PG8_STAGE(PG8_SB(1, 0), cB + kstep, voffB); PG8_STAGE(PG8_SA(1, 0), cA + kstep, voffA); PG8_STAGE(PG8_SB(1, 1), cB + hstep + kstep, voffB);
        PG8_WAIT_V(6); PG8_BAR;
    }
    for (;;) {
        const bool has_next = S.next(ui + 1, nxt);
        const char* nA = has_next ? (const char*)g.A + (size_t)nxt.pm * tstep : cA; const char* nB = has_next ? (const char*)g.Bt + (size_t)nxt.pb * tstep : cB;
        int unt = nt;
        if constexpr (KSPLIT) { if (has_next && (nxt.kh & 3) == 2) { nA += (size_t)(nt / 2) * kstep; nB += (size_t)(nt / 2) * kstep; } if (cur.kh & 3) unt = nt / 2; }
        for (int t = 0; t < unt; t += 2) {
            const bool last = (t == unt - 2);
            const char* a1 = cA + (size_t)(t + 1) * kstep;
            const char* a2 = last ? nA : cA + (size_t)(t + 2) * kstep; const char* b2 = last ? nB : cB + (size_t)(t + 2) * kstep;
            const char* a3 = a2 + kstep; const char* b3 = b2 + kstep;
            if constexpr (MIDK) { if (t == nt / 2) {
                const LAS float* rs = (const LAS float*)(lds + RS_OFF);
#pragma unroll
                for (int ai = 0; ai < 2; ++ai)
#pragma unroll
                    for (int m = 0; m < 4; ++m) { const float sc = rs_scale(rs, ui & 1, ai * HALF + wr * 64 + m * 16 + fr, 1.0f / D_RNN);
#pragma unroll
                        for (int bj = 0; bj < 2; ++bj)
#pragma unroll
                            for (int n = 0; n < 2; ++n) acc[ai][bj][m][n] = acc[ai][bj][m][n] * sc; } } }
            if constexpr (SP2) {
            PG8_LDB(B0, 0, 0); PG8_LDB(B1, 0, 1); PG8_SCHED; PG8_LDA(At, 0, 0); PG8_STAGE(PG8_SA(1, 1), a1 + hstep, voffA);
            PG8_WAIT_V(8); PG8_WAIT_L(0); PG8_BAR; PG8_MMA(0, 0, At, B0); PG8_MMA(0, 1, At, B1); PG8_BAR; PG8_SCHED;
            PG8_LDA(At, 0, 1); PG8_STAGE(PG8_SB(0, 0), b2, voffB); PG8_STAGE(PG8_SB(0, 1), b2 + hstep, voffB); PG8_STAGE(PG8_SA(0, 0), a2, voffA);
            PG8_WAIT_V(8); PG8_WAIT_L(0); PG8_BAR; PG8_MMA(1, 0, At, B0); PG8_MMA(1, 1, At, B1); PG8_BAR; PG8_SCHED;
            PG8_LDB(B0, 1, 0); PG8_LDB(B1, 1, 1); PG8_SCHED; PG8_LDA(At, 1, 0); PG8_STAGE(PG8_SA(0, 1), a2 + hstep, voffA);
            PG8_WAIT_V(8); PG8_WAIT_L(0); PG8_BAR; PG8_MMA(0, 0, At, B0); PG8_MMA(0, 1, At, B1); PG8_BAR; PG8_SCHED;
            PG8_LDA(At, 1, 1); PG8_STAGE(PG8_SB(1, 0), b3, voffB); PG8_STAGE(PG8_SB(1, 1), b3 + hstep, voffB); PG8_STAGE(PG8_SA(1, 0), a3, voffA);
            PG8_WAIT_V(8); PG8_WAIT_L(0); PG8_BAR; PG8_MMA(1, 0, At, B0); PG8_MMA(1, 1, At, B1); PG8_BAR; PG8_SCHED;
            } else {
            PG8_LDB(B0, 0, 0); PG8_SCHED; PG8_LDA(At, 0, 0); PG8_STAGE(PG8_SA(1, 1), a1 + hstep, voffA);
            PG8_WAIT_L(8); PG8_BAR; PG8_WAIT_L(0); PG8_MMA(0, 0, At, B0); PG8_BAR; PG8_SCHED;
            PG8_LDB(B1, 0, 1); PG8_STAGE(PG8_SB(0, 0), b2, voffB);
            PG8_BAR; PG8_WAIT_L(0); PG8_MMA(0, 1, At, B1); PG8_BAR;
            PG8_LDA(At, 0, 1); PG8_STAGE(PG8_SA(0, 0), a2, voffA);
            PG8_BAR; PG8_WAIT_L(0); PG8_MMA(1, 0, At, B0); PG8_BAR; PG8_SCHED;
            PG8_STAGE(PG8_SB(0, 1), b2 + hstep, voffB);
            PG8_WAIT_V(6); PG8_BAR; PG8_MMA(1, 1, At, B1); PG8_BAR;
            PG8_LDB(B0, 1, 0); PG8_SCHED; PG8_LDA(At, 1, 0); PG8_STAGE(PG8_SA(0, 1), a2 + hstep, voffA);
            PG8_WAIT_L(8); PG8_BAR; PG8_WAIT_L(0); PG8_MMA(0, 0, At, B0); PG8_BAR; PG8_SCHED;
            PG8_LDB(B1, 1, 1); PG8_STAGE(PG8_SB(1, 0), b3, voffB);
            PG8_BAR; PG8_WAIT_L(0); PG8_MMA(0, 1, At, B1); PG8_BAR;
            PG8_LDA(At, 1, 1); PG8_STAGE(PG8_SA(1, 0), a3, voffA);
            PG8_BAR; PG8_WAIT_L(0); PG8_MMA(1, 0, At, B0); PG8_BAR; PG8_SCHED;
            PG8_STAGE(PG8_SB(1, 1), b3 + hstep, voffB);
            PG8_WAIT_V(6); PG8_BAR; PG8_MMA(1, 1, At, B1); PG8_BAR;
            }
        }
        if constexpr (ALIGN_EPI) { if (wr == 0) PG8_BAR; }
        if constexpr (KIND == 1) asm volatile("s_nop 15\n\ts_nop 15" ::: "memory");
        typename Sched::Pre pre; if (has_next) S.a_issue(nxt, pre);
        E(acc, cur, wr, wc, fr, fq); S.done(cur);
        if (has_next) S.a_finish(nxt, (ui + 1) & 1, pre);
        if (!has_next) break;
#pragma unroll
        for (int a = 0; a < 2; ++a)
#pragma unroll
            for (int b = 0; b < 2; ++b)
#pragma unroll
                for (int m = 0; m < 4; ++m)
#pragma unroll
                    for (int n = 0; n < 2; ++n) acc[a][b][m][n] = (f32x4){0.f, 0.f, 0.f, 0.f};
        cur = nxt; cA = nA; cB = nB; ++ui;
        if constexpr (ALIGN_EPI) { if (wr == 1) PG8_BAR; }
    }
    PG8_WAIT_V(0);
    if constexpr (!ALIGN_EPI) { if (wr == 0) PG8_BAR; }
    PG8_BAR;
#undef PG8_SA
#undef PG8_SB
#undef PG8_STAGE
#undef PG8_LDA
#undef PG8_LDB
#undef PG8_MMA
#undef PG8_CAT
#undef PG8_WAIT_V
#undef PG8_WAIT_L
#undef PG8_BAR
#undef PG8_SCHED
}
}

#define XB_TMO      128
#define XB_XCNT(j)  (256  + 64 * (j))
#define XB_XSUB(j)  (1280 + 64 * (j))
#define XB_XGEN(j)  (2304 + 64 * (j))
#define XB_TOP      3328
#define XB_TOPGEN   3392
#define XCD_BAR_WORDS 3456
#define XB_SPIN_CAP (1u << 18)
__device__ __forceinline__ unsigned xb_ld(unsigned* p)              { return __hip_atomic_load(p, __ATOMIC_RELAXED, __HIP_MEMORY_SCOPE_AGENT); }
__device__ __forceinline__ unsigned xb_add(unsigned* p, unsigned v) { return __hip_atomic_fetch_add(p, v, __ATOMIC_RELAXED, __HIP_MEMORY_SCOPE_AGENT); }
__device__ __forceinline__ unsigned xb_xcc_id() { return (unsigned)__builtin_amdgcn_s_getreg((3 << 11) | 20) & 0xFu; }
#define XB_SPIN(cond, bar) do { unsigned _sp = 0; while (cond) { __builtin_amdgcn_s_sleep(1); \
    if ((++_sp & 255u) == 0u) { if (xb_ld(&(bar)[XB_TMO])) break; if (_sp > XB_SPIN_CAP) { atomicAdd(&(bar)[XB_TMO], 1u); break; } } } } while (0)
struct XcdBarrier { unsigned* bar; unsigned x; volatile LAS unsigned* st; };
__device__ __forceinline__ XcdBarrier xcd_barrier_post(unsigned* bar, volatile LAS unsigned* st) {
    XcdBarrier b; b.bar = bar; b.x = xb_xcc_id(); b.st = st;
    if (threadIdx.x == 0) (void)xb_add(&bar[XB_XCNT(b.x)], 1u);
    return b;
}
__device__ __forceinline__ void xcd_barrier_complete(unsigned* bar, unsigned x, unsigned& nloc, unsigned& nx) {
    const unsigned G = gridDim.x * gridDim.y * gridDim.z;
    unsigned sum, cnt, mine, sp = 0u;
    for (;;) {
        sum = 0u; cnt = 0u; mine = 0u;
#pragma unroll
        for (unsigned j = 0; j < 16; ++j) { const unsigned c = xb_ld(&bar[XB_XCNT(j)]); sum += c; cnt += (c > 0u) ? 1u : 0u; mine = (j == x) ? c : mine; }
        if (sum == G) break;
        __builtin_amdgcn_s_sleep(1);
        if ((++sp & 255u) == 0u) { if (xb_ld(&bar[XB_TMO])) break; if (sp > XB_SPIN_CAP) { atomicAdd(&bar[XB_TMO], 1u); break; } }
    }
    nloc = mine > 0u ? mine : 1u; nx = cnt > 0u ? cnt : 1u;
}
__device__ __forceinline__ void xcd_barrier(const XcdBarrier& b) {
    asm volatile("s_waitcnt vmcnt(0)" ::: "memory");
    __syncthreads();
    if (threadIdx.x == 0) {
        unsigned* bar = b.bar;
        __builtin_amdgcn_s_waitcnt(0);
        unsigned nloc = b.st[0], nx = b.st[1];
        if (nloc == 0u) { xcd_barrier_complete(bar, b.x, nloc, nx); b.st[0] = nloc; b.st[1] = nx; }
        const unsigned old = xb_add(&bar[XB_XSUB(b.x)], 1u);
        const unsigned gen = old / nloc;
        if (old + 1u == (gen + 1u) * nloc) {
            __builtin_amdgcn_fence(__ATOMIC_RELEASE, "agent");
            asm volatile("s_waitcnt vmcnt(0)" ::: "memory");
            const unsigned og = xb_add(&bar[XB_TOP], 1u);
            const unsigned tg = og / nx;
            if (og + 1u == (tg + 1u) * nx) xb_add(&bar[XB_TOPGEN], 1u);
            else XB_SPIN(xb_ld(&bar[XB_TOPGEN]) == tg, bar);
            __builtin_amdgcn_fence(__ATOMIC_ACQUIRE, "agent");
            xb_add(&bar[XB_XGEN(b.x)], 1u);
            asm volatile("s_waitcnt vmcnt(0)" ::: "memory");
        } else {
            XB_SPIN(xb_ld(&bar[XB_XGEN(b.x)]) == gen, bar);
            __builtin_amdgcn_fence(__ATOMIC_ACQUIRE, "agent");
            asm volatile("s_waitcnt vmcnt(0)" ::: "memory");
        }
    }
    __syncthreads();
}

__device__ __forceinline__ void p0_transpose_item(const float* W, int K, int N, bf16* WT, int kb, int nb, int drow0, LAS float* scr, int lane) {
    const int k0 = 64 * kb, n0 = 32 * nb;
#pragma unroll 8
    for (int i = 0; i < 32; ++i) { const int kk = 2 * i + (lane >> 5); scr[kk * 33 + (lane & 31)] = W[(size_t)(k0 + kk) * N + n0 + (lane & 31)]; }
    asm volatile("s_waitcnt lgkmcnt(0)" ::: "memory");
    const int c = lane & 7;
#pragma unroll
    for (int j = 0; j < 4; ++j) { const int n = (lane >> 3) + 8 * j; const LAS float* s = scr + (8 * c) * 33 + n;
        u32x4 o; o.x = pk2(s[0 * 33], s[1 * 33]); o.y = pk2(s[2 * 33], s[3 * 33]); o.z = pk2(s[4 * 33], s[5 * 33]); o.w = pk2(s[6 * 33], s[7 * 33]);
        *(u32x4*)(WT + (size_t)(drow0 + n) * K + k0 + 8 * c) = o; }
    asm volatile("s_waitcnt lgkmcnt(0)" ::: "memory");
}

__device__ __forceinline__ void p0_transpose_item_fp8(const float* W, int K, int N, unsigned char* WT, int kb, int nb, int drow0, LAS float* scr, int lane) {
    const int k0 = 64 * kb, n0 = 32 * nb;
#pragma unroll 8
    for (int i = 0; i < 32; ++i) { const int kk = 2 * i + (lane >> 5); scr[kk * 33 + (lane & 31)] = W[(size_t)(k0 + kk) * N + n0 + (lane & 31)]; }
    asm volatile("s_waitcnt lgkmcnt(0)" ::: "memory");
    const int c = lane & 3;
#pragma unroll
    for (int j = 0; j < 2; ++j) { const int n = (lane >> 2) + 16 * j; const LAS float* s = scr + (16 * c) * 33 + n;
        u32x4 o; o.x = pg8::pk4_fp8(64.f * s[0 * 33], 64.f * s[1 * 33], 64.f * s[2 * 33], 64.f * s[3 * 33]); o.y = pg8::pk4_fp8(64.f * s[4 * 33], 64.f * s[5 * 33], 64.f * s[6 * 33], 64.f * s[7 * 33]);
        o.z = pg8::pk4_fp8(64.f * s[8 * 33], 64.f * s[9 * 33], 64.f * s[10 * 33], 64.f * s[11 * 33]); o.w = pg8::pk4_fp8(64.f * s[12 * 33], 64.f * s[13 * 33], 64.f * s[14 * 33], 64.f * s[15 * 33]);
        *(u32x4*)(WT + (size_t)(drow0 + n) * K + k0 + 16 * c) = o; }
    asm volatile("s_waitcnt lgkmcnt(0)" ::: "memory");
}

__device__ __forceinline__ const float* inp(int i) {
    int off = i * 8; asm volatile("" : "+s"(off));
    const __attribute__((address_space(4))) char* ka = (const __attribute__((address_space(4))) char*)__builtin_amdgcn_kernarg_segment_ptr();
    return *(const float* const __attribute__((address_space(4)))*)(ka + off);
}

struct Ctx {
    LAS unsigned char* lds; LAS unsigned* lctl;
    int tid, lane, wave, vcu, G;
    float* out; unsigned char* ws;
};

__device__ __forceinline__ Ctx fresh(const Ctx& F) { Ctx R = F; int ln, wv = F.wave; asm volatile("v_mbcnt_lo_u32_b32 %0, -1, 0\n\tv_mbcnt_hi_u32_b32 %0, -1, %0" : "=v"(ln)); asm volatile("" : "+s"(wv));
    R.lane = ln; R.wave = wv; R.tid = wv * 64 + ln; return R; }

constexpr int I_IN = (D / 64) * (D_IN / 64), I_OUT = (D / 64) * (D / 64), I_GU = (D / 64) * (D_FF / 64), I_DN = (D_FF / 64) * (D / 64), I_LRU = 2 * 2;
constexpr int E0 = 2 * I_IN, E1 = E0 + 2 * I_OUT, E2 = E1 + I_GU, E3 = E2 + I_GU, E4 = E3 + I_DN, E5 = E4 + NE * I_GU, E6 = E5 + NE * I_GU, E7 = E6 + NE * I_DN, E8 = E7 + 32 * I_LRU;
struct CvDesc { const f32x4* src; unsigned char* dst; int N4, K, fp8; };
__device__ __forceinline__ CvDesc cv_desc(const Ctx& F, const float* const* in, int it) {
    const int n4 = F.lane & 15, kq = F.lane >> 4;
    const float* W; unsigned char* WT; int K, N, kb, nb, gu = 0, fp8 = 0;
    if (it < E0) { const int l = it / I_IN, r = it % I_IN, nblk = D_IN / 64; kb = r / nblk; nb = r % nblk; W = inp(2) + (size_t)l * D * D_IN; K = D; N = D_IN; WT = F.ws + WS_WIN + (size_t)l * D_IN * D * 2; }
    else if (it < E1) { const int q = it - E0, l = q / I_OUT, r = q % I_OUT, nblk = D / 64; kb = r / nblk; nb = r % nblk; W = inp(12) + (size_t)l * D * D; K = D; N = D; WT = F.ws + WS_WOUT + (size_t)l * D * D * 2; }
    else if (it < E3) { const int q = it - E1, up = q / I_GU, r = q % I_GU, nblk = D_FF / 64; kb = r / nblk; nb = r % nblk; W = up ? inp(15) : inp(14); K = D; N = D_FF; WT = F.ws + WS_WGU_D; gu = 1 + up; }
    else if (it < E4) { const int r = it - E3, nblk = D / 32; kb = r / nblk; nb = r % nblk; W = inp(16); K = D_FF; N = D; WT = F.ws + WS_WDN_D; fp8 = 1; }
    else if (it < E6) { const int q = it - E4, up = q / (NE * I_GU), q2 = q % (NE * I_GU), e = q2 / I_GU, r = q2 % I_GU, nblk = D_FF / 32; kb = r / nblk; nb = r % nblk;
        W = (up ? inp(19) : inp(18)) + (size_t)e * D * D_FF; K = D; N = D_FF; WT = F.ws + WS_WGU_M + (size_t)e * 2 * D_FF * D; gu = 1 + up; fp8 = 1; }
    else if (it < E7) { const int q = it - E6, e = q / I_DN, r = q % I_DN, nblk = D / 32; kb = r / nblk; nb = r % nblk; W = inp(20) + (size_t)e * D_FF * D; K = D_FF; N = D; WT = F.ws + WS_WDN_M + (size_t)e * D * D_FF; fp8 = 1; }
    else { const int q = it - E7, mi = q / I_LRU, r = q % I_LRU; kb = r / 2; nb = r % 2;
        const int mat = (mi / 8) & 1, n = mi & 7, l = mi / 16; W = (mat ? inp(7) : inp(5)) + (size_t)(l * 8 + n) * 16384; K = 128; N = 128; WT = F.ws + WS_WLRU + (size_t)mi * 16384 * 2; }
    const int k0 = fp8 ? 128 * kb + 16 * (F.lane >> 3) : 64 * kb + 16 * kq, nn = fp8 ? 32 * nb + 4 * (F.lane & 7) : 64 * nb + 4 * n4;
    const int drow = gu ? ((nn >> 7) * 256 + (nn & 127) + (gu - 1) * 128) : nn;
    CvDesc d; d.src = (const f32x4*)(W + (size_t)k0 * N + nn); d.N4 = N / 4; d.K = K; d.fp8 = fp8; d.dst = WT + ((size_t)drow * K + k0) * (fp8 ? 1 : 2); return d;
}
__device__ __forceinline__ void cv_load(const CvDesc& d, f32x4 (&x)[16]) {
#pragma unroll
    for (int j = 0; j < 16; ++j) x[j] = d.src[(size_t)j * d.N4];
}
__device__ __forceinline__ void cv_store(const CvDesc& d, const f32x4 (&x)[16]) {
    if (d.fp8) {
#pragma unroll
        for (int c = 0; c < 4; ++c) { u32x4 o;
            o.x = pg8::pk4_fp8(64.f * x[0][c], 64.f * x[1][c], 64.f * x[2][c], 64.f * x[3][c]); o.y = pg8::pk4_fp8(64.f * x[4][c], 64.f * x[5][c], 64.f * x[6][c], 64.f * x[7][c]);
            o.z = pg8::pk4_fp8(64.f * x[8][c], 64.f * x[9][c], 64.f * x[10][c], 64.f * x[11][c]); o.w = pg8::pk4_fp8(64.f * x[12][c], 64.f * x[13][c], 64.f * x[14][c], 64.f * x[15][c]);
            *(u32x4*)(d.dst + (size_t)c * d.K) = o; }
    } else {
#pragma unroll
        for (int c = 0; c < 4; ++c) { u32x4 o0, o1;
            o0.x = pk2(x[0][c], x[1][c]); o0.y = pk2(x[2][c], x[3][c]); o0.z = pk2(x[4][c], x[5][c]); o0.w = pk2(x[6][c], x[7][c]);
            o1.x = pk2(x[8][c], x[9][c]); o1.y = pk2(x[10][c], x[11][c]); o1.z = pk2(x[12][c], x[13][c]); o1.w = pk2(x[14][c], x[15][c]);
            u32x4* dst = (u32x4*)(d.dst + (size_t)c * d.K * 2); dst[0] = o0; dst[1] = o1; }
    }
}
__device__ __forceinline__ void convert_items(const Ctx& F, const float* const* in, int lo, int hi, int w0, int nw) {
    int it = lo + w0; if (it >= hi) return;
    CvDesc cur = cv_desc(F, in, it); f32x4 x[16]; cv_load(cur, x);
    for (;;) {
        const int nx = it + nw; const bool more = nx < hi;
        CvDesc nxt = cur; f32x4 y[16];
        if (more) { nxt = cv_desc(F, in, nx); cv_load(nxt, y); }
        cv_store(cur, x);
        if (!more) break;
#pragma unroll
        for (int j = 0; j < 16; ++j) x[j] = y[j];
        cur = nxt; it = nx;
    }
}
__device__ __forceinline__ void w_quant_item(const Ctx& F, const float* W, int N, int nb, float* SW, unsigned char* WT, int gu) {
    const int n4 = F.lane & 7, nn = 32 * nb + 4 * n4, k0 = 256 * F.wave + 32 * (F.lane >> 3);
    const f32x4* src = (const f32x4*)(W + (size_t)k0 * N + nn);
    f32x4 x[32];
#pragma unroll
    for (int j = 0; j < 32; ++j) x[j] = src[(size_t)j * (N / 4)];
    f32x4 mx = (f32x4){0.f, 0.f, 0.f, 0.f};
#pragma unroll
    for (int j = 0; j < 32; ++j) mx = __builtin_elementwise_max(mx, __builtin_elementwise_abs(x[j]));
#pragma unroll
    for (int c = 0; c < 4; ++c) { float v = mx[c]; v = fmaxf(v, shfl_idx(v, F.lane ^ 8)); v = fmaxf(v, shfl_idx(v, F.lane ^ 16)); v = fmaxf(v, shfl_idx(v, F.lane ^ 32)); mx[c] = v; }
    LAS f32x4* cmx = (LAS f32x4*)F.lds;
    if ((F.lane >> 3) == 0) cmx[F.wave * 8 + n4] = mx;
    __syncthreads();
    f32x4 m = cmx[n4];
#pragma unroll
    for (int w = 1; w < 8; ++w) m = __builtin_elementwise_max(m, cmx[w * 8 + n4]);
    __syncthreads();
    const int drow = gu ? ((nn >> 7) * 256 + (nn & 127) + (gu - 1) * 128) : nn;
#pragma unroll
    for (int c = 0; c < 4; ++c) { const float cm = fmaxf(m[c], 1e-30f), inv = 127.0f / cm; unsigned w[8];
#pragma unroll
        for (int q = 0; q < 8; ++q) { unsigned pk = 0;
#pragma unroll
            for (int b = 0; b < 4; ++b) { const int v = (int)rintf(x[4 * q + b][c] * inv); pk |= ((unsigned)v & 0xffu) << (8 * b); }
            w[q] = pk; }
        u32x4* dst = (u32x4*)(WT + (size_t)(drow + c) * D + k0);
        dst[0] = (u32x4){w[0], w[1], w[2], w[3]}; dst[1] = (u32x4){w[4], w[5], w[6], w[7]};
        if (F.wave == 0 && (F.lane >> 3) == 0) SW[nn + c] = cm * (1.0f / 127.0f); }
}
constexpr int QI_GU = D_FF / 32, QI_IN = D_IN / 32, QI_ALL = 2 * QI_GU + 2 * QI_IN;
__device__ __forceinline__ void i8_quantize_items(const Ctx& F, int first, int count, int c, int G) {
    float* SW = (float*)(F.ws + WS_SW);
    for (int it = first + c; it < first + count; it += G) {
        if (it < 2 * QI_GU) { const int up = it >= QI_GU, nb = it - up * QI_GU; w_quant_item(F, up ? inp(15) : inp(14), D_FF, nb, SW + up * D_FF, F.ws + WS_WGU_D, 1 + up); }
        else { const int q = it - 2 * QI_GU, l = q >= QI_IN, nb = q - l * QI_IN; w_quant_item(F, inp(2) + (size_t)l * D * D_IN, D_IN, nb, SW + 2 * D_FF + l * D_IN, F.ws + WS_WIN + (size_t)l * D_IN * D, 0); }
    }
}
__device__ __forceinline__ void p0_convert(const Ctx& F, const float* const* in, int c, int G) {
    i8_quantize_items(F, 0, 2 * QI_GU, c, G); i8_quantize_items(F, 2 * QI_GU + QI_IN, QI_IN, c, G);
    const int gw = c * 8 + F.wave, NGW = G * 8;
    convert_items(F, in, E0, E1, gw, NGW); convert_items(F, in, E3, E8, gw, NGW);
}
__device__ __forceinline__ void p0_prologue(const Ctx& F) {
    i8_quantize_items(F, 2 * QI_GU, QI_IN, F.vcu, F.G);
    f32x2* ROPE = (f32x2*)(F.ws + WS_ROPE);
    for (int i = (F.vcu * 512 + F.tid); i < SEQ * 32; i += F.G * 512) {
        const int s = i >> 5, j = i & 31;
        const float invf = exp2f(-(float)j * (13.287712379549449f / 32.0f));
        const float ang = (float)s * invf;
        const float nrev = rintf(ang * 0.15915494309189535f);
        float r = fmaf(-nrev, 6.28125f, ang); r = fmaf(-nrev, 0.0019353071795864769f, r);
        ROPE[i] = (f32x2){cosf(r), sinf(r)};
    }
}

template <bool ROUTE, bool OUTI8 = false>
__device__ __forceinline__ void norm_phase(const Ctx& F, const float* X, const float* gain, bf16* H, const float* router) {
    const int gw = F.vcu * 8 + F.wave, NGW = F.G * 8;
    f32x4 gv[8];
#pragma unroll
    for (int j = 0; j < 8; ++j) gv[j] = ((const f32x4*)gain)[F.lane + 64 * j];
    LAS float* RT = (LAS float*)F.lds;
    LAS unsigned* lst = (LAS unsigned*)(F.lds + 65536);
    unsigned* TOPE = (unsigned*)(F.ws + WS_ROUTE + RT_TOPE); float* TOPG = (float*)(F.ws + WS_ROUTE + RT_TOPG);
    unsigned* TOPR = (unsigned*)(F.ws + WS_ROUTE + RT_TOPR); unsigned* CNTB = (unsigned*)(F.ws + WS_ROUTE + RT_CNTB);
    if (ROUTE) {
        for (int i = F.tid; i < D * NE; i += 512) { const int c = i >> 3, e = i & 7; RT[e * D + c] = router[i]; }
        __syncthreads();
    }
    int it = 0;
    f32x4 v[8];
    if (gw < T) { const f32x4* xr = (const f32x4*)(X + (size_t)gw * D) + F.lane;
#pragma unroll
        for (int j = 0; j < 8; ++j) v[j] = xr[64 * j]; }
    for (int m = gw; m < T; m += NGW, ++it) {
        f32x4 vn[8];
        if (m + NGW < T) { const f32x4* xr = (const f32x4*)(X + (size_t)(m + NGW) * D) + F.lane;
#pragma unroll
            for (int j = 0; j < 8; ++j) vn[j] = xr[64 * j]; }
        else {
#pragma unroll
            for (int j = 0; j < 8; ++j) vn[j] = v[j]; }
        float ss = 0.f;
#pragma unroll
        for (int j = 0; j < 8; ++j) ss += (v[j].x * v[j].x + v[j].y * v[j].y) + (v[j].z * v[j].z + v[j].w * v[j].w);
        ss = wave_sum(ss, F.lane);
        const float rstd = 1.0f / sqrtf(ss * (1.0f / D) + EPS);
        if (OUTI8) {
            float mx = 0.f;
#pragma unroll
            for (int j = 0; j < 8; ++j) { v[j] = v[j] * rstd * gv[j]; mx = fmaxf(mx, fmaxf(fmaxf(fabsf(v[j].x), fabsf(v[j].y)), fmaxf(fabsf(v[j].z), fabsf(v[j].w)))); }
#pragma unroll
            for (int o = 1; o < 64; o <<= 1) mx = fmaxf(mx, shfl_x(mx, o, F.lane));
            mx = fmaxf(mx, 1e-30f); const float inv = 127.0f / mx;
            if (F.lane == 0) ((float*)(F.ws + WS_SA))[m] = mx * (1.0f / 127.0f);
            unsigned* o4 = (unsigned*)((unsigned char*)H + (size_t)m * D) + F.lane;
#pragma unroll
            for (int j = 0; j < 8; ++j) { const int a = (int)rintf(v[j].x * inv), b2 = (int)rintf(v[j].y * inv), c = (int)rintf(v[j].z * inv), d = (int)rintf(v[j].w * inv);
                o4[64 * j] = ((unsigned)a & 0xffu) | (((unsigned)b2 & 0xffu) << 8) | (((unsigned)c & 0xffu) << 16) | (((unsigned)d & 0xffu) << 24); }
        } else if (ROUTE) {
            unsigned* o4 = (unsigned*)((unsigned char*)H + (size_t)m * D) + F.lane;
#pragma unroll
            for (int j = 0; j < 8; ++j) { v[j] = v[j] * rstd * gv[j]; o4[64 * j] = pg8::pk4_fp8(v[j].x, v[j].y, v[j].z, v[j].w); }
        } else {
            u32x2* o8 = (u32x2*)(H + (size_t)m * D) + F.lane;
#pragma unroll
            for (int j = 0; j < 8; ++j) { v[j] = v[j] * rstd * gv[j]; o8[64 * j] = (u32x2){pk2(v[j].x, v[j].y), pk2(v[j].z, v[j].w)}; }
        }
        if (ROUTE) {
            float lg[8];
#pragma unroll
            for (int e = 0; e < 8; ++e) { float a = 0.f;
#pragma unroll
                for (int j = 0; j < 8; ++j) { const f32x4 r = ((const LAS f32x4*)(RT + e * D))[F.lane + 64 * j]; a += (v[j].x * r.x + v[j].y * r.y) + (v[j].z * r.z + v[j].w * r.w); }
                lg[e] = wave_sum(a, F.lane); }
            float v1 = -3.0e38f, v2 = -3.0e38f; int e1 = 0, e2 = 0;
#pragma unroll
            for (int e = 0; e < 8; ++e) { const float x = lg[e]; if (x > v1) { v2 = v1; e2 = e1; v1 = x; e1 = e; } else if (x > v2) { v2 = x; e2 = e; } }
            const float g2 = 1.0f / (1.0f + expf(v1 - v2)), g1 = 1.0f - g2;
            if (F.lane == 0) { TOPE[m] = (unsigned)e1 | ((unsigned)e2 << 8); TOPG[2 * m] = g1; TOPG[2 * m + 1] = g2; lst[it * 8 + F.wave] = (unsigned)e1 | ((unsigned)e2 << 8); }
        }
#pragma unroll
        for (int j = 0; j < 8; ++j) v[j] = vn[j];
    }
    if (ROUTE) {
        __syncthreads();
        if (F.tid < NE) {
            const unsigned e = F.tid; unsigned cnt = 0;
            const int niter = (T + NGW - 1) / NGW;
            for (int i = 0; i < niter; ++i)
                for (int w = 0; w < 8; ++w) { const int m = F.vcu * 8 + w + i * NGW; if (m < T) { const unsigned ent = lst[i * 8 + w];
                    if ((ent & 0xffu) == e) TOPR[2 * m] = cnt++;
                    if (((ent >> 8) & 0xffu) == e) TOPR[2 * m + 1] = cnt++; } }
            CNTB[F.vcu * 8 + e] = cnt;
        }
    }
}

__device__ __forceinline__ void moe_tables(const Ctx& F) {
    const unsigned* CNTB = (const unsigned*)(F.ws + WS_ROUTE + RT_CNTB);
    {
        const int e = F.wave; unsigned tot = 0, pre = 0;
        for (int b = F.lane; b < F.G; b += 64) { const unsigned c = CNTB[b * 8 + e]; tot += c; pre += (b < F.vcu) ? c : 0u; }
#pragma unroll
        for (int o = 1; o < 64; o <<= 1) { tot += shfl_u(tot, F.lane ^ o); pre += shfl_u(pre, F.lane ^ o); }
        if (F.lane == 0) { F.lctl[LC_PRE + e] = pre; F.lctl[LC_TOT + e] = tot; }
    }
    __syncthreads();
    if (F.tid == 0) { unsigned tb = 0; for (int e = 0; e < NE; ++e) { F.lctl[LC_TB + e] = tb; tb += (F.lctl[LC_TOT + e] + 255u) >> 8; }
        F.lctl[LC_TB + 8] = tb; F.lctl[LC_NMT] = tb; }
    __syncthreads();
    if (F.tid < MAXMT) { unsigned e = 0;
#pragma unroll
        for (int k = 1; k < NE; ++k) e += ((unsigned)F.tid >= F.lctl[LC_TB + k]) ? 1u : 0u;
        F.lctl[LC_TEXP + F.tid] = e; }
    __syncthreads();
}

__device__ __forceinline__ void gather_phase(const Ctx& F) {
    const int gw = F.vcu * 8 + F.wave, NGW = F.G * 8;
    const unsigned* TOPE = (const unsigned*)(F.ws + WS_ROUTE + RT_TOPE); const unsigned* TOPR = (const unsigned*)(F.ws + WS_ROUTE + RT_TOPR); unsigned* SLOT = (unsigned*)(F.ws + WS_ROUTE + RT_SLOT);
    const bf16* H = (const bf16*)(F.ws + WS_H); unsigned char* HP = F.ws + WS_PROJ;
    for (int m0 = gw; m0 < T; m0 += 4 * NGW) {
        unsigned ent[4], tr[4][2]; u32x4 r[4][2];
#pragma unroll
        for (int q = 0; q < 4; ++q) { const int m = m0 + q * NGW;
            if (m < T) { ent[q] = TOPE[m]; tr[q][0] = TOPR[2 * m]; tr[q][1] = TOPR[2 * m + 1];
                const u32x4* src = (const u32x4*)((const unsigned char*)H + (size_t)m * D) + F.lane;
                r[q][0] = src[0]; r[q][1] = src[64]; } }
#pragma unroll
        for (int q = 0; q < 4; ++q) { const int m = m0 + q * NGW;
            if (m < T) {
#pragma unroll
                for (int k = 0; k < 2; ++k) { const unsigned e = (ent[q] >> (8 * k)) & 0xffu; const unsigned slot = F.lctl[LC_TB + e] * 256u + F.lctl[LC_PRE + e] + tr[q][k];
                    if (F.lane == 0) SLOT[2 * m + k] = slot;
                    u32x4* dst = (u32x4*)(HP + (size_t)slot * D) + F.lane;
                    dst[0] = r[q][0]; dst[64] = r[q][1]; } } }
    }
}

__device__ __forceinline__ void final_phase(const Ctx& F, const float* gain) {
    const int gw = F.vcu * 8 + F.wave, NGW = F.G * 8;
    const float* TOPG = (const float*)(F.ws + WS_ROUTE + RT_TOPG); const unsigned* SLOT = (const unsigned*)(F.ws + WS_ROUTE + RT_SLOT);
    const bf16* OS = (const bf16*)(F.ws + WS_PROJ); const bf16* OS2 = (const bf16*)(F.ws + WS_H);
    LAS unsigned char* SPL = (LAS unsigned char*)(F.lctl + LC_SPLIT);
    { pg8::SplitOrder S; S.init((int)F.lctl[LC_NMT], D / 256, F.G, 0, nullptr); S.init2();
      for (int i = F.tid; i < MAXMT * 8; i += 512) SPL[i] = 0xffu;
      __syncthreads();
      if (F.tid < S.rem) { pg8::Unit u; if (S.unit_at((long)S.R * S.G + F.tid, u)) SPL[u.pm * 8 + u.pn] = (unsigned char)F.tid; }
      __syncthreads(); }
    f32x4 gv[8];
#pragma unroll
    for (int j = 0; j < 8; ++j) gv[j] = ((const f32x4*)gain)[F.lane + 64 * j];
    float g1 = 0.f, g2 = 0.f, ng1 = 0.f, ng2 = 0.f; unsigned s1 = 0, s2 = 0, ns1 = 0, ns2 = 0;
    f32x4 xv[8]; u32x2 av[8], bv[8];
    if (gw < T) { g1 = TOPG[2 * gw]; g2 = TOPG[2 * gw + 1]; s1 = SLOT[2 * gw]; s2 = SLOT[2 * gw + 1];
        const f32x4* xr0 = (const f32x4*)(F.out + (size_t)gw * D) + F.lane; const u32x2* o1 = (const u32x2*)(OS + (size_t)s1 * D) + F.lane; const u32x2* o2 = (const u32x2*)(OS + (size_t)s2 * D) + F.lane;
#pragma unroll
        for (int j = 0; j < 8; ++j) { xv[j] = xr0[64 * j]; av[j] = o1[64 * j]; bv[j] = o2[64 * j]; } }
    if (gw + NGW < T) { const int mn = gw + NGW; ng1 = TOPG[2 * mn]; ng2 = TOPG[2 * mn + 1]; ns1 = SLOT[2 * mn]; ns2 = SLOT[2 * mn + 1]; }
    for (int m = gw; m < T; m += NGW) {
        f32x4* xr = (f32x4*)(F.out + (size_t)m * D) + F.lane;
        f32x4 xn[8]; u32x2 an[8], bn[8]; float fg1 = 0.f, fg2 = 0.f; unsigned fs1 = 0, fs2 = 0;
        if (m + NGW < T) { const f32x4* xrn = (const f32x4*)(F.out + (size_t)(m + NGW) * D) + F.lane; const u32x2* o1 = (const u32x2*)(OS + (size_t)ns1 * D) + F.lane; const u32x2* o2 = (const u32x2*)(OS + (size_t)ns2 * D) + F.lane;
#pragma unroll
            for (int j = 0; j < 8; ++j) { xn[j] = xrn[64 * j]; an[j] = o1[64 * j]; bn[j] = o2[64 * j]; } }
        else {
#pragma unroll
            for (int j = 0; j < 8; ++j) { xn[j] = xv[j]; an[j] = av[j]; bn[j] = bv[j]; } }
        if (m + 2 * NGW < T) { const int mf = m + 2 * NGW; fg1 = TOPG[2 * mf]; fg2 = TOPG[2 * mf + 1]; fs1 = SLOT[2 * mf]; fs2 = SLOT[2 * mf + 1]; }
        f32x4 v[8]; float ss = 0.f;
#pragma unroll
        for (int j = 0; j < 8; ++j) { const u32x2 a = av[j], b = bv[j]; v[j] = xv[j];
            float va[4] = {bflo(a.x), bfhi(a.x), bflo(a.y), bfhi(a.y)}, vb[4] = {bflo(b.x), bfhi(b.x), bflo(b.y), bfhi(b.y)};
            const unsigned q1 = SPL[(s1 >> 8) * 8 + j], q2 = SPL[(s2 >> 8) * 8 + j];
            if (q1 != 0xffu) { const u32x2 c = ((const u32x2*)(OS2 + ((size_t)q1 * 256 + (s1 & 255u)) * 256))[F.lane]; va[0] += bflo(c.x); va[1] += bfhi(c.x); va[2] += bflo(c.y); va[3] += bfhi(c.y); }
            if (q2 != 0xffu) { const u32x2 c = ((const u32x2*)(OS2 + ((size_t)q2 * 256 + (s2 & 255u)) * 256))[F.lane]; vb[0] += bflo(c.x); vb[1] += bfhi(c.x); vb[2] += bflo(c.y); vb[3] += bfhi(c.y); }
            v[j].x += g1 * va[0] + g2 * vb[0]; v[j].y += g1 * va[1] + g2 * vb[1]; v[j].z += g1 * va[2] + g2 * vb[2]; v[j].w += g1 * va[3] + g2 * vb[3];
            ss += (v[j].x * v[j].x + v[j].y * v[j].y) + (v[j].z * v[j].z + v[j].w * v[j].w); }
        ss = wave_sum(ss, F.lane);
        const float rstd = 1.0f / sqrtf(ss * (1.0f / D) + EPS);
#pragma unroll
        for (int j = 0; j < 8; ++j) xr[64 * j] = v[j] * rstd * gv[j];
#pragma unroll
        for (int j = 0; j < 8; ++j) { xv[j] = xn[j]; av[j] = an[j]; bv[j] = bn[j]; }
        g1 = ng1; g2 = ng2; s1 = ns1; s2 = ns2; ng1 = fg1; ng2 = fg2; ns1 = fs1; ns2 = fs2;
    }
}

__device__ __forceinline__ void lru_unit(const Ctx& F, int l, int b, int n, int hf, const float* const* in) {
    asm volatile("" : "+s"(l), "+s"(b), "+s"(n), "+s"(hf));
    const int tid = F.tid, wave = F.wave, lane = F.lane, fr = lane & 15, fq = lane >> 4, nt = wave & 3, mh = wave >> 2;
    LAS unsigned char* XC = F.lds; LAS float* EX = (LAS float*)(F.lds + 32768);
    LAS float* HS = EX + 256;
    static_assert(32768 + (256 + 128 * 68) * 4 <= LDSCTL_OFF, "RG-LRU LDS map");
    const bf16* PROJ = (const bf16*)(F.ws + WS_PROJ); bf16* Y = (bf16*)(F.ws + WS_H); float* SSP = (float*)(F.ws + WS_SSP);
    const bf16* WL = (const bf16*)(F.ws + WS_WLRU) + (size_t)l * 2 * 8 * 16384;
    const int os_g = tid & 7, os_tok = tid >> 3;
    float gn[8]; { const f32x4 a = *(const f32x4*)(inp(10) + (size_t)l * D_RNN + n * 128 + hf * 64 + 8 * os_g), c = *(const f32x4*)(inp(10) + (size_t)l * D_RNN + n * 128 + hf * 64 + 8 * os_g + 4);
        gn[0] = a.x; gn[1] = a.y; gn[2] = a.z; gn[3] = a.w; gn[4] = c.x; gn[5] = c.y; gn[6] = c.z; gn[7] = c.w; }
    const int cg = tid & 15, tl = tid >> 4, cch = n * 128 + cg * 8;
    const int prow0 = ((tl >> 4) << 6) | ((tl & 3) << 4) | (((tl >> 2) & 3) << 2);
    float cw[4][8], cb[8];
#pragma unroll
    for (int tap = 0; tap < 4; ++tap) { const f32x4 a = *(const f32x4*)(inp(3) + (size_t)(l * 4 + tap) * D_RNN + cch), c = *(const f32x4*)(inp(3) + (size_t)(l * 4 + tap) * D_RNN + cch + 4);
        cw[tap][0] = a.x; cw[tap][1] = a.y; cw[tap][2] = a.z; cw[tap][3] = a.w; cw[tap][4] = c.x; cw[tap][5] = c.y; cw[tap][6] = c.z; cw[tap][7] = c.w; }
    { const f32x4 a = *(const f32x4*)(inp(4) + (size_t)l * D_RNN + cch), c = *(const f32x4*)(inp(4) + (size_t)l * D_RNN + cch + 4);
        cb[0] = a.x; cb[1] = a.y; cb[2] = a.z; cb[3] = a.w; cb[4] = c.x; cb[5] = c.y; cb[6] = c.z; cb[7] = c.w; }
    const int lc = hf * 64 + nt * 16 + fr, gc = n * 128 + lc;
    const float ba_c = inp(6)[l * D_RNN + gc], bx_c = inp(8)[l * D_RNN + gc];
    const float sp8 = 8.0f * log1pf(expf(-inp(9)[l * D_RNN + gc]));
    bf16x8 Wa[4], Wx[4];
#pragma unroll
    for (int ks = 0; ks < 4; ++ks) { Wa[ks] = *(const bf16x8*)(WL + (size_t)((0 * 8 + n) * 128 + lc) * 128 + 32 * ks + 8 * fq);
                                     Wx[ks] = *(const bf16x8*)(WL + (size_t)((1 * 8 + n) * 128 + lc) * 128 + 32 * ks + 8 * fq); }
    float Hc = 0.f;
    u32x4 xr[7];
#pragma unroll
    for (int r = 0; r < 7; ++r) { const int t = 4 * tl - 3 + r; xr[r] = (u32x4){0u, 0u, 0u, 0u}; if (t >= 0) xr[r] = *(const u32x4*)(PROJ + (size_t)(b * SEQ + t) * D_IN + cch); }
    for (int ck = 0; ck < SEQ / 128; ++ck) {
        const int t0 = ck * 128;
        {
            float xv[7][8];
#pragma unroll
            for (int r = 0; r < 7; ++r) { const u32x4 w = xr[r];
                xv[r][0] = bflo(w.x); xv[r][1] = bfhi(w.x); xv[r][2] = bflo(w.y); xv[r][3] = bfhi(w.y); xv[r][4] = bflo(w.z); xv[r][5] = bfhi(w.z); xv[r][6] = bflo(w.w); xv[r][7] = bfhi(w.w); }
#pragma unroll
            for (int q = 0; q < 4; ++q) { float y[8];
#pragma unroll
                for (int c = 0; c < 8; ++c) { float a = cb[c];
#pragma unroll
                    for (int tap = 0; tap < 4; ++tap) a += cw[tap][c] * xv[q + tap][c];
                    y[c] = a; }
                *(LAS u32x4*)(XC + tile_off(prow0 + q, 8 * cg, 4)) = (u32x4){pk2(y[0], y[1]), pk2(y[2], y[3]), pk2(y[4], y[5]), pk2(y[6], y[7])}; }
        }
        __syncthreads();
        if (ck + 1 < SEQ / 128) {
#pragma unroll
            for (int r = 0; r < 7; ++r) xr[r] = *(const u32x4*)(PROJ + (size_t)(b * SEQ + t0 + 128 + 4 * tl - 3 + r) * D_IN + cch);
        }
        u32x4 gpre[2];
#pragma unroll
        for (int j = 0; j < 2; ++j) gpre[j] = *(const u32x4*)(PROJ + (size_t)(b * SEQ + t0 + os_tok + 64 * j) * D_IN + OFF_GATE + n * 128 + hf * 64 + 8 * os_g);
        float av[16], bv[16];
#pragma unroll
        for (int mi = 0; mi < 4; ++mi) {
            const int mt = 4 * mh + mi;
            f32x4 aa = (f32x4){0.f, 0.f, 0.f, 0.f}, ax = (f32x4){0.f, 0.f, 0.f, 0.f};
#pragma unroll
            for (int ks = 0; ks < 4; ++ks) { const bf16x8 xf = lds_frag(XC, tile_off(16 * mt + fr, 32 * ks + 8 * fq, 4)); aa = MFMA16(xf, Wa[ks], aa); ax = MFMA16(xf, Wx[ks], ax); }
#pragma unroll
            for (int i = 0; i < 4; ++i) { const int tok = 64 * mh + 16 * fq + 4 * mi + i;
                const float r = sigmoidf_(aa[i] + ba_c), ig = sigmoidf_(ax[i] + bx_c);
                const float a = __expf(-sp8 * r); float mult = sqrtf(fmaxf(1.0f - a * a, 0.f));
                if (ck == 0 && tok == 0) mult = 1.0f;
                const float xcv = __builtin_bit_cast(float, (unsigned)(*(const LAS unsigned short*)(XC + tile_off(16 * mt + 4 * fq + i, lc, 4))) << 16);
                av[4 * mi + i] = a; bv[4 * mi + i] = mult * ig * xcv; }
        }
        float P = av[0], Q = bv[0];
#pragma unroll
        for (int k = 1; k < 16; ++k) { P *= av[k]; Q = Q * av[k] + bv[k]; }
        { const float P1 = shfl_idx(P, lane - 16), Q1 = shfl_idx(Q, lane - 16); if (fq >= 1) { Q = P * Q1 + Q; P = P * P1; } }
        { const float P2 = shfl_idx(P, lane - 32), Q2 = shfl_idx(Q, lane - 32); if (fq >= 2) { Q = P * Q2 + Q; P = P * P2; } }
        float Pex = shfl_idx(P, lane - 16), Qex = shfl_idx(Q, lane - 16); if (fq == 0) { Pex = 1.0f; Qex = 0.f; }
        const float Pc = shfl_idx(P, fr + 48), Qc = shfl_idx(Q, fr + 48);
        if (fq == 0) { EX[((mh * 4 + nt) * 16 + fr) * 2] = Pc; EX[((mh * 4 + nt) * 16 + fr) * 2 + 1] = Qc; }
        __syncthreads();
        const float P0 = EX[((0 * 4 + nt) * 16 + fr) * 2], Q0 = EX[((0 * 4 + nt) * 16 + fr) * 2 + 1], P1h = EX[((1 * 4 + nt) * 16 + fr) * 2], Q1h = EX[((1 * 4 + nt) * 16 + fr) * 2 + 1];
        const float Hmid = P0 * Hc + Q0;
        const float Hw = (mh == 0) ? Hc : Hmid;
        Hc = P1h * Hmid + Q1h;
        {
            float h = Pex * Hw + Qex;
#pragma unroll
            for (int k = 0; k < 16; ++k) { h = av[k] * h + bv[k]; HS[(64 * mh + 16 * fq + k) * 68 + nt * 16 + fr] = h; }
        }
        __syncthreads();
#pragma unroll
        for (int j = 0; j < 2; ++j) { const int tk = os_tok + 64 * j; const size_t row = (size_t)(b * SEQ + t0 + tk);
            const u32x4 gw = gpre[j];
            const f32x4 h0 = *(const LAS f32x4*)(HS + tk * 68 + 8 * os_g), h1 = *(const LAS f32x4*)(HS + tk * 68 + 8 * os_g + 4);
            const float hh[8] = {h0.x, h0.y, h0.z, h0.w, h1.x, h1.y, h1.z, h1.w};
            {
                float ss = ((hh[0] * hh[0] + hh[1] * hh[1]) + (hh[2] * hh[2] + hh[3] * hh[3])) + ((hh[4] * hh[4] + hh[5] * hh[5]) + (hh[6] * hh[6] + hh[7] * hh[7]));
                ss += shfl_x(ss, 1, lane); ss += shfl_x(ss, 2, lane); ss += shfl_x(ss, 4, lane);
                if (os_g == 0) SSP[row * 16 + (n * 2 + hf)] = ss; }
            const float g[8] = {bflo(gw.x), bfhi(gw.x), bflo(gw.y), bfhi(gw.y), bflo(gw.z), bfhi(gw.z), bflo(gw.w), bfhi(gw.w)}; float y[8];
#pragma unroll
            for (int r = 0; r < 8; ++r) { const float x = g[r]; y[r] = hh[r] * gn[r] * (x * sigmoidf_(1.5957691216f * (x + 0.044715f * x * x * x))); }
            *(u32x4*)(Y + row * D + n * 128 + hf * 64 + 8 * os_g) = (u32x4){pk2(y[0], y[1]), pk2(y[2], y[3]), pk2(y[4], y[5]), pk2(y[6], y[7])}; }
    }
    __syncthreads();
}

typedef short s16x4 __attribute__((ext_vector_type(4)));
__device__ __forceinline__ bf16x8 tr_frag(LAS unsigned char* base, int stride, int krow0, int col0, int lane) {
    const int g = lane >> 4, i = lane & 15, q = i >> 2, p = i & 3;
    const s16x4 lo = __builtin_amdgcn_ds_read_tr16_b64_v4i16((LAS s16x4*)(base + (krow0 + 8 * g + q) * stride + (col0 + 4 * p) * 2));
    const s16x4 hi = __builtin_amdgcn_ds_read_tr16_b64_v4i16((LAS s16x4*)(base + (krow0 + 8 * g + 4 + q) * stride + (col0 + 4 * p) * 2));
    return __builtin_shufflevector(lo, hi, 0, 1, 2, 3, 4, 5, 6, 7);
}
constexpr int SKZ = 144, SVS = 288;
__device__ __forceinline__ void ret_unit(const Ctx& F, int l, int b, int h, int c0, int c1, const float* const* in) {
    asm volatile("" : "+s"(l), "+s"(b), "+s"(h), "+s"(c0), "+s"(c1));
    const int tid = F.tid, wave = F.wave, lane = F.lane, fr = lane & 15, fq = lane >> 4;
    LAS unsigned char* Qs = F.lds; LAS unsigned char* Ks = F.lds + 16384; LAS unsigned char* Kz = F.lds + 32768; LAS unsigned char* Vs = Kz + 128 * SKZ;
    LAS unsigned char* Ps = Vs + 128 * SVS; LAS unsigned char* STs = Ps + 32768;
    static_assert(32768 + 128 * SKZ + 128 * SVS + 32768 + 16384 <= LDSCTL_OFF, "retention LDS map");
    const bf16* PROJ = (const bf16*)(F.ws + WS_PROJ); bf16* Y = (bf16*)(F.ws + WS_H); const f32x2* ROPE = (const f32x2*)(F.ws + WS_ROPE);
    const float* rg = inp(11) + (size_t)l * 1024 + h * 128;
    const float lgm = log2f(1.0f - exp2f(-5.0f - (float)h));
    const float cdec = exp2f(128.0f * lgm);
    const int tok = tid >> 2, seg = tid & 3;
    const float zeta = exp2f((float)(127 - tok) * lgm);
    f32x4 accS[4];
#pragma unroll
    for (int dt = 0; dt < 4; ++dt) accS[dt] = (f32x4){0.f, 0.f, 0.f, 0.f};
    f32x4 pr_cs[4]; u32x4 pr_k[2], pr_v[4], pr_q[2];
#define RET_LOAD(ckk, want_q) do { const size_t ro_ = (size_t)(b * SEQ + (ckk) * 128 + tok) * D_IN; const f32x4* cs_ = (const f32x4*)(ROPE + (size_t)((ckk) * 128 + tok) * 32 + 8 * seg); \
        _Pragma("unroll") for (int i_ = 0; i_ < 4; ++i_) pr_cs[i_] = cs_[i_]; \
        pr_k[0] = *(const u32x4*)(PROJ + ro_ + OFF_K + h * 64 + 8 * seg); pr_k[1] = *(const u32x4*)(PROJ + ro_ + OFF_K + h * 64 + 32 + 8 * seg); \
        _Pragma("unroll") for (int q_ = 0; q_ < 4; ++q_) pr_v[q_] = *(const u32x4*)(PROJ + ro_ + OFF_V + h * 128 + 32 * seg + 8 * q_); \
        if (want_q) { pr_q[0] = *(const u32x4*)(PROJ + ro_ + OFF_Q + h * 64 + 8 * seg); pr_q[1] = *(const u32x4*)(PROJ + ro_ + OFF_Q + h * 64 + 32 + 8 * seg); } } while (0)
    pr_q[0] = pr_q[1] = (u32x4){0u, 0u, 0u, 0u};
    RET_LOAD(0, c0 == 0);
    for (int ck = 0; ck < c1; ++ck) {
        const int t0 = ck * 128; const bool full = ck >= c0;
        if (full) {
#pragma unroll
            for (int dt = 0; dt < 4; ++dt) *(LAS u32x2*)(STs + tile_off(16 * wave + fr, 16 * dt + 4 * fq, 2)) = (u32x2){pk2(accS[dt][0], accS[dt][1]), pk2(accS[dt][2], accS[dt][3])};
        }
        {
            float c[8], s[8];
#pragma unroll
            for (int i = 0; i < 4; ++i) { const f32x4 v = pr_cs[i]; c[2 * i] = v.x; s[2 * i] = v.y; c[2 * i + 1] = v.z; s[2 * i + 1] = v.w; }
            if (full) {
                const u32x4 w1 = pr_q[0], w2 = pr_q[1];
                const float x1[8] = {bflo(w1.x), bfhi(w1.x), bflo(w1.y), bfhi(w1.y), bflo(w1.z), bfhi(w1.z), bflo(w1.w), bfhi(w1.w)};
                const float x2[8] = {bflo(w2.x), bfhi(w2.x), bflo(w2.y), bfhi(w2.y), bflo(w2.z), bfhi(w2.z), bflo(w2.w), bfhi(w2.w)};
                float r1[8], r2[8];
#pragma unroll
                for (int i = 0; i < 8; ++i) { r1[i] = x1[i] * c[i] - x2[i] * s[i]; r2[i] = x1[i] * s[i] + x2[i] * c[i]; }
                *(LAS u32x4*)(Qs + tile_off(tok, 8 * seg, 2)) = (u32x4){pk2(r1[0], r1[1]), pk2(r1[2], r1[3]), pk2(r1[4], r1[5]), pk2(r1[6], r1[7])};
                *(LAS u32x4*)(Qs + tile_off(tok, 32 + 8 * seg, 2)) = (u32x4){pk2(r2[0], r2[1]), pk2(r2[2], r2[3]), pk2(r2[4], r2[5]), pk2(r2[6], r2[7])};
            }
            {
                const u32x4 w1 = pr_k[0], w2 = pr_k[1];
                const float x1[8] = {bflo(w1.x), bfhi(w1.x), bflo(w1.y), bfhi(w1.y), bflo(w1.z), bfhi(w1.z), bflo(w1.w), bfhi(w1.w)};
                const float x2[8] = {bflo(w2.x), bfhi(w2.x), bflo(w2.y), bfhi(w2.y), bflo(w2.z), bfhi(w2.z), bflo(w2.w), bfhi(w2.w)};
                float r1[8], r2[8];
#pragma unroll
                for (int i = 0; i < 8; ++i) { r1[i] = (x1[i] * c[i] - x2[i] * s[i]) * 0.125f; r2[i] = (x1[i] * s[i] + x2[i] * c[i]) * 0.125f; }
                if (full) {
                    *(LAS u32x4*)(Ks + tile_off(tok, 8 * seg, 2)) = (u32x4){pk2(r1[0], r1[1]), pk2(r1[2], r1[3]), pk2(r1[4], r1[5]), pk2(r1[6], r1[7])};
                    *(LAS u32x4*)(Ks + tile_off(tok, 32 + 8 * seg, 2)) = (u32x4){pk2(r2[0], r2[1]), pk2(r2[2], r2[3]), pk2(r2[4], r2[5]), pk2(r2[6], r2[7])};
                }
#pragma unroll
                for (int i = 0; i < 8; ++i) { r1[i] *= zeta; r2[i] *= zeta; }
                *(LAS u32x4*)(Kz + tok * SKZ + 16 * seg) = (u32x4){pk2(r1[0], r1[1]), pk2(r1[2], r1[3]), pk2(r1[4], r1[5]), pk2(r1[6], r1[7])};
                *(LAS u32x4*)(Kz + tok * SKZ + 64 + 16 * seg) = (u32x4){pk2(r2[0], r2[1]), pk2(r2[2], r2[3]), pk2(r2[4], r2[5]), pk2(r2[6], r2[7])};
            }
#pragma unroll
            for (int q = 0; q < 4; ++q) *(LAS u32x4*)(Vs + tok * SVS + 64 * seg + 16 * q) = pr_v[q];
        }
        __syncthreads();
        if (ck + 1 < c1) RET_LOAD(ck + 1, ck + 1 >= c0);
        if (full) {
            bf16x8 qf[2];
#pragma unroll
            for (int ks = 0; ks < 2; ++ks) qf[ks] = lds_frag(Qs, tile_off(16 * wave + fr, 32 * ks + 8 * fq, 2));
            int irow = 16 * wave + fr; float lgv = lgm; asm volatile("" : "+v"(irow), "+v"(lgv));
#pragma unroll
            for (int jt = 0; jt < 8; ++jt) {
                u32x2 pw = (u32x2){0u, 0u};
                if (jt <= wave) {
                    f32x4 sc = (f32x4){0.f, 0.f, 0.f, 0.f};
#pragma unroll
                    for (int ks = 0; ks < 2; ++ks) sc = MFMA16(lds_frag(Ks, tile_off(16 * jt + fr, 32 * ks + 8 * fq, 2)), qf[ks], sc);
                    float p[4];
#pragma unroll
                    for (int r = 0; r < 4; ++r) { const int dij = irow - (16 * jt + 4 * fq + r); p[r] = (dij >= 0) ? sc[r] * __builtin_amdgcn_exp2f((float)dij * lgv) : 0.f; }
                    pw = (u32x2){pk2(p[0], p[1]), pk2(p[2], p[3])};
                }
                *(LAS u32x2*)(Ps + tile_off(irow, 16 * jt + 4 * fq, 4)) = pw;
            }
            __syncthreads();
            bf16x8 pf[4];
#pragma unroll
            for (int ks = 0; ks < 4; ++ks) pf[ks] = lds_frag(Ps, tile_off(16 * wave + fr, 32 * ks + 8 * fq, 4));
            const float xi = __builtin_amdgcn_exp2f((float)(irow + 1) * lgv);
            float o[8][4]; float sum = 0.f;
#pragma unroll
            for (int et = 0; et < 8; ++et) {
                f32x4 ao = (f32x4){0.f, 0.f, 0.f, 0.f}, ac = (f32x4){0.f, 0.f, 0.f, 0.f};
#pragma unroll
                for (int ks = 0; ks < 4; ++ks) if (32 * ks <= 16 * wave + 15) ao = MFMA16(tr_frag(Vs, SVS, 32 * ks, 16 * et, lane), pf[ks], ao);
#pragma unroll
                for (int ks = 0; ks < 2; ++ks) ac = MFMA16(lds_frag(STs, tile_off(16 * et + fr, 32 * ks + 8 * fq, 2)), qf[ks], ac);
#pragma unroll
                for (int r = 0; r < 4; ++r) { o[et][r] = ao[r] + xi * ac[r]; sum += o[et][r]; }
            }
            sum += shfl_x(sum, 16, lane); sum += shfl_x(sum, 32, lane);
            const float mean = sum * (1.0f / 128.0f); float var = 0.f;
#pragma unroll
            for (int et = 0; et < 8; ++et)
#pragma unroll
                for (int r = 0; r < 4; ++r) { const float d = o[et][r] - mean; var += d * d; }
            var += shfl_x(var, 16, lane); var += shfl_x(var, 32, lane);
            const float rstd = 1.0f / sqrtf(var * (1.0f / 128.0f) + EPS);
            {
                const size_t rowo = (size_t)(b * SEQ + t0 + irow);
#pragma unroll
                for (int et = 0; et < 8; ++et) {
                    const u32x2 gw = *(const u32x2*)(PROJ + rowo * D_IN + OFF_G + h * 128 + 16 * et + 4 * fq);
                    const f32x4 gn = *(const f32x4*)(rg + 16 * et + 4 * fq);
                    const float g[4] = {bflo(gw.x), bfhi(gw.x), bflo(gw.y), bfhi(gw.y)};
                    float y[4];
#pragma unroll
                    for (int r = 0; r < 4; ++r) y[r] = (o[et][r] - mean) * rstd * gn[r] * (g[r] * sigmoidf_(g[r]));
                    *(u32x2*)(Y + rowo * D + 1024 + h * 128 + 16 * et + 4 * fq) = (u32x2){pk2(y[0], y[1]), pk2(y[2], y[3])};
                }
            }
        }
        {
            bf16x8 vf[4];
#pragma unroll
            for (int ks = 0; ks < 4; ++ks) vf[ks] = tr_frag(Vs, SVS, 32 * ks, 16 * wave, lane);
#pragma unroll
            for (int dt = 0; dt < 4; ++dt) { accS[dt] = accS[dt] * cdec;
#pragma unroll
                for (int ks = 0; ks < 4; ++ks) accS[dt] = MFMA16(tr_frag(Kz, SKZ, 32 * ks, 16 * dt, lane), vf[ks], accS[dt]); }
        }
        __syncthreads();
    }
#undef RET_LOAD
}

__device__ __forceinline__ void ylru_phase(const Ctx& F, int l, const float* gain) {
    const int gw = F.vcu * 8 + F.wave, NGW = F.G * 8;
    const float* HLRU = (const float*)(F.ws + WS_HID); const float* SSP = (const float*)(F.ws + WS_SSP); const bf16* PROJ = (const bf16*)(F.ws + WS_PROJ); bf16* Y = (bf16*)(F.ws + WS_H);
    f32x4 gv[4];
#pragma unroll
    for (int j = 0; j < 4; ++j) gv[j] = ((const f32x4*)(gain + (size_t)l * D_RNN))[F.lane + 64 * j];
    for (int m = gw; m < T; m += NGW) {
        float ss = 0.f;
#pragma unroll
        for (int n = 0; n < 16; ++n) ss += SSP[(size_t)n * T + m];
        const float rstd = 1.0f / sqrtf(ss * (1.0f / D_RNN) + EPS);
#pragma unroll
        for (int j = 0; j < 4; ++j) { const f32x4 hh = ((const f32x4*)(HLRU + (size_t)m * D_RNN))[F.lane + 64 * j];
            const u32x2 gw2 = ((const u32x2*)(PROJ + (size_t)m * D_IN + OFF_GATE))[F.lane + 64 * j];
            const float g[4] = {bflo(gw2.x), bfhi(gw2.x), bflo(gw2.y), bfhi(gw2.y)}; float y[4];
#pragma unroll
            for (int r = 0; r < 4; ++r) { const float x = g[r]; const float ge = x * sigmoidf_(1.5957691216f * (x + 0.044715f * x * x * x)); y[r] = hh[r] * rstd * gv[j][r] * ge; }
            ((u32x2*)(Y + (size_t)m * D))[F.lane + 64 * j] = (u32x2){pk2(y[0], y[1]), pk2(y[2], y[3])}; }
    }
}

constexpr int NPHASE = 20;
struct Args { const float* in[22]; float* out; unsigned char* ws; int ph_lo, ph_hi, li, pad; };
__global__ void __launch_bounds__(512, 2) fwd(Args args) {
    extern __shared__ __attribute__((aligned(16))) unsigned char lds_raw[];
    Ctx F;
    F.lds = (LAS unsigned char*)lds_raw; F.lctl = (LAS unsigned*)(F.lds + LDSCTL_OFF);
    F.tid = threadIdx.x; F.lane = F.tid & 63; F.wave = __builtin_amdgcn_readfirstlane(F.tid >> 6);
    F.G = gridDim.x; { const int bx = blockIdx.x; F.vcu = (F.G % 8 == 0) ? (bx % 8) * (F.G / 8) + bx / 8 : bx; }
    F.out = args.out; F.ws = args.ws;
    for (int u = F.tid; u < (LDS_BYTES - LDSCTL_OFF) / 4; u += 512) F.lctl[u] = 0u;
    __syncthreads();
    unsigned* ctl = (unsigned*)(args.ws + WS_CTL);
    XcdBarrier bar = xcd_barrier_post(ctl + CW_BAR + args.li * XCD_BAR_WORDS, (volatile LAS unsigned*)(F.lctl + LC_BAR));
    const int lo = args.ph_lo, hi = args.ph_hi;
#define IN(k) (lo <= (k) && (k) < hi)
#define SEAM(k) do { if ((k) + 1 < hi) xcd_barrier(bar); } while (0)
    bf16* Hb = (bf16*)(args.ws + WS_H); bf16* PROJ = (bf16*)(args.ws + WS_PROJ); bf16* HID = (bf16*)(args.ws + WS_HID);

    if (IN(0)) REPEAT(REP_P0) { const Ctx P = fresh(F); p0_prologue(P); norm_phase<false, true>(P, inp(0), inp(1), Hb, nullptr); SEAM(0); }

    for (int l = 0; l < 2; ++l) {
        const int pb = 1 + 9 * l;
        const float* Xin = (l == 0) ? inp(0) : args.out;
        if (IN(pb + 0) && l == 1) REPEAT(REP_NORM) { const Ctx P = fresh(F); norm_phase<false, true>(P, Xin, inp(1) + (size_t)l * D, Hb, nullptr); SEAM(pb + 0); }
        if (IN(pb + 1)) REPEAT(REP_GIN) {
            const Ctx P = fresh(F);
            int Gv = F.G, cv = (int)blockIdx.x; bool gemm = true;
            if (l == 0) {
                const int xcd = (int)blockIdx.x % 8, idx = (int)blockIdx.x / 8, per = F.G / 8, nc = (F.G % 8 == 0 && per > GIN0_NC) ? GIN0_NC : 0;
                int cc = F.vcu, cg = F.G; bool conv = true;
                if (nc != 0) { if (idx >= per - nc) { cc = (idx - (per - nc)) * 8 + xcd; cg = nc * 8; gemm = false; } else { conv = false; Gv = (per - nc) * 8; cv = idx * 8 + xcd; } }
                if (conv) p0_convert(P, args.in, cc, cg);
            }
            if (gemm) {
                pg8::Gemm g{Hb, args.ws + WS_WIN + (size_t)l * D_IN * D, D}; pg8::GroupOrder S; S.init(T / 256, D_IN / 256, Gv, cv, nullptr);
                pg8::EpiOut<true> E{nullptr, nullptr, PROJ, D_IN, 1, (const float*)(args.ws + WS_SA), (const float*)(args.ws + WS_SW) + 2 * D_FF + (size_t)l * D_IN};
                pg8::gemm_phase<pg8::EpiOut<true>, pg8::GroupOrder, true, true, 2>(P.lds, P.tid, g, S, E);
            }
            SEAM(pb + 1);
        }
        if (IN(pb + 2)) REPEAT(REP_MIX) {
            const Ctx P = fresh(F);
            for (int u = blockIdx.x; u < 128; u += F.G) REPEAT(REP_RET) { const int bh = u & 63, th = u >> 6; ret_unit(P, l, bh >> 3, bh & 7, th ? 9 : 0, th ? 16 : 9, args.in); }
            { int u0 = (int)blockIdx.x - 128; if (u0 < 0) u0 += F.G; for (int u = u0; u < 128; u += F.G) REPEAT(REP_LRU) { const int bn = u & 63; lru_unit(P, l, bn >> 3, bn & 7, u >> 6, args.in); } }
            SEAM(pb + 2);
        }
        if (IN(pb + 4)) {
            const Ctx P = fresh(F);
            pg8::Gemm g{Hb, (const bf16*)(args.ws + WS_WOUT) + (size_t)l * D * D, 2 * D}; pg8::RowScaleOrder S; S.init(T / 256, D / 256, F.G, (int)blockIdx.x, nullptr);
            S.ssp = (const float*)(args.ws + WS_SSP); S.rs = (LAS float*)(P.lds + pg8::RS_OFF); S.tid = P.tid;
            pg8::EpiOut<false> E{Xin, args.out, nullptr, D, 0, nullptr, nullptr};
            pg8::gemm_phase<pg8::EpiOut<false>, pg8::RowScaleOrder, true, true, 0, true>(P.lds, P.tid, g, S, E);
            SEAM(pb + 4);
        }
        if (IN(pb + 5)) REPEAT(REP_NORM) {
            const Ctx P = fresh(F);
            if (l == 0) { norm_phase<false, true>(P, args.out, inp(13) + (size_t)l * D, Hb, nullptr); }
            else norm_phase<true>(P, args.out, inp(13) + (size_t)l * D, Hb, inp(17));
            SEAM(pb + 5);
        }
        if (IN(pb + 6) && l == 1) REPEAT(REP_GATHER) { const Ctx P = fresh(F); moe_tables(P); gather_phase(P); SEAM(pb + 6); }
        if (IN(pb + 7)) REPEAT(REP_GGU) {
            const Ctx P = fresh(F);
            if (l == 0) {
                pg8::Gemm g{Hb, args.ws + WS_WGU_D, D}; pg8::GroupOrder S; S.init(T / 256, 2 * D_FF / 256, F.G, (int)blockIdx.x, nullptr);
                pg8::EpiSwiglu<true, true> E{HID, D_FF, (const float*)(args.ws + WS_SA), (const float*)(args.ws + WS_SW)};
                pg8::gemm_phase<pg8::EpiSwiglu<true, true>, pg8::GroupOrder, true, true, 2>(P.lds, P.tid, g, S, E);
            } else {
                if (!MK_ONE_LAUNCH || lo > pb + 6) moe_tables(P);
                pg8::Gemm g{args.ws + WS_PROJ, args.ws + WS_WGU_M, D}; pg8::GroupOrder S; S.init((int)P.lctl[LC_NMT], 2 * D_FF / 256, F.G, (int)blockIdx.x, (const LAS int*)(P.lctl + LC_TEXP));
                pg8::EpiSwiglu<true> E{HID, D_FF, nullptr, nullptr};
                pg8::gemm_phase<pg8::EpiSwiglu<true>, pg8::GroupOrder, true, true, 1>(P.lds, P.tid, g, S, E);
            }
            SEAM(pb + 7);
        }
        if (IN(pb + 8)) {
            const Ctx P = fresh(F);
            if (l == 0) {
                pg8::Gemm g{HID, args.ws + WS_WDN_D, D_FF}; pg8::GroupOrder S; S.init(T / 256, D / 256, F.G, (int)blockIdx.x, nullptr);
                pg8::EpiOut<false> E{args.out, args.out, nullptr, D, 0, nullptr, nullptr};
                pg8::gemm_phase<pg8::EpiOut<false>, pg8::GroupOrder, true, true, 1>(P.lds, P.tid, g, S, E);
            } else {
                if (!MK_ONE_LAUNCH || lo > pb + 6) moe_tables(P);
                static_assert((D_FF / 128 / 2) % 2 == 0, "half of K is a whole number of K-tile pairs");
                pg8::Gemm g{HID, args.ws + WS_WDN_M, D_FF}; pg8::SplitOrder S; S.init((int)P.lctl[LC_NMT], D / 256, F.G, (int)blockIdx.x, (const LAS int*)(P.lctl + LC_TEXP)); S.init2();
                pg8::EpiOut<false, true> E{nullptr, nullptr, PROJ, D, 1, nullptr, nullptr, (bf16*)(args.ws + WS_H)};
                pg8::gemm_phase<pg8::EpiOut<false, true>, pg8::SplitOrder, true, true, 1, false, true>(P.lds, P.tid, g, S, E);
            }
            SEAM(pb + 8);
        }
    }
    if (IN(19)) { const Ctx P = fresh(F); if (!MK_ONE_LAUNCH || lo > 16) moe_tables(P); final_phase(P, inp(21)); }
#undef IN
#undef SEAM
}

extern "C" void kernel_launch(void* const* d_in, const int* in_sizes, int n_in, void* d_out, int out_size, void* d_ws, size_t ws_size, hipStream_t stream) {
    static int grid = 0;
    if (grid == 0) {
        if (n_in != 22 || in_sizes[0] != T * D || out_size != T * D || ws_size < WS_END) { fprintf(stderr, "kernel_launch: unexpected shapes (n_in %d, in0 %d, out %d, ws %zu < %zu); nothing launched\n", n_in, n_in > 0 ? in_sizes[0] : -1, out_size, ws_size, (size_t)WS_END); grid = -1; return; }
        int dev = 0, cus = 0, per_cu = 0;
        if (hipGetDevice(&dev) != hipSuccess || hipDeviceGetAttribute(&cus, hipDeviceAttributeMultiprocessorCount, dev) != hipSuccess) { grid = -1; return; }
        if (hipFuncSetAttribute((const void*)fwd, hipFuncAttributeMaxDynamicSharedMemorySize, LDS_BYTES) != hipSuccess) { fprintf(stderr, "kernel_launch: hipFuncSetAttribute failed\n"); grid = -1; return; }
        if (hipOccupancyMaxActiveBlocksPerMultiprocessor(&per_cu, (const void*)fwd, 512, LDS_BYTES) != hipSuccess || per_cu < 1) fprintf(stderr, "kernel_launch: occupancy query reports %d\n", per_cu);
        (void)hipGetLastError();
        grid = cus < 256 ? cus : 256;
    }
    if (grid < 0) return;
    if (hipMemsetAsync((char*)d_ws + WS_CTL, 0, CTL_ZERO_BYTES, stream) != hipSuccess) return;
    Args a{};
    for (int i = 0; i < 22; ++i) a.in[i] = (const float*)d_in[i];
    a.out = (float*)d_out; a.ws = (unsigned char*)d_ws; a.pad = 0;
#if MK_ONE_LAUNCH
    a.ph_lo = 0; a.ph_hi = NPHASE; a.li = 0;
    hipLaunchKernelGGL(fwd, dim3(grid), dim3(512), LDS_BYTES, stream, a);
#else
    int li = 0;
    for (int p = 0; p < NPHASE; ++p) {
        if (p == 1 || p == 1 + 6 || p == 4 || p == 13) continue;
        a.ph_lo = p; a.ph_hi = p + 1; a.li = li++;
        hipLaunchKernelGGL(fwd, dim3(grid), dim3(512), LDS_BYTES, stream, a);
    }
#endif
}
```

```cpp
#include <hip/hip_runtime.h>
#include <cstdio>
#include <cstdint>

#ifndef MK_ONE_LAUNCH
#define MK_ONE_LAUNCH 1
#endif

#ifndef REP_P0
#define REP_P0 1
#endif
#ifndef REP_NORM
#define REP_NORM 1
#endif
#ifndef REP_GIN
#define REP_GIN 1
#endif
#ifndef REP_MIX
#define REP_MIX 1
#endif
#ifndef REP_YLRU
#define REP_YLRU 1
#endif
#ifndef REP_GATHER
#define REP_GATHER 1
#endif
#ifndef REP_GGU
#define REP_GGU 1
#endif
#ifndef REP_RET
#define REP_RET 1
#endif
#ifndef REP_LRU
#define REP_LRU 1
#endif
#define REPEAT(n) for (int rep_ = 0; rep_ < (n); ++rep_)
#ifndef GIN0_NC
#define GIN0_NC 20
#endif
#define LAS __attribute__((address_space(3)))
#define GAS __attribute__((address_space(1)))
typedef unsigned short bf16;
typedef short bf16x8 __attribute__((ext_vector_type(8)));
typedef float f32x4 __attribute__((ext_vector_type(4)));
typedef float f32x2 __attribute__((ext_vector_type(2)));
typedef unsigned u32x4 __attribute__((ext_vector_type(4)));
typedef unsigned u32x2 __attribute__((ext_vector_type(2)));

constexpr int BATCH = 8, SEQ = 2048, T = BATCH * SEQ, D = 2048, D_IN = 5120, D_RNN = 1024, NH = 8, DK = 64, DV = 128, D_FF = 5632, NE = 8;
constexpr int OFF_GATE = 1024, OFF_Q = 2048, OFF_K = 2560, OFF_V = 3072, OFF_G = 4096;
constexpr float EPS = 1e-6f;
constexpr int MAXMT = 136;
constexpr int MPAD = MAXMT * 256;

constexpr size_t MiB = 1u << 20;
constexpr size_t WS_CTL = 0, CTL_ZERO_BYTES = 1 * MiB;
constexpr size_t WS_ROPE = 1 * MiB;
constexpr size_t WS_WLRU = 2 * MiB;
constexpr size_t WS_SSP = 3 * MiB;
constexpr size_t WS_ROUTE = 4 * MiB;
constexpr size_t RT_TOPE = 0, RT_TOPG = 65536, RT_TOPR = 65536 * 3, RT_SLOT = 65536 * 5, RT_CNTB = 65536 * 7, RT_ROWOF = 65536 * 8;
constexpr size_t WS_SA = 5 * MiB;
constexpr size_t WS_SW = 6 * MiB;
constexpr size_t WS_WIN = 8 * MiB;
constexpr size_t WS_WOUT = 48 * MiB;
constexpr size_t WS_WGU_D = 64 * MiB;
constexpr size_t WS_WDN_D = 108 * MiB;
constexpr size_t WS_WGU_M = 130 * MiB;
constexpr size_t WS_WDN_M = 482 * MiB;
constexpr size_t WS_H = 658 * MiB;
constexpr size_t WS_PROJ = 722 * MiB;
constexpr size_t WS_HID = 882 * MiB;
constexpr size_t WS_END = 1256 * MiB;
static_assert(WS_WIN + (size_t)2 * D_IN * D * 2 <= WS_WOUT && WS_WOUT + (size_t)2 * D * D * 2 <= WS_WGU_D && WS_WGU_D + (size_t)2 * D_FF * D * 2 <= WS_WDN_D &&
              WS_WDN_D + (size_t)D * D_FF * 2 <= WS_WGU_M && WS_WGU_M + (size_t)NE * 2 * D_FF * D * 2 <= WS_WDN_M && WS_WDN_M + (size_t)NE * D * D_FF * 2 <= WS_H &&
              WS_H + (size_t)T * D * 2 <= WS_PROJ && WS_PROJ + (size_t)T * D_IN * 2 <= WS_HID && WS_PROJ + (size_t)MPAD * D * 2 <= WS_HID && WS_HID + (size_t)MPAD * D_FF * 2 <= WS_END, "d_ws map");
constexpr int CW_TMO = 0;
constexpr int CW_BAR = 4096;

constexpr int RING_BYTES = 131072;
constexpr int LDSCTL_OFF = 140 * 1024;
constexpr int LDS_BYTES = 147456;
constexpr int LC_BAR = 0, LC_TB = 16, LC_PRE = 32, LC_TOT = 40, LC_NMT = 48, LC_TEXP = 64, LC_SPLIT = 256;

#define RLX_AGENT __ATOMIC_RELAXED, __HIP_MEMORY_SCOPE_AGENT
__device__ __forceinline__ unsigned f2bf(float f) { unsigned u = __builtin_bit_cast(unsigned, f); return (u + 0x7fffu + ((u >> 16) & 1u)) >> 16; }
__device__ __forceinline__ unsigned pk2(float lo, float hi) { return f2bf(lo) | (f2bf(hi) << 16); }
__device__ __forceinline__ float bflo(unsigned w) { return __builtin_bit_cast(float, w << 16); }
__device__ __forceinline__ float bfhi(unsigned w) { return __builtin_bit_cast(float, w & 0xffff0000u); }
__device__ __forceinline__ float shfl_idx(float v, int src) { return __builtin_bit_cast(float, __builtin_amdgcn_ds_bpermute(src << 2, __builtin_bit_cast(int, v))); }
__device__ __forceinline__ float shfl_x(float v, int o, int lane) { return shfl_idx(v, lane ^ o); }
__device__ __forceinline__ unsigned shfl_u(unsigned v, int src) { return (unsigned)__builtin_amdgcn_ds_bpermute(src << 2, (int)v); }
__device__ __forceinline__ float wave_sum(float v, int lane) {
#pragma unroll
    for (int o = 1; o < 64; o <<= 1) v += shfl_x(v, o, lane);
    return v;
}
__device__ __forceinline__ float sigmoidf_(float x) { return __builtin_amdgcn_rcpf(1.0f + __expf(-x)); }
__device__ __forceinline__ int tile_off(int r, int c, int kc32) { const int ob = (r & 15) * 64 + (c & 31) * 2; return ((r >> 4) * kc32 + (c >> 5)) * 1024 + (ob ^ (((ob >> 9) & 1) << 5)); }
__device__ __forceinline__ bf16x8 lds_frag(LAS unsigned char* base, int off) { return *(const LAS bf16x8*)(base + off); }
#define MFMA16(a, b, c) __builtin_amdgcn_mfma_f32_16x16x32_bf16((a), (b), (c), 0, 0, 0)

namespace pg8 {
constexpr int BM = 256, BK = 64, HALF = 128, HTB = HALF * BK * 2, STAGE_BYTES = 8 * HTB, NXCD = 8, WGM = 8;
__host__ __device__ __forceinline__ int lds_byte(int r, int c) { const int st = (r >> 4) * 2 + (c >> 5), rr = r & 15, cc = c & 31, ob = rr * 64 + cc * 2; return st * 1024 + (ob ^ (((ob >> 9) & 1) << 5)); }
__host__ __device__ __forceinline__ void stage_rc(int b, int& R, int& C) { const int st = b / 1024, sb = b % 1024, swz = sb ^ (((sb >> 9) & 1) << 5); R = (st >> 1) * 16 + swz / 64; C = (st & 1) * 32 + (swz % 64) / 2; }
__host__ __device__ __forceinline__ int perm32(int rho) { const int n = rho >> 4, i = rho & 15; return 8 * (i >> 2) + 4 * n + (i & 3); }

struct Unit { int pm, pn, pb, kh; };
struct Gemm { const void* A; const void* Bt; int Kb; const unsigned* arow; };

struct GroupOrder {
    int nM, nN, nwg, G, c; const LAS int* texp;
    __device__ void init(int nM_, int nN_, int G_, int c_, const LAS int* texp_) { nM = nM_; nN = nN_; nwg = nM * nN; G = G_; c = c_; texp = texp_; }
    __device__ bool next(int i, Unit& u) const { return unit_at((long)i * G + c, u); }
    __device__ bool unit_at(long L, Unit& u) const {
        if (L >= nwg) return false;
        int wgid = (int)L; { const int q = nwg / NXCD, r = nwg % NXCD, xcd = wgid % NXCD, off = wgid / NXCD; wgid = (xcd < r ? xcd * (q + 1) : r * (q + 1) + (xcd - r) * q) + off; }
        const int nig = WGM * nN, gid = wgid / nig, fm = gid * WGM, gsz = (nM - fm) < WGM ? (nM - fm) : WGM;
        u.pm = fm + ((wgid % nig) % gsz); u.pn = (wgid % nig) / gsz;
        u.pb = (texp ? __builtin_amdgcn_readfirstlane(texp[u.pm]) : 0) * nN + u.pn; return true;
    }
    struct Pre {};
    __device__ __forceinline__ void a_issue(const Unit&, Pre&) const {}
    __device__ __forceinline__ void a_finish(const Unit&, int, const Pre&) const {}
    __device__ __forceinline__ void done(const Unit&) const {}
};
struct SplitOrder : GroupOrder {
    int R, rem;
    __device__ void init2() { R = nwg / G; rem = nwg - R * G; if (2 * rem > G) rem = 0; }
    __device__ bool next(int i, Unit& u) const {
        if (rem == 0 || i < R) { const bool ok = GroupOrder::next(i, u); u.kh = 0; return ok; }
        if (i > R || c >= 2 * rem) return false;
        const bool ok = unit_at((long)R * G + (c >> 1), u); u.kh = ((c >> 1) << 2) | (1 + (c & 1)); return ok;
    }
};
constexpr int RS_OFF = 131072;
struct RowScaleOrder : GroupOrder {
    const float* ssp; LAS float* rs; int tid;
    struct Pre { f32x4 a, b; };
    __device__ __forceinline__ void a_issue(const Unit& u, Pre& p) const {
        const int r = tid & 255, h = tid >> 8; const f32x4* q = (const f32x4*)(ssp + (size_t)(u.pm * BM + r) * 16 + h * 8);
        p.a = q[0]; p.b = q[1];
    }
    __device__ __forceinline__ void a_finish(const Unit&, int par, const Pre& p) const {
        const int r = tid & 255, h = tid >> 8; const f32x4 t4 = p.a + p.b;
        rs[(par * 2 + h) * 256 + r] = (t4[0] + t4[1]) + (t4[2] + t4[3]);
    }
};
__device__ __forceinline__ float rs_scale(const LAS float* rs, int par, int r, float inv) { return 1.0f / sqrtf((rs[(par * 2) * 256 + r] + rs[(par * 2 + 1) * 256 + r]) * inv + EPS); }

__device__ __forceinline__ unsigned cvt_pk_bf16(float lo, float hi) { unsigned r; asm volatile("v_cvt_pk_bf16_f32 %0, %1, %2" : "=v"(r) : "v"(lo), "v"(hi)); return r; }

template <bool INI8 = false, bool KS = false> struct EpiOut {
    static constexpr bool PERM = true;
    const float* base; float* C; bf16* O; int ldc; int mode; const float* SA; const float* SW;
    bf16* O2;
    __device__ __forceinline__ void operator()(const f32x4 (&acc)[2][2][4][2], const Unit& u, int wr, int wc, int fr, int fq) const {
        int row0 = u.pm * BM + wr * 64 + fr, col0 = u.pn * BM + wc * 32 + 8 * fq;
        if (mode == 1) {
            bf16* O = this->O; int ldc = this->ldc;
            if constexpr (KS) { if ((u.kh & 3) == 2) { O = O2 + (size_t)(u.kh >> 2) * (BM * BM); ldc = BM; row0 = wr * 64 + fr; col0 = wc * 32 + 8 * fq; } }
            float sw[2][8];
            if constexpr (INI8) {
#pragma unroll
                for (int bj = 0; bj < 2; ++bj)
#pragma unroll
                    for (int j = 0; j < 8; ++j) sw[bj][j] = SW[col0 + bj * HALF + j]; }
#pragma unroll
            for (int ai = 0; ai < 2; ++ai)
#pragma unroll
                for (int m = 0; m < 4; ++m) {
                    const size_t off = (size_t)(row0 + ai * HALF + m * 16) * ldc + col0;
                    float sa = 1.0f; if constexpr (INI8) sa = SA[row0 + ai * HALF + m * 16];
#pragma unroll
                    for (int bj = 0; bj < 2; ++bj) { float f[8];
#pragma unroll
                        for (int j = 0; j < 4; ++j) { const float a0 = acc[ai][bj][m][0][j], a1 = acc[ai][bj][m][1][j];
                            if constexpr (INI8) { f[j] = (float)__builtin_bit_cast(int, a0) * (sa * sw[bj][j]); f[4 + j] = (float)__builtin_bit_cast(int, a1) * (sa * sw[bj][4 + j]); }
                            else { f[j] = a0; f[4 + j] = a1; } }
                        u32x4 w; w.x = cvt_pk_bf16(f[0], f[1]); w.y = cvt_pk_bf16(f[2], f[3]); w.z = cvt_pk_bf16(f[4], f[5]); w.w = cvt_pk_bf16(f[6], f[7]);
                        *(u32x4*)(O + off + bj * HALF) = w; }
                }
        } else {
#pragma unroll
            for (int ai = 0; ai < 2; ++ai) {
                f32x4 bb[4][2][2];
#pragma unroll
                for (int m = 0; m < 4; ++m) { const size_t off = (size_t)(row0 + ai * HALF + m * 16) * ldc + col0;
#pragma unroll
                    for (int bj = 0; bj < 2; ++bj) { bb[m][bj][0] = *(const f32x4*)(base + off + bj * HALF); bb[m][bj][1] = *(const f32x4*)(base + off + bj * HALF + 4); } }
#pragma unroll
                for (int m = 0; m < 4; ++m) { const size_t off = (size_t)(row0 + ai * HALF + m * 16) * ldc + col0;
#pragma unroll
                    for (int bj = 0; bj < 2; ++bj) { *(f32x4*)(C + off + bj * HALF) = bb[m][bj][0] + acc[ai][bj][m][0]; *(f32x4*)(C + off + bj * HALF + 4) = bb[m][bj][1] + acc[ai][bj][m][1]; } }
                asm volatile("" ::: "memory");
            }
        }
    }
};
__device__ __forceinline__ float clamp448(float x) { return __builtin_amdgcn_fmed3f(x, -448.0f, 448.0f); }
__device__ __forceinline__ unsigned pk4_fp8(float a, float b, float c, float d) { unsigned w = 0; w = __builtin_amdgcn_cvt_pk_fp8_f32(clamp448(a), clamp448(b), w, false); w = __builtin_amdgcn_cvt_pk_fp8_f32(clamp448(c), clamp448(d), w, true); return w; }
template <bool OUT8, bool INI8 = false> struct EpiSwiglu {
    static constexpr bool PERM = true;
    void* O; int ldc; const float* SA; const float* SW;
    __device__ __forceinline__ void operator()(const f32x4 (&acc)[2][2][4][2], const Unit& u, int wr, int wc, int fr, int fq) const {
        const int row0 = u.pm * BM + wr * 64 + fr, col0 = u.pn * HALF + wc * 32 + 8 * fq;
        float swg[8], swu[8];
        if constexpr (INI8) {
#pragma unroll
            for (int j = 0; j < 8; ++j) { swg[j] = SW[col0 + j]; swu[j] = SW[ldc + col0 + j]; } }
#pragma unroll
        for (int ai = 0; ai < 2; ++ai)
#pragma unroll
            for (int m = 0; m < 4; ++m) {
                float h[8]; float sa = 1.0f; if constexpr (INI8) sa = SA[row0 + ai * HALF + m * 16];
#pragma unroll
                for (int n = 0; n < 2; ++n)
#pragma unroll
                    for (int j = 0; j < 4; ++j) { float g = acc[ai][0][m][n][j], up = acc[ai][1][m][n][j];
                        if constexpr (INI8) { g = (float)__builtin_bit_cast(int, g) * (sa * swg[4 * n + j]); up = (float)__builtin_bit_cast(int, up) * (sa * swu[4 * n + j]); } h[n * 4 + j] = g * __builtin_amdgcn_rcpf(1.0f + __builtin_amdgcn_exp2f(-1.44269504f * g)) * up; }
                if constexpr (OUT8) { *(u32x2*)((unsigned char*)O + (size_t)(row0 + ai * HALF + m * 16) * ldc + col0) = (u32x2){pk4_fp8(h[0], h[1], h[2], h[3]), pk4_fp8(h[4], h[5], h[6], h[7])}; }
                else { u32x4 w; w.x = cvt_pk_bf16(h[0], h[1]); w.y = cvt_pk_bf16(h[2], h[3]); w.z = cvt_pk_bf16(h[4], h[5]); w.w = cvt_pk_bf16(h[6], h[7]);
                    *(u32x4*)((bf16*)O + (size_t)(row0 + ai * HALF + m * 16) * ldc + col0) = w; }
            }
    }
};

typedef int i32x4 __attribute__((ext_vector_type(4)));
typedef int i32x8 __attribute__((ext_vector_type(8)));
template <class Epi, class Sched, bool ALIGN_EPI, bool SP2, int KIND  , bool MIDK = false, bool KSPLIT = false, bool GA = false>
__device__ __forceinline__ void gemm_phase(LAS unsigned char* lds, const int tid, const Gemm g, const Sched& S, const Epi& E) {
    const int wid = __builtin_amdgcn_readfirstlane(tid >> 6), lane = tid & 63, wr = wid >> 2, wc = wid & 3, fr = lane & 15, fq = lane >> 4;
    const int K = g.Kb, nt = K / 128;
    unsigned voffA[2], voffB[2];
#pragma unroll
    for (int i = 0; i < 2; ++i) { int R, C; stage_rc(tid * 16 + i * 8192, R, C); const int Rb = Epi::PERM ? ((R & ~31) + perm32(R & 31)) : R;
        voffA[i] = (unsigned)(R * K + C * 2); voffB[i] = (unsigned)(Rb * K + C * 2); }
    int rA0 = 0; unsigned colA = 0; { int R, C; stage_rc(tid * 16, R, C); rA0 = R; colA = (unsigned)(C * 2); }
    unsigned gofC[2][2], gofN[2][2], gofX[2][2]; (void)gofC; (void)gofN; (void)gofX; (void)rA0; (void)colA;
    LAS unsigned* atab = (LAS unsigned*)(lds + RS_OFF);
    const size_t kstep = (size_t)(BK * 2);
    const size_t hstep = (size_t)HALF * K;
    const size_t tstep = 2 * hstep;
    const unsigned ldsw = (unsigned)wid * 1024u;
    const int aoff = lds_byte(wr * 64 + fr, fq * 8), boff = lds_byte(wc * 32 + fr, fq * 8);
#define PG8_SA(b, h) (((b) * 2 + (h)) * HTB)
#define PG8_SB(b, h) ((4 + (b) * 2 + (h)) * HTB)
#define PG8_STAGE(bufoff, gbase, voff) do { _Pragma("unroll") for (int _i = 0; _i < 2; ++_i) \
        __builtin_amdgcn_global_load_lds((const unsigned*)((const char*)(gbase) + (voff)[_i]), (LAS unsigned*)(lds + (bufoff) + ldsw + _i * 8192), 16, 0, 0); } while (0)
#define PG8_STAGE_A(b, h, base, offs) do { if constexpr (GA) { PG8_STAGE(PG8_SA(b, h), (base), (offs)[h]); } else { PG8_STAGE(PG8_SA(b, h), (base) + (h) * hstep, voffA); } } while (0)
#define PG8_LDA(dst, b, h) do { _Pragma("unroll") for (int m = 0; m < 4; ++m) _Pragma("unroll") for (int k = 0; k < 2; ++k) dst[m][k] = *(const LAS bf16x8*)(lds + PG8_SA(b, h) + aoff + m * 2048 + k * 1024); } while (0)
#define PG8_LDB(dst, b, h) do { _Pragma("unroll") for (int n = 0; n < 2; ++n) _Pragma("unroll") for (int k = 0; k < 2; ++k) dst[n][k] = *(const LAS bf16x8*)(lds + PG8_SB(b, h) + boff + n * 2048 + k * 1024); } while (0)
#define PG8_CAT(x) __builtin_shufflevector(__builtin_bit_cast(i32x4, (x)[0]), __builtin_bit_cast(i32x4, (x)[1]), 0, 1, 2, 3, 4, 5, 6, 7)
#define PG8_MMA(ai, bj, At, Bt) do { __builtin_amdgcn_s_setprio(1); _Pragma("unroll") for (int m = 0; m < 4; ++m) _Pragma("unroll") for (int n = 0; n < 2; ++n) { \
        if constexpr (KIND == 1) { const i32x8 bw_ = PG8_CAT(Bt[n]), aw_ = PG8_CAT(At[m]); \
            asm volatile("v_mfma_scale_f32_16x16x128_f8f6f4 %0, %1, %2, %0, %3, %4 op_sel_hi:[0,0,0]" : "+v"(acc[ai][bj][m][n]) : "v"(bw_), "v"(aw_), "v"(sc_w), "v"(sc_a)); } \
        else if constexpr (KIND == 2) { _Pragma("unroll") for (int k = 0; k < 2; ++k) acc[ai][bj][m][n] = __builtin_bit_cast(f32x4, __builtin_amdgcn_mfma_i32_16x16x64_i8( \
            __builtin_bit_cast(i32x4, Bt[n][k]), __builtin_bit_cast(i32x4, At[m][k]), __builtin_bit_cast(i32x4, acc[ai][bj][m][n]), 0, 0, 0)); } \
        else { _Pragma("unroll") for (int k = 0; k < 2; ++k) acc[ai][bj][m][n] = __builtin_amdgcn_mfma_f32_16x16x32_bf16(Bt[n][k], At[m][k], acc[ai][bj][m][n], 0, 0, 0); } } \
        __builtin_amdgcn_s_setprio(0); } while (0)
#define PG8_WAIT_V(n) asm volatile("s_waitcnt vmcnt(" #n ")" ::: "memory")
#define PG8_WAIT_L(n) asm volatile("s_waitcnt lgkmcnt(" #n ")" ::: "memory")
#define PG8_BAR __builtin_amdgcn_s_barrier()
#define PG8_SCHED __builtin_amdgcn_sched_barrier(0)
    Unit cur, nxt; int ui = 0;
    if (!S.next(0, cur)) return;
    const int sc_w = 0x79797979, sc_a = 0x7f7f7f7f; (void)sc_w; (void)sc_a;
    f32x4 acc[2][2][4][2];
#pragma unroll
    for (int a = 0; a < 2; ++a)
#pragma unroll
        for (int b = 0; b < 2; ++b)
#pragma unroll
            for (int m = 0; m < 4; ++m)
#pragma unroll
                for (int n = 0; n < 2; ++n) acc[a][b][m][n] = (f32x4){0.f, 0.f, 0.f, 0.f};
    bf16x8 At[4][2], B0[2][2], B1[2][2];
    const char* cA = (const char*)g.A + (GA ? (size_t)0 : (size_t)cur.pm * tstep); const char* cB = (const char*)g.Bt + (size_t)cur.pb * tstep;
    if constexpr (GA) {
        static_assert(SP2 && !KSPLIT && !MIDK, "gathered A: SP2 schedule only");
#pragma unroll
        for (int h = 0; h < 2; ++h)
#pragma unroll
            for (int i = 0; i < 2; ++i) { gofC[h][i] = g.arow[cur.pm * BM + h * HALF + rA0 + 64 * i] * (unsigned)K + colA; gofN[h][i] = gofC[h][i]; }
    }
    if constexpr (KSPLIT) { if ((cur.kh & 3) == 2) { cA += (size_t)(nt / 2) * kstep; cB += (size_t)(nt / 2) * kstep; } }
    { typename Sched::Pre pre0; S.a_issue(cur, pre0); S.a_finish(cur, 0, pre0); }
    if constexpr (SP2) {
        PG8_STAGE(PG8_SB(0, 0), cB, voffB); PG8_STAGE(PG8_SB(0, 1), cB + hstep, voffB); PG8_STAGE_A(0, 0, cA, gofC); PG8_STAGE_A(0, 1, cA, gofC);
        if (wr == 1) PG8_BAR;
        PG8_WAIT_V(2); PG8_BAR;
        PG8_STAGE(PG8_SB(1, 0), cB + kstep, voffB); PG8_STAGE_A(1, 0, cA + kstep, gofC); PG8_STAGE(PG8_SB(1, 1), cB + hstep + kstep, voffB);
        PG8_WAIT_V(6); PG8_BAR;
    } else {
        PG8_STAGE(PG8_SB(0, 0), cB, voffB); PG8_STAGE(PG8_SA(0, 0), cA, voffA); PG8_STAGE(PG8_SB(0, 1), cB + hstep, voffB); PG8_STAGE(PG8_SA(0, 1), cA + hstep, voffA);
        if (wr == 1) PG8_BAR;
        PG8_WAIT_V(4); PG8_BAR;
        PG8_STAGE(PG8_SB(1, 0), cB + kstep, voffB); PG8_STAGE(PG8_SA(1, 0), cA + kstep, voffA); PG8_STAGE(PG8_SB(1, 1), cB + hstep + kstep, voffB);
        PG8_WAIT_V(6); PG8_BAR;
    }
    for (;;) {
        const bool has_next = S.next(ui + 1, nxt);
        const char* nA = (has_next && !GA) ? (const char*)g.A + (size_t)nxt.pm * tstep : cA; const char* nB = has_next ? (const char*)g.Bt + (size_t)nxt.pb * tstep : cB;
        if constexpr (GA) { if (has_next && wid == 0)
            __builtin_amdgcn_global_load_lds(g.arow + (size_t)nxt.pm * BM + lane * 4, atab + ((ui + 1) & 1) * BM, 16, 0, 0); }
        int unt = nt;
        if constexpr (KSPLIT) { if (has_next && (nxt.kh & 3) == 2) { nA += (size_t)(nt / 2) * kstep; nB += (size_t)(nt / 2) * kstep; } if (cur.kh & 3) unt = nt / 2; }
        for (int t = 0; t < unt; t += 2) {
            const bool last = (t == unt - 2);
            const char* a1 = cA + (size_t)(t + 1) * kstep;
            const char* a2 = last ? nA : cA + (size_t)(t + 2) * kstep; const char* b2 = last ? nB : cB + (size_t)(t + 2) * kstep;
            const char* a3 = a2 + kstep; const char* b3 = b2 + kstep;
            if constexpr (GA) {
                if (t == 2 && has_next) {
#pragma unroll
                    for (int h = 0; h < 2; ++h)
#pragma unroll
                        for (int i = 0; i < 2; ++i) gofN[h][i] = atab[((ui + 1) & 1) * BM + h * HALF + rA0 + 64 * i] * (unsigned)K + colA; }
#pragma unroll
                for (int h = 0; h < 2; ++h)
#pragma unroll
                    for (int i = 0; i < 2; ++i) gofX[h][i] = last ? gofN[h][i] : gofC[h][i];
            }
            if constexpr (MIDK) { if (t == nt / 2) {
                const LAS float* rs = (const LAS float*)(lds + RS_OFF);
#pragma unroll
                for (int ai = 0; ai < 2; ++ai)
#pragma unroll
                    for (int m = 0; m < 4; ++m) { const float sc = rs_scale(rs, ui & 1, ai * HALF + wr * 64 + m * 16 + fr, 1.0f / D_RNN);
#pragma unroll
                        for (int bj = 0; bj < 2; ++bj)
#pragma unroll
                            for (int n = 0; n < 2; ++n) acc[ai][bj][m][n] = acc[ai][bj][m][n] * sc; } } }
            if constexpr (SP2) {
            PG8_LDB(B0, 0, 0); PG8_LDB(B1, 0, 1); PG8_SCHED; PG8_LDA(At, 0, 0); PG8_STAGE_A(1, 1, a1, gofC);
            PG8_WAIT_V(8); PG8_WAIT_L(0); PG8_BAR; PG8_MMA(0, 0, At, B0); PG8_MMA(0, 1, At, B1); PG8_BAR; PG8_SCHED;
            PG8_LDA(At, 0, 1); PG8_STAGE(PG8_SB(0, 0), b2, voffB); PG8_STAGE(PG8_SB(0, 1), b2 + hstep, voffB); PG8_STAGE_A(0, 0, a2, gofX);
            PG8_WAIT_V(8); PG8_WAIT_L(0); PG8_BAR; PG8_MMA(1, 0, At, B0); PG8_MMA(1, 1, At, B1); PG8_BAR; PG8_SCHED;
            PG8_LDB(B0, 1, 0); PG8_LDB(B1, 1, 1); PG8_SCHED; PG8_LDA(At, 1, 0); PG8_STAGE_A(0, 1, a2, gofX);
            PG8_WAIT_V(8); PG8_WAIT_L(0); PG8_BAR; PG8_MMA(0, 0, At, B0); PG8_MMA(0, 1, At, B1); PG8_BAR; PG8_SCHED;
            PG8_LDA(At, 1, 1); PG8_STAGE(PG8_SB(1, 0), b3, voffB); PG8_STAGE(PG8_SB(1, 1), b3 + hstep, voffB); PG8_STAGE_A(1, 0, a3, gofX);
            PG8_WAIT_V(8); PG8_WAIT_L(0); PG8_BAR; PG8_MMA(1, 0, At, B0); PG8_MMA(1, 1, At, B1); PG8_BAR; PG8_SCHED;
            } else {
            PG8_LDB(B0, 0, 0); PG8_SCHED; PG8_LDA(At, 0, 0); PG8_STAGE(PG8_SA(1, 1), a1 + hstep, voffA);
            PG8_WAIT_L(8); PG8_BAR; PG8_WAIT_L(0); PG8_MMA(0, 0, At, B0); PG8_BAR; PG8_SCHED;
            PG8_LDB(B1, 0, 1); PG8_STAGE(PG8_SB(0, 0), b2, voffB);
            PG8_BAR; PG8_WAIT_L(0); PG8_MMA(0, 1, At, B1); PG8_BAR;
            PG8_LDA(At, 0, 1); PG8_STAGE(PG8_SA(0, 0), a2, voffA);
            PG8_BAR; PG8_WAIT_L(0); PG8_MMA(1, 0, At, B0); PG8_BAR; PG8_SCHED;
            PG8_STAGE(PG8_SB(0, 1), b2 + hstep, voffB);
            PG8_WAIT_V(6); PG8_BAR; PG8_MMA(1, 1, At, B1); PG8_BAR;
            PG8_LDB(B0, 1, 0); PG8_SCHED; PG8_LDA(At, 1, 0); PG8_STAGE(PG8_SA(0, 1), a2 + hstep, voffA);
            PG8_WAIT_L(8); PG8_BAR; PG8_WAIT_L(0); PG8_MMA(0, 0, At, B0); PG8_BAR; PG8_SCHED;
            PG8_LDB(B1, 1, 1); PG8_STAGE(PG8_SB(1, 0), b3, voffB);
            PG8_BAR; PG8_WAIT_L(0); PG8_MMA(0, 1, At, B1); PG8_BAR;
            PG8_LDA(At, 1, 1); PG8_STAGE(PG8_SA(1, 0), a3, voffA);
            PG8_BAR; PG8_WAIT_L(0); PG8_MMA(1, 0, At, B0); PG8_BAR; PG8_SCHED;
            PG8_STAGE(PG8_SB(1, 1), b3 + hstep, voffB);
            PG8_WAIT_V(6); PG8_BAR; PG8_MMA(1, 1, At, B1); PG8_BAR;
            }
        }
        if constexpr (ALIGN_EPI) { if (wr == 0) PG8_BAR; }
        if constexpr (KIND == 1) asm volatile("s_nop 15\n\ts_nop 15" ::: "memory");
        typename Sched::Pre pre; if (has_next) S.a_issue(nxt, pre);
        E(acc, cur, wr, wc, fr, fq); S.done(cur);
        if (has_next) S.a_finish(nxt, (ui + 1) & 1, pre);
        if (!has_next) break;
#pragma unroll
        for (int a = 0; a < 2; ++a)
#pragma unroll
            for (int b = 0; b < 2; ++b)
#pragma unroll
                for (int m = 0; m < 4; ++m)
#pragma unroll
                    for (int n = 0; n < 2; ++n) acc[a][b][m][n] = (f32x4){0.f, 0.f, 0.f, 0.f};
        cur = nxt; cA = nA; cB = nB; ++ui;
        if constexpr (GA) {
#pragma unroll
            for (int h = 0; h < 2; ++h)
#pragma unroll
                for (int i = 0; i < 2; ++i) gofC[h][i] = gofN[h][i]; }
        if constexpr (ALIGN_EPI) { if (wr == 1) PG8_BAR; }
    }
    PG8_WAIT_V(0);
    if constexpr (!ALIGN_EPI) { if (wr == 0) PG8_BAR; }
    PG8_BAR;
#undef PG8_SA
#undef PG8_SB
#undef PG8_STAGE
#undef PG8_LDA
#undef PG8_STAGE_A
#undef PG8_LDB
#undef PG8_MMA
#undef PG8_CAT
#undef PG8_WAIT_V
#undef PG8_WAIT_L
#undef PG8_BAR
#undef PG8_SCHED
}
}

#define XB_TMO      128
#define XB_XCNT(j)  (256  + 64 * (j))
#define XB_XSUB(j)  (1280 + 64 * (j))
#define XB_XGEN(j)  (2304 + 64 * (j))
#define XB_TOP      3328
#define XB_TOPGEN   3392
#define XCD_BAR_WORDS 3456
#define XB_SPIN_CAP (1u << 18)
__device__ __forceinline__ unsigned xb_ld(unsigned* p)              { return __hip_atomic_load(p, __ATOMIC_RELAXED, __HIP_MEMORY_SCOPE_AGENT); }
__device__ __forceinline__ unsigned xb_add(unsigned* p, unsigned v) { return __hip_atomic_fetch_add(p, v, __ATOMIC_RELAXED, __HIP_MEMORY_SCOPE_AGENT); }
__device__ __forceinline__ unsigned xb_xcc_id() { return (unsigned)__builtin_amdgcn_s_getreg((3 << 11) | 20) & 0xFu; }
#define XB_SPIN(cond, bar) do { unsigned _sp = 0; while (cond) { __builtin_amdgcn_s_sleep(1); \
    if ((++_sp & 255u) == 0u) { if (xb_ld(&(bar)[XB_TMO])) break; if (_sp > XB_SPIN_CAP) { atomicAdd(&(bar)[XB_TMO], 1u); break; } } } } while (0)
struct XcdBarrier { unsigned* bar; unsigned x; volatile LAS unsigned* st; };
__device__ __forceinline__ XcdBarrier xcd_barrier_post(unsigned* bar, volatile LAS unsigned* st) {
    XcdBarrier b; b.bar = bar; b.x = xb_xcc_id(); b.st = st;
    if (threadIdx.x == 0) (void)xb_add(&bar[XB_XCNT(b.x)], 1u);
    return b;
}
__device__ __forceinline__ void xcd_barrier_complete(unsigned* bar, unsigned x, unsigned& nloc, unsigned& nx) {
    const unsigned G = gridDim.x * gridDim.y * gridDim.z;
    unsigned sum, cnt, mine, sp = 0u;
    for (;;) {
        sum = 0u; cnt = 0u; mine = 0u;
#pragma unroll
        for (unsigned j = 0; j < 16; ++j) { const unsigned c = xb_ld(&bar[XB_XCNT(j)]); sum += c; cnt += (c > 0u) ? 1u : 0u; mine = (j == x) ? c : mine; }
        if (sum == G) break;
        __builtin_amdgcn_s_sleep(1);
        if ((++sp & 255u) == 0u) { if (xb_ld(&bar[XB_TMO])) break; if (sp > XB_SPIN_CAP) { atomicAdd(&bar[XB_TMO], 1u); break; } }
    }
    nloc = mine > 0u ? mine : 1u; nx = cnt > 0u ? cnt : 1u;
}
__device__ __forceinline__ void xcd_barrier(const XcdBarrier& b) {
    asm volatile("s_waitcnt vmcnt(0)" ::: "memory");
    __syncthreads();
    if (threadIdx.x == 0) {
        unsigned* bar = b.bar;
        __builtin_amdgcn_s_waitcnt(0);
        unsigned nloc = b.st[0], nx = b.st[1];
        if (nloc == 0u) { xcd_barrier_complete(bar, b.x, nloc, nx); b.st[0] = nloc; b.st[1] = nx; }
        const unsigned old = xb_add(&bar[XB_XSUB(b.x)], 1u);
        const unsigned gen = old / nloc;
        if (old + 1u == (gen + 1u) * nloc) {
            __builtin_amdgcn_fence(__ATOMIC_RELEASE, "agent");
            asm volatile("s_waitcnt vmcnt(0)" ::: "memory");
            const unsigned og = xb_add(&bar[XB_TOP], 1u);
            const unsigned tg = og / nx;
            if (og + 1u == (tg + 1u) * nx) xb_add(&bar[XB_TOPGEN], 1u);
            else XB_SPIN(xb_ld(&bar[XB_TOPGEN]) == tg, bar);
            __builtin_amdgcn_fence(__ATOMIC_ACQUIRE, "agent");
            xb_add(&bar[XB_XGEN(b.x)], 1u);
            asm volatile("s_waitcnt vmcnt(0)" ::: "memory");
        } else {
            XB_SPIN(xb_ld(&bar[XB_XGEN(b.x)]) == gen, bar);
            __builtin_amdgcn_fence(__ATOMIC_ACQUIRE, "agent");
            asm volatile("s_waitcnt vmcnt(0)" ::: "memory");
        }
    }
    __syncthreads();
}

__device__ __forceinline__ void p0_transpose_item(const float* W, int K, int N, bf16* WT, int kb, int nb, int drow0, LAS float* scr, int lane) {
    const int k0 = 64 * kb, n0 = 32 * nb;
#pragma unroll 8
    for (int i = 0; i < 32; ++i) { const int kk = 2 * i + (lane >> 5); scr[kk * 33 + (lane & 31)] = W[(size_t)(k0 + kk) * N + n0 + (lane & 31)]; }
    asm volatile("s_waitcnt lgkmcnt(0)" ::: "memory");
    const int c = lane & 7;
#pragma unroll
    for (int j = 0; j < 4; ++j) { const int n = (lane >> 3) + 8 * j; const LAS float* s = scr + (8 * c) * 33 + n;
        u32x4 o; o.x = pk2(s[0 * 33], s[1 * 33]); o.y = pk2(s[2 * 33], s[3 * 33]); o.z = pk2(s[4 * 33], s[5 * 33]); o.w = pk2(s[6 * 33], s[7 * 33]);
        *(u32x4*)(WT + (size_t)(drow0 + n) * K + k0 + 8 * c) = o; }
    asm volatile("s_waitcnt lgkmcnt(0)" ::: "memory");
}

__device__ __forceinline__ void p0_transpose_item_fp8(const float* W, int K, int N, unsigned char* WT, int kb, int nb, int drow0, LAS float* scr, int lane) {
    const int k0 = 64 * kb, n0 = 32 * nb;
#pragma unroll 8
    for (int i = 0; i < 32; ++i) { const int kk = 2 * i + (lane >> 5); scr[kk * 33 + (lane & 31)] = W[(size_t)(k0 + kk) * N + n0 + (lane & 31)]; }
    asm volatile("s_waitcnt lgkmcnt(0)" ::: "memory");
    const int c = lane & 3;
#pragma unroll
    for (int j = 0; j < 2; ++j) { const int n = (lane >> 2) + 16 * j; const LAS float* s = scr + (16 * c) * 33 + n;
        u32x4 o; o.x = pg8::pk4_fp8(64.f * s[0 * 33], 64.f * s[1 * 33], 64.f * s[2 * 33], 64.f * s[3 * 33]); o.y = pg8::pk4_fp8(64.f * s[4 * 33], 64.f * s[5 * 33], 64.f * s[6 * 33], 64.f * s[7 * 33]);
        o.z = pg8::pk4_fp8(64.f * s[8 * 33], 64.f * s[9 * 33], 64.f * s[10 * 33], 64.f * s[11 * 33]); o.w = pg8::pk4_fp8(64.f * s[12 * 33], 64.f * s[13 * 33], 64.f * s[14 * 33], 64.f * s[15 * 33]);
        *(u32x4*)(WT + (size_t)(drow0 + n) * K + k0 + 16 * c) = o; }
    asm volatile("s_waitcnt lgkmcnt(0)" ::: "memory");
}

__device__ __forceinline__ const float* inp(int i) {
    int off = i * 8; asm volatile("" : "+s"(off));
    const __attribute__((address_space(4))) char* ka = (const __attribute__((address_space(4))) char*)__builtin_amdgcn_kernarg_segment_ptr();
    return *(const float* const __attribute__((address_space(4)))*)(ka + off);
}

struct Ctx {
    LAS unsigned char* lds; LAS unsigned* lctl;
    int tid, lane, wave, vcu, G;
    float* out; unsigned char* ws;
};

__device__ __forceinline__ Ctx fresh(const Ctx& F) { Ctx R = F; int ln, wv = F.wave; asm volatile("v_mbcnt_lo_u32_b32 %0, -1, 0\n\tv_mbcnt_hi_u32_b32 %0, -1, %0" : "=v"(ln)); asm volatile("" : "+s"(wv));
    R.lane = ln; R.wave = wv; R.tid = wv * 64 + ln; return R; }

constexpr int I_IN = (D / 64) * (D_IN / 64), I_OUT = (D / 64) * (D / 64), I_GU = (D / 64) * (D_FF / 64), I_DN = (D_FF / 64) * (D / 64), I_LRU = 2 * 2;
constexpr int E0 = 2 * I_IN, E1 = E0 + 2 * I_OUT, E2 = E1 + I_GU, E3 = E2 + I_GU, E4 = E3 + I_DN, E5 = E4 + NE * I_GU, E6 = E5 + NE * I_GU, E7 = E6 + NE * I_DN, E8 = E7 + 32 * I_LRU;
struct CvDesc { const f32x4* src; unsigned char* dst; int N4, K, fp8; };
__device__ __forceinline__ CvDesc cv_desc(const Ctx& F, const float* const* in, int it) {
    const int n4 = F.lane & 15, kq = F.lane >> 4;
    const float* W; unsigned char* WT; int K, N, kb, nb, gu = 0, fp8 = 0;
    if (it < E0) { const int l = it / I_IN, r = it % I_IN, nblk = D_IN / 64; kb = r / nblk; nb = r % nblk; W = inp(2) + (size_t)l * D * D_IN; K = D; N = D_IN; WT = F.ws + WS_WIN + (size_t)l * D_IN * D * 2; }
    else if (it < E1) { const int q = it - E0, l = q / I_OUT, r = q % I_OUT, nblk = D / 64; kb = r / nblk; nb = r % nblk; W = inp(12) + (size_t)l * D * D; K = D; N = D; WT = F.ws + WS_WOUT + (size_t)l * D * D * 2; }
    else if (it < E3) { const int q = it - E1, up = q / I_GU, r = q % I_GU, nblk = D_FF / 64; kb = r / nblk; nb = r % nblk; W = up ? inp(15) : inp(14); K = D; N = D_FF; WT = F.ws + WS_WGU_D; gu = 1 + up; }
    else if (it < E4) { const int r = it - E3, nblk = D / 32; kb = r / nblk; nb = r % nblk; W = inp(16); K = D_FF; N = D; WT = F.ws + WS_WDN_D; fp8 = 1; }
    else if (it < E6) { const int q = it - E4, up = q / (NE * I_GU), q2 = q % (NE * I_GU), e = q2 / I_GU, r = q2 % I_GU, nblk = D_FF / 32; kb = r / nblk; nb = r % nblk;
        W = (up ? inp(19) : inp(18)) + (size_t)e * D * D_FF; K = D; N = D_FF; WT = F.ws + WS_WGU_M + (size_t)e * 2 * D_FF * D; gu = 1 + up; fp8 = 1; }
    else if (it < E7) { const int q = it - E6, e = q / I_DN, r = q % I_DN, nblk = D / 32; kb = r / nblk; nb = r % nblk; W = inp(20) + (size_t)e * D_FF * D; K = D_FF; N = D; WT = F.ws + WS_WDN_M + (size_t)e * D * D_FF; fp8 = 1; }
    else { const int q = it - E7, mi = q / I_LRU, r = q % I_LRU; kb = r / 2; nb = r % 2;
        const int mat = (mi / 8) & 1, n = mi & 7, l = mi / 16; W = (mat ? inp(7) : inp(5)) + (size_t)(l * 8 + n) * 16384; K = 128; N = 128; WT = F.ws + WS_WLRU + (size_t)mi * 16384 * 2; }
    const int k0 = fp8 ? 128 * kb + 16 * (F.lane >> 3) : 64 * kb + 16 * kq, nn = fp8 ? 32 * nb + 4 * (F.lane & 7) : 64 * nb + 4 * n4;
    const int drow = gu ? ((nn >> 7) * 256 + (nn & 127) + (gu - 1) * 128) : nn;
    CvDesc d; d.src = (const f32x4*)(W + (size_t)k0 * N + nn); d.N4 = N / 4; d.K = K; d.fp8 = fp8; d.dst = WT + ((size_t)drow * K + k0) * (fp8 ? 1 : 2); return d;
}
__device__ __forceinline__ void cv_load(const CvDesc& d, f32x4 (&x)[16]) {
#pragma unroll
    for (int j = 0; j < 16; ++j) x[j] = d.src[(size_t)j * d.N4];
}
__device__ __forceinline__ void cv_store(const CvDesc& d, const f32x4 (&x)[16]) {
    if (d.fp8) {
#pragma unroll
        for (int c = 0; c < 4; ++c) { u32x4 o;
            o.x = pg8::pk4_fp8(64.f * x[0][c], 64.f * x[1][c], 64.f * x[2][c], 64.f * x[3][c]); o.y = pg8::pk4_fp8(64.f * x[4][c], 64.f * x[5][c], 64.f * x[6][c], 64.f * x[7][c]);
            o.z = pg8::pk4_fp8(64.f * x[8][c], 64.f * x[9][c], 64.f * x[10][c], 64.f * x[11][c]); o.w = pg8::pk4_fp8(64.f * x[12][c], 64.f * x[13][c], 64.f * x[14][c], 64.f * x[15][c]);
            *(u32x4*)(d.dst + (size_t)c * d.K) = o; }
    } else {
#pragma unroll
        for (int c = 0; c < 4; ++c) { u32x4 o0, o1;
            o0.x = pk2(x[0][c], x[1][c]); o0.y = pk2(x[2][c], x[3][c]); o0.z = pk2(x[4][c], x[5][c]); o0.w = pk2(x[6][c], x[7][c]);
            o1.x = pk2(x[8][c], x[9][c]); o1.y = pk2(x[10][c], x[11][c]); o1.z = pk2(x[12][c], x[13][c]); o1.w = pk2(x[14][c], x[15][c]);
            u32x4* dst = (u32x4*)(d.dst + (size_t)c * d.K * 2); dst[0] = o0; dst[1] = o1; }
    }
}
__device__ __forceinline__ void convert_items(const Ctx& F, const float* const* in, int lo, int hi, int w0, int nw) {
    int it = lo + w0; if (it >= hi) return;
    CvDesc cur = cv_desc(F, in, it); f32x4 x[16]; cv_load(cur, x);
    for (;;) {
        const int nx = it + nw; const bool more = nx < hi;
        CvDesc nxt = cur; f32x4 y[16];
        if (more) { nxt = cv_desc(F, in, nx); cv_load(nxt, y); }
        cv_store(cur, x);
        if (!more) break;
#pragma unroll
        for (int j = 0; j < 16; ++j) x[j] = y[j];
        cur = nxt; it = nx;
    }
}
__device__ __forceinline__ void w_quant_item(const Ctx& F, const float* W, int N, int nb, float* SW, unsigned char* WT, int gu) {
    const int n4 = F.lane & 7, nn = 32 * nb + 4 * n4, k0 = 256 * F.wave + 32 * (F.lane >> 3);
    const f32x4* src = (const f32x4*)(W + (size_t)k0 * N + nn);
    f32x4 x[32];
#pragma unroll
    for (int j = 0; j < 32; ++j) x[j] = src[(size_t)j * (N / 4)];
    f32x4 mx = (f32x4){0.f, 0.f, 0.f, 0.f};
#pragma unroll
    for (int j = 0; j < 32; ++j) mx = __builtin_elementwise_max(mx, __builtin_elementwise_abs(x[j]));
#pragma unroll
    for (int c = 0; c < 4; ++c) { float v = mx[c]; v = fmaxf(v, shfl_idx(v, F.lane ^ 8)); v = fmaxf(v, shfl_idx(v, F.lane ^ 16)); v = fmaxf(v, shfl_idx(v, F.lane ^ 32)); mx[c] = v; }
    LAS f32x4* cmx = (LAS f32x4*)F.lds;
    if ((F.lane >> 3) == 0) cmx[F.wave * 8 + n4] = mx;
    __syncthreads();
    f32x4 m = cmx[n4];
#pragma unroll
    for (int w = 1; w < 8; ++w) m = __builtin_elementwise_max(m, cmx[w * 8 + n4]);
    __syncthreads();
    const int drow = gu ? ((nn >> 7) * 256 + (nn & 127) + (gu - 1) * 128) : nn;
#pragma unroll
    for (int c = 0; c < 4; ++c) { const float cm = fmaxf(m[c], 1e-30f), inv = 127.0f / cm; unsigned w[8];
#pragma unroll
        for (int q = 0; q < 8; ++q) { unsigned pk = 0;
#pragma unroll
            for (int b = 0; b < 4; ++b) { const int v = (int)rintf(x[4 * q + b][c] * inv); pk |= ((unsigned)v & 0xffu) << (8 * b); }
            w[q] = pk; }
        u32x4* dst = (u32x4*)(WT + (size_t)(drow + c) * D + k0);
        dst[0] = (u32x4){w[0], w[1], w[2], w[3]}; dst[1] = (u32x4){w[4], w[5], w[6], w[7]};
        if (F.wave == 0 && (F.lane >> 3) == 0) SW[nn + c] = cm * (1.0f / 127.0f); }
}
constexpr int QI_GU = D_FF / 32, QI_IN = D_IN / 32, QI_ALL = 2 * QI_GU + 2 * QI_IN;
__device__ __forceinline__ void i8_quantize_items(const Ctx& F, int first, int count, int c, int G) {
    float* SW = (float*)(F.ws + WS_SW);
    for (int it = first + c; it < first + count; it += G) {
        if (it < 2 * QI_GU) { const int up = it >= QI_GU, nb = it - up * QI_GU; w_quant_item(F, up ? inp(15) : inp(14), D_FF, nb, SW + up * D_FF, F.ws + WS_WGU_D, 1 + up); }
        else { const int q = it - 2 * QI_GU, l = q >= QI_IN, nb = q - l * QI_IN; w_quant_item(F, inp(2) + (size_t)l * D * D_IN, D_IN, nb, SW + 2 * D_FF + l * D_IN, F.ws + WS_WIN + (size_t)l * D_IN * D, 0); }
    }
}
__device__ __forceinline__ void p0_convert(const Ctx& F, const float* const* in, int c, int G) {
    i8_quantize_items(F, 0, 2 * QI_GU, c, G); i8_quantize_items(F, 2 * QI_GU + QI_IN, QI_IN, c, G);
    const int gw = c * 8 + F.wave, NGW = G * 8;
    convert_items(F, in, E0, E1, gw, NGW); convert_items(F, in, E3, E8, gw, NGW);
}
__device__ __forceinline__ void p0_prologue(const Ctx& F) {
    i8_quantize_items(F, 2 * QI_GU, QI_IN, F.vcu, F.G);
    f32x2* ROPE = (f32x2*)(F.ws + WS_ROPE);
    for (int i = (F.vcu * 512 + F.tid); i < SEQ * 32; i += F.G * 512) {
        const int s = i >> 5, j = i & 31;
        const float invf = exp2f(-(float)j * (13.287712379549449f / 32.0f));
        const float ang = (float)s * invf;
        const float nrev = rintf(ang * 0.15915494309189535f);
        float r = fmaf(-nrev, 6.28125f, ang); r = fmaf(-nrev, 0.0019353071795864769f, r);
        ROPE[i] = (f32x2){cosf(r), sinf(r)};
    }
}

template <bool ROUTE, bool OUTI8 = false>
__device__ __forceinline__ void norm_phase(const Ctx& F, const float* X, const float* gain, bf16* H, const float* router) {
    const int gw = F.vcu * 8 + F.wave, NGW = F.G * 8;
    f32x4 gv[8];
#pragma unroll
    for (int j = 0; j < 8; ++j) gv[j] = ((const f32x4*)gain)[F.lane + 64 * j];
    LAS float* RT = (LAS float*)F.lds;
    LAS unsigned* lst = (LAS unsigned*)(F.lds + 65536);
    unsigned* TOPE = (unsigned*)(F.ws + WS_ROUTE + RT_TOPE); float* TOPG = (float*)(F.ws + WS_ROUTE + RT_TOPG);
    unsigned* TOPR = (unsigned*)(F.ws + WS_ROUTE + RT_TOPR); unsigned* CNTB = (unsigned*)(F.ws + WS_ROUTE + RT_CNTB);
    if (ROUTE) {
        for (int i = F.tid; i < D * NE; i += 512) { const int c = i >> 3, e = i & 7; RT[e * D + c] = router[i]; }
        __syncthreads();
    }
    int it = 0;
    f32x4 v[8];
    if (gw < T) { const f32x4* xr = (const f32x4*)(X + (size_t)gw * D) + F.lane;
#pragma unroll
        for (int j = 0; j < 8; ++j) v[j] = xr[64 * j]; }
    for (int m = gw; m < T; m += NGW, ++it) {
        f32x4 vn[8];
        if (m + NGW < T) { const f32x4* xr = (const f32x4*)(X + (size_t)(m + NGW) * D) + F.lane;
#pragma unroll
            for (int j = 0; j < 8; ++j) vn[j] = xr[64 * j]; }
        else {
#pragma unroll
            for (int j = 0; j < 8; ++j) vn[j] = v[j]; }
        float ss = 0.f;
#pragma unroll
        for (int j = 0; j < 8; ++j) ss += (v[j].x * v[j].x + v[j].y * v[j].y) + (v[j].z * v[j].z + v[j].w * v[j].w);
        ss = wave_sum(ss, F.lane);
        const float rstd = 1.0f / sqrtf(ss * (1.0f / D) + EPS);
        if (OUTI8) {
            float mx = 0.f;
#pragma unroll
            for (int j = 0; j < 8; ++j) { v[j] = v[j] * rstd * gv[j]; mx = fmaxf(mx, fmaxf(fmaxf(fabsf(v[j].x), fabsf(v[j].y)), fmaxf(fabsf(v[j].z), fabsf(v[j].w)))); }
#pragma unroll
            for (int o = 1; o < 64; o <<= 1) mx = fmaxf(mx, shfl_x(mx, o, F.lane));
            mx = fmaxf(mx, 1e-30f); const float inv = 127.0f / mx;
            if (F.lane == 0) ((float*)(F.ws + WS_SA))[m] = mx * (1.0f / 127.0f);
            unsigned* o4 = (unsigned*)((unsigned char*)H + (size_t)m * D) + F.lane;
#pragma unroll
            for (int j = 0; j < 8; ++j) { const int a = (int)rintf(v[j].x * inv), b2 = (int)rintf(v[j].y * inv), c = (int)rintf(v[j].z * inv), d = (int)rintf(v[j].w * inv);
                o4[64 * j] = ((unsigned)a & 0xffu) | (((unsigned)b2 & 0xffu) << 8) | (((unsigned)c & 0xffu) << 16) | (((unsigned)d & 0xffu) << 24); }
        } else if (ROUTE) {
            unsigned* o4 = (unsigned*)((unsigned char*)H + (size_t)m * D) + F.lane;
#pragma unroll
            for (int j = 0; j < 8; ++j) { v[j] = v[j] * rstd * gv[j]; o4[64 * j] = pg8::pk4_fp8(v[j].x, v[j].y, v[j].z, v[j].w); }
        } else {
            u32x2* o8 = (u32x2*)(H + (size_t)m * D) + F.lane;
#pragma unroll
            for (int j = 0; j < 8; ++j) { v[j] = v[j] * rstd * gv[j]; o8[64 * j] = (u32x2){pk2(v[j].x, v[j].y), pk2(v[j].z, v[j].w)}; }
        }
        if (ROUTE) {
            float lg[8];
#pragma unroll
            for (int e = 0; e < 8; ++e) { float a = 0.f;
#pragma unroll
                for (int j = 0; j < 8; ++j) { const f32x4 r = ((const LAS f32x4*)(RT + e * D))[F.lane + 64 * j]; a += (v[j].x * r.x + v[j].y * r.y) + (v[j].z * r.z + v[j].w * r.w); }
                lg[e] = wave_sum(a, F.lane); }
            float v1 = -3.0e38f, v2 = -3.0e38f; int e1 = 0, e2 = 0;
#pragma unroll
            for (int e = 0; e < 8; ++e) { const float x = lg[e]; if (x > v1) { v2 = v1; e2 = e1; v1 = x; e1 = e; } else if (x > v2) { v2 = x; e2 = e; } }
            const float g2 = 1.0f / (1.0f + expf(v1 - v2)), g1 = 1.0f - g2;
            if (F.lane == 0) { TOPE[m] = (unsigned)e1 | ((unsigned)e2 << 8); TOPG[2 * m] = g1; TOPG[2 * m + 1] = g2; lst[it * 8 + F.wave] = (unsigned)e1 | ((unsigned)e2 << 8); }
        }
#pragma unroll
        for (int j = 0; j < 8; ++j) v[j] = vn[j];
    }
    if (ROUTE) {
        __syncthreads();
        if (F.tid < NE) {
            const unsigned e = F.tid; unsigned cnt = 0;
            const int niter = (T + NGW - 1) / NGW;
            for (int i = 0; i < niter; ++i)
                for (int w = 0; w < 8; ++w) { const int m = F.vcu * 8 + w + i * NGW; if (m < T) { const unsigned ent = lst[i * 8 + w];
                    if ((ent & 0xffu) == e) TOPR[2 * m] = cnt++;
                    if (((ent >> 8) & 0xffu) == e) TOPR[2 * m + 1] = cnt++; } }
            CNTB[F.vcu * 8 + e] = cnt;
        }
    }
}

__device__ __forceinline__ void moe_tables(const Ctx& F) {
    const unsigned* CNTB = (const unsigned*)(F.ws + WS_ROUTE + RT_CNTB);
    {
        const int e = F.wave; unsigned tot = 0, pre = 0;
        for (int b = F.lane; b < F.G; b += 64) { const unsigned c = CNTB[b * 8 + e]; tot += c; pre += (b < F.vcu) ? c : 0u; }
#pragma unroll
        for (int o = 1; o < 64; o <<= 1) { tot += shfl_u(tot, F.lane ^ o); pre += shfl_u(pre, F.lane ^ o); }
        if (F.lane == 0) { F.lctl[LC_PRE + e] = pre; F.lctl[LC_TOT + e] = tot; }
    }
    __syncthreads();
    if (F.tid == 0) { unsigned tb = 0; for (int e = 0; e < NE; ++e) { F.lctl[LC_TB + e] = tb; tb += (F.lctl[LC_TOT + e] + 255u) >> 8; }
        F.lctl[LC_TB + 8] = tb; F.lctl[LC_NMT] = tb; }
    __syncthreads();
    if (F.tid < MAXMT) { unsigned e = 0;
#pragma unroll
        for (int k = 1; k < NE; ++k) e += ((unsigned)F.tid >= F.lctl[LC_TB + k]) ? 1u : 0u;
        F.lctl[LC_TEXP + F.tid] = e; }
    __syncthreads();
}

__device__ __forceinline__ void slot_tables(const Ctx& F) {
    const int gw = F.vcu * 8 + F.wave, NGW = F.G * 8;
    const unsigned* TOPE = (const unsigned*)(F.ws + WS_ROUTE + RT_TOPE); const unsigned* TOPR = (const unsigned*)(F.ws + WS_ROUTE + RT_TOPR); unsigned* SLOT = (unsigned*)(F.ws + WS_ROUTE + RT_SLOT);
    unsigned* ROWOF = (unsigned*)(F.ws + WS_ROUTE + RT_ROWOF);
    for (int m0 = gw; m0 < T; m0 += 32 * NGW) {
        const int m = m0 + (F.lane >> 1) * NGW, k = F.lane & 1;
        if (m < T) { const unsigned e = (TOPE[m] >> (8 * k)) & 0xffu; const unsigned slot = F.lctl[LC_TB + e] * 256u + F.lctl[LC_PRE + e] + TOPR[2 * m + k];
            SLOT[2 * m + k] = slot; ROWOF[slot] = (unsigned)m; }
    }
    if (F.vcu == 0) {
        for (int e = 0; e < NE; ++e) { const unsigned lo = F.lctl[LC_TB + e] * 256u + F.lctl[LC_TOT + e], hi = F.lctl[LC_TB + e + 1] * 256u;
            for (unsigned i = lo + F.tid; i < hi; i += 512) ROWOF[i] = 0u; }
    }
}

__device__ __forceinline__ void final_phase(const Ctx& F, const float* gain) {
    const int gw = F.vcu * 8 + F.wave, NGW = F.G * 8;
    const float* TOPG = (const float*)(F.ws + WS_ROUTE + RT_TOPG); const unsigned* SLOT = (const unsigned*)(F.ws + WS_ROUTE + RT_SLOT);
    const bf16* OS = (const bf16*)(F.ws + WS_PROJ); const bf16* OS2 = (const bf16*)(F.ws + WS_H);
    LAS unsigned char* SPL = (LAS unsigned char*)(F.lctl + LC_SPLIT);
    { pg8::SplitOrder S; S.init((int)F.lctl[LC_NMT], D / 256, F.G, 0, nullptr); S.init2();
      for (int i = F.tid; i < MAXMT * 8; i += 512) SPL[i] = 0xffu;
      __syncthreads();
      if (F.tid < S.rem) { pg8::Unit u; if (S.unit_at((long)S.R * S.G + F.tid, u)) SPL[u.pm * 8 + u.pn] = (unsigned char)F.tid; }
      __syncthreads(); }
    f32x4 gv[8];
#pragma unroll
    for (int j = 0; j < 8; ++j) gv[j] = ((const f32x4*)gain)[F.lane + 64 * j];
    float g1 = 0.f, g2 = 0.f, ng1 = 0.f, ng2 = 0.f; unsigned s1 = 0, s2 = 0, ns1 = 0, ns2 = 0;
    f32x4 xv[8]; u32x2 av[8], bv[8];
    if (gw < T) { g1 = TOPG[2 * gw]; g2 = TOPG[2 * gw + 1]; s1 = SLOT[2 * gw]; s2 = SLOT[2 * gw + 1];
        const f32x4* xr0 = (const f32x4*)(F.out + (size_t)gw * D) + F.lane; const u32x2* o1 = (const u32x2*)(OS + (size_t)s1 * D) + F.lane; const u32x2* o2 = (const u32x2*)(OS + (size_t)s2 * D) + F.lane;
#pragma unroll
        for (int j = 0; j < 8; ++j) { xv[j] = xr0[64 * j]; av[j] = o1[64 * j]; bv[j] = o2[64 * j]; } }
    if (gw + NGW < T) { const int mn = gw + NGW; ng1 = TOPG[2 * mn]; ng2 = TOPG[2 * mn + 1]; ns1 = SLOT[2 * mn]; ns2 = SLOT[2 * mn + 1]; }
    for (int m = gw; m < T; m += NGW) {
        f32x4* xr = (f32x4*)(F.out + (size_t)m * D) + F.lane;
        f32x4 xn[8]; u32x2 an[8], bn[8]; float fg1 = 0.f, fg2 = 0.f; unsigned fs1 = 0, fs2 = 0;
        if (m + NGW < T) { const f32x4* xrn = (const f32x4*)(F.out + (size_t)(m + NGW) * D) + F.lane; const u32x2* o1 = (const u32x2*)(OS + (size_t)ns1 * D) + F.lane; const u32x2* o2 = (const u32x2*)(OS + (size_t)ns2 * D) + F.lane;
#pragma unroll
            for (int j = 0; j < 8; ++j) { xn[j] = xrn[64 * j]; an[j] = o1[64 * j]; bn[j] = o2[64 * j]; } }
        else {
#pragma unroll
            for (int j = 0; j < 8; ++j) { xn[j] = xv[j]; an[j] = av[j]; bn[j] = bv[j]; } }
        if (m + 2 * NGW < T) { const int mf = m + 2 * NGW; fg1 = TOPG[2 * mf]; fg2 = TOPG[2 * mf + 1]; fs1 = SLOT[2 * mf]; fs2 = SLOT[2 * mf + 1]; }
        f32x4 v[8]; float ss = 0.f;
#pragma unroll
        for (int j = 0; j < 8; ++j) { const u32x2 a = av[j], b = bv[j]; v[j] = xv[j];
            float va[4] = {bflo(a.x), bfhi(a.x), bflo(a.y), bfhi(a.y)}, vb[4] = {bflo(b.x), bfhi(b.x), bflo(b.y), bfhi(b.y)};
            const unsigned q1 = SPL[(s1 >> 8) * 8 + j], q2 = SPL[(s2 >> 8) * 8 + j];
            if (q1 != 0xffu) { const u32x2 c = ((const u32x2*)(OS2 + ((size_t)q1 * 256 + (s1 & 255u)) * 256))[F.lane]; va[0] += bflo(c.x); va[1] += bfhi(c.x); va[2] += bflo(c.y); va[3] += bfhi(c.y); }
            if (q2 != 0xffu) { const u32x2 c = ((const u32x2*)(OS2 + ((size_t)q2 * 256 + (s2 & 255u)) * 256))[F.lane]; vb[0] += bflo(c.x); vb[1] += bfhi(c.x); vb[2] += bflo(c.y); vb[3] += bfhi(c.y); }
            v[j].x += g1 * va[0] + g2 * vb[0]; v[j].y += g1 * va[1] + g2 * vb[1]; v[j].z += g1 * va[2] + g2 * vb[2]; v[j].w += g1 * va[3] + g2 * vb[3];
            ss += (v[j].x * v[j].x + v[j].y * v[j].y) + (v[j].z * v[j].z + v[j].w * v[j].w); }
        ss = wave_sum(ss, F.lane);
        const float rstd = 1.0f / sqrtf(ss * (1.0f / D) + EPS);
#pragma unroll
        for (int j = 0; j < 8; ++j) xr[64 * j] = v[j] * rstd * gv[j];
#pragma unroll
        for (int j = 0; j < 8; ++j) { xv[j] = xn[j]; av[j] = an[j]; bv[j] = bn[j]; }
        g1 = ng1; g2 = ng2; s1 = ns1; s2 = ns2; ng1 = fg1; ng2 = fg2; ns1 = fs1; ns2 = fs2;
    }
}

__device__ __forceinline__ void lru_unit(const Ctx& F, int l, int b, int n, int hf, const float* const* in) {
    asm volatile("" : "+s"(l), "+s"(b), "+s"(n), "+s"(hf));
    const int tid = F.tid, wave = F.wave, lane = F.lane, fr = lane & 15, fq = lane >> 4, nt = wave & 3, mh = wave >> 2;
    LAS unsigned char* XC = F.lds; LAS float* EX = (LAS float*)(F.lds + 32768);
    LAS float* HS = EX + 256;
    static_assert(32768 + (256 + 128 * 68) * 4 <= LDSCTL_OFF, "RG-LRU LDS map");
    const bf16* PROJ = (const bf16*)(F.ws + WS_PROJ); bf16* Y = (bf16*)(F.ws + WS_H); float* SSP = (float*)(F.ws + WS_SSP);
    const bf16* WL = (const bf16*)(F.ws + WS_WLRU) + (size_t)l * 2 * 8 * 16384;
    const int os_g = tid & 7, os_tok = tid >> 3;
    float gn[8]; { const f32x4 a = *(const f32x4*)(inp(10) + (size_t)l * D_RNN + n * 128 + hf * 64 + 8 * os_g), c = *(const f32x4*)(inp(10) + (size_t)l * D_RNN + n * 128 + hf * 64 + 8 * os_g + 4);
        gn[0] = a.x; gn[1] = a.y; gn[2] = a.z; gn[3] = a.w; gn[4] = c.x; gn[5] = c.y; gn[6] = c.z; gn[7] = c.w; }
    const int cg = tid & 15, tl = tid >> 4, cch = n * 128 + cg * 8;
    const int prow0 = ((tl >> 4) << 6) | ((tl & 3) << 4) | (((tl >> 2) & 3) << 2);
    float cw[4][8], cb[8];
#pragma unroll
    for (int tap = 0; tap < 4; ++tap) { const f32x4 a = *(const f32x4*)(inp(3) + (size_t)(l * 4 + tap) * D_RNN + cch), c = *(const f32x4*)(inp(3) + (size_t)(l * 4 + tap) * D_RNN + cch + 4);
        cw[tap][0] = a.x; cw[tap][1] = a.y; cw[tap][2] = a.z; cw[tap][3] = a.w; cw[tap][4] = c.x; cw[tap][5] = c.y; cw[tap][6] = c.z; cw[tap][7] = c.w; }
    { const f32x4 a = *(const f32x4*)(inp(4) + (size_t)l * D_RNN + cch), c = *(const f32x4*)(inp(4) + (size_t)l * D_RNN + cch + 4);
        cb[0] = a.x; cb[1] = a.y; cb[2] = a.z; cb[3] = a.w; cb[4] = c.x; cb[5] = c.y; cb[6] = c.z; cb[7] = c.w; }
    const int lc = hf * 64 + nt * 16 + fr, gc = n * 128 + lc;
    const float ba_c = inp(6)[l * D_RNN + gc], bx_c = inp(8)[l * D_RNN + gc];
    const float sp8 = 8.0f * log1pf(expf(-inp(9)[l * D_RNN + gc]));
    bf16x8 Wa[4], Wx[4];
#pragma unroll
    for (int ks = 0; ks < 4; ++ks) { Wa[ks] = *(const bf16x8*)(WL + (size_t)((0 * 8 + n) * 128 + lc) * 128 + 32 * ks + 8 * fq);
                                     Wx[ks] = *(const bf16x8*)(WL + (size_t)((1 * 8 + n) * 128 + lc) * 128 + 32 * ks + 8 * fq); }
    float Hc = 0.f;
    u32x4 xr[7];
#pragma unroll
    for (int r = 0; r < 7; ++r) { const int t = 4 * tl - 3 + r; xr[r] = (u32x4){0u, 0u, 0u, 0u}; if (t >= 0) xr[r] = *(const u32x4*)(PROJ + (size_t)(b * SEQ + t) * D_IN + cch); }
    for (int ck = 0; ck < SEQ / 128; ++ck) {
        const int t0 = ck * 128;
        {
            float xv[7][8];
#pragma unroll
            for (int r = 0; r < 7; ++r) { const u32x4 w = xr[r];
                xv[r][0] = bflo(w.x); xv[r][1] = bfhi(w.x); xv[r][2] = bflo(w.y); xv[r][3] = bfhi(w.y); xv[r][4] = bflo(w.z); xv[r][5] = bfhi(w.z); xv[r][6] = bflo(w.w); xv[r][7] = bfhi(w.w); }
#pragma unroll
            for (int q = 0; q < 4; ++q) { float y[8];
#pragma unroll
                for (int c = 0; c < 8; ++c) { float a = cb[c];
#pragma unroll
                    for (int tap = 0; tap < 4; ++tap) a += cw[tap][c] * xv[q + tap][c];
                    y[c] = a; }
                *(LAS u32x4*)(XC + tile_off(prow0 + q, 8 * cg, 4)) = (u32x4){pk2(y[0], y[1]), pk2(y[2], y[3]), pk2(y[4], y[5]), pk2(y[6], y[7])}; }
        }
        __syncthreads();
        if (ck + 1 < SEQ / 128) {
#pragma unroll
            for (int r = 0; r < 7; ++r) xr[r] = *(const u32x4*)(PROJ + (size_t)(b * SEQ + t0 + 128 + 4 * tl - 3 + r) * D_IN + cch);
        }
        u32x4 gpre[2];
#pragma unroll
        for (int j = 0; j < 2; ++j) gpre[j] = *(const u32x4*)(PROJ + (size_t)(b * SEQ + t0 + os_tok + 64 * j) * D_IN + OFF_GATE + n * 128 + hf * 64 + 8 * os_g);
        float av[16], bv[16];
#pragma unroll
        for (int mi = 0; mi < 4; ++mi) {
            const int mt = 4 * mh + mi;
            f32x4 aa = (f32x4){0.f, 0.f, 0.f, 0.f}, ax = (f32x4){0.f, 0.f, 0.f, 0.f};
#pragma unroll
            for (int ks = 0; ks < 4; ++ks) { const bf16x8 xf = lds_frag(XC, tile_off(16 * mt + fr, 32 * ks + 8 * fq, 4)); aa = MFMA16(xf, Wa[ks], aa); ax = MFMA16(xf, Wx[ks], ax); }
#pragma unroll
            for (int i = 0; i < 4; ++i) { const int tok = 64 * mh + 16 * fq + 4 * mi + i;
                const float r = sigmoidf_(aa[i] + ba_c), ig = sigmoidf_(ax[i] + bx_c);
                const float a = __expf(-sp8 * r); float mult = sqrtf(fmaxf(1.0f - a * a, 0.f));
                if (ck == 0 && tok == 0) mult = 1.0f;
                const float xcv = __builtin_bit_cast(float, (unsigned)(*(const LAS unsigned short*)(XC + tile_off(16 * mt + 4 * fq + i, lc, 4))) << 16);
                av[4 * mi + i] = a; bv[4 * mi + i] = mult * ig * xcv; }
        }
        float P = av[0], Q = bv[0];
#pragma unroll
        for (int k = 1; k < 16; ++k) { P *= av[k]; Q = Q * av[k] + bv[k]; }
        { const float P1 = shfl_idx(P, lane - 16), Q1 = shfl_idx(Q, lane - 16); if (fq >= 1) { Q = P * Q1 + Q; P = P * P1; } }
        { const float P2 = shfl_idx(P, lane - 32), Q2 = shfl_idx(Q, lane - 32); if (fq >= 2) { Q = P * Q2 + Q; P = P * P2; } }
        float Pex = shfl_idx(P, lane - 16), Qex = shfl_idx(Q, lane - 16); if (fq == 0) { Pex = 1.0f; Qex = 0.f; }
        const float Pc = shfl_idx(P, fr + 48), Qc = shfl_idx(Q, fr + 48);
        if (fq == 0) { EX[((mh * 4 + nt) * 16 + fr) * 2] = Pc; EX[((mh * 4 + nt) * 16 + fr) * 2 + 1] = Qc; }
        __syncthreads();
        const float P0 = EX[((0 * 4 + nt) * 16 + fr) * 2], Q0 = EX[((0 * 4 + nt) * 16 + fr) * 2 + 1], P1h = EX[((1 * 4 + nt) * 16 + fr) * 2], Q1h = EX[((1 * 4 + nt) * 16 + fr) * 2 + 1];
        const float Hmid = P0 * Hc + Q0;
        const float Hw = (mh == 0) ? Hc : Hmid;
        Hc = P1h * Hmid + Q1h;
        {
            float h = Pex * Hw + Qex;
#pragma unroll
            for (int k = 0; k < 16; ++k) { h = av[k] * h + bv[k]; HS[(64 * mh + 16 * fq + k) * 68 + nt * 16 + fr] = h; }
        }
        __syncthreads();
#pragma unroll
        for (int j = 0; j < 2; ++j) { const int tk = os_tok + 64 * j; const size_t row = (size_t)(b * SEQ + t0 + tk);
            const u32x4 gw = gpre[j];
            const f32x4 h0 = *(const LAS f32x4*)(HS + tk * 68 + 8 * os_g), h1 = *(const LAS f32x4*)(HS + tk * 68 + 8 * os_g + 4);
            const float hh[8] = {h0.x, h0.y, h0.z, h0.w, h1.x, h1.y, h1.z, h1.w};
            {
                float ss = ((hh[0] * hh[0] + hh[1] * hh[1]) + (hh[2] * hh[2] + hh[3] * hh[3])) + ((hh[4] * hh[4] + hh[5] * hh[5]) + (hh[6] * hh[6] + hh[7] * hh[7]));
                ss += shfl_x(ss, 1, lane); ss += shfl_x(ss, 2, lane); ss += shfl_x(ss, 4, lane);
                if (os_g == 0) SSP[row * 16 + (n * 2 + hf)] = ss; }
            const float g[8] = {bflo(gw.x), bfhi(gw.x), bflo(gw.y), bfhi(gw.y), bflo(gw.z), bfhi(gw.z), bflo(gw.w), bfhi(gw.w)}; float y[8];
#pragma unroll
            for (int r = 0; r < 8; ++r) { const float x = g[r]; y[r] = hh[r] * gn[r] * (x * sigmoidf_(1.5957691216f * (x + 0.044715f * x * x * x))); }
            *(u32x4*)(Y + row * D + n * 128 + hf * 64 + 8 * os_g) = (u32x4){pk2(y[0], y[1]), pk2(y[2], y[3]), pk2(y[4], y[5]), pk2(y[6], y[7])}; }
    }
    __syncthreads();
}

typedef short s16x4 __attribute__((ext_vector_type(4)));
__device__ __forceinline__ bf16x8 tr_frag(LAS unsigned char* base, int stride, int krow0, int col0, int lane) {
    const int g = lane >> 4, i = lane & 15, q = i >> 2, p = i & 3;
    const s16x4 lo = __builtin_amdgcn_ds_read_tr16_b64_v4i16((LAS s16x4*)(base + (krow0 + 8 * g + q) * stride + (col0 + 4 * p) * 2));
    const s16x4 hi = __builtin_amdgcn_ds_read_tr16_b64_v4i16((LAS s16x4*)(base + (krow0 + 8 * g + 4 + q) * stride + (col0 + 4 * p) * 2));
    return __builtin_shufflevector(lo, hi, 0, 1, 2, 3, 4, 5, 6, 7);
}
constexpr int SKZ = 144, SVS = 288;
__device__ __forceinline__ void ret_unit(const Ctx& F, int l, int b, int h, int c0, int c1, const float* const* in) {
    asm volatile("" : "+s"(l), "+s"(b), "+s"(h), "+s"(c0), "+s"(c1));
    const int tid = F.tid, wave = F.wave, lane = F.lane, fr = lane & 15, fq = lane >> 4;
    LAS unsigned char* Qs = F.lds; LAS unsigned char* Ks = F.lds + 16384; LAS unsigned char* Kz = F.lds + 32768; LAS unsigned char* Vs = Kz + 128 * SKZ;
    LAS unsigned char* Ps = Vs + 128 * SVS; LAS unsigned char* STs = Ps + 32768;
    static_assert(32768 + 128 * SKZ + 128 * SVS + 32768 + 16384 <= LDSCTL_OFF, "retention LDS map");
    const bf16* PROJ = (const bf16*)(F.ws + WS_PROJ); bf16* Y = (bf16*)(F.ws + WS_H); const f32x2* ROPE = (const f32x2*)(F.ws + WS_ROPE);
    const float* rg = inp(11) + (size_t)l * 1024 + h * 128;
    const float lgm = log2f(1.0f - exp2f(-5.0f - (float)h));
    const float cdec = exp2f(128.0f * lgm);
    const int tok = tid >> 2, seg = tid & 3;
    const float zeta = exp2f((float)(127 - tok) * lgm);
    f32x4 accS[4];
#pragma unroll
    for (int dt = 0; dt < 4; ++dt) accS[dt] = (f32x4){0.f, 0.f, 0.f, 0.f};
    f32x4 pr_cs[4]; u32x4 pr_k[2], pr_v[4], pr_q[2];
#define RET_LOAD(ckk, want_q) do { const size_t ro_ = (size_t)(b * SEQ + (ckk) * 128 + tok) * D_IN; const f32x4* cs_ = (const f32x4*)(ROPE + (size_t)((ckk) * 128 + tok) * 32 + 8 * seg); \
        _Pragma("unroll") for (int i_ = 0; i_ < 4; ++i_) pr_cs[i_] = cs_[i_]; \
        pr_k[0] = *(const u32x4*)(PROJ + ro_ + OFF_K + h * 64 + 8 * seg); pr_k[1] = *(const u32x4*)(PROJ + ro_ + OFF_K + h * 64 + 32 + 8 * seg); \
        _Pragma("unroll") for (int q_ = 0; q_ < 4; ++q_) pr_v[q_] = *(const u32x4*)(PROJ + ro_ + OFF_V + h * 128 + 32 * seg + 8 * q_); \
        if (want_q) { pr_q[0] = *(const u32x4*)(PROJ + ro_ + OFF_Q + h * 64 + 8 * seg); pr_q[1] = *(const u32x4*)(PROJ + ro_ + OFF_Q + h * 64 + 32 + 8 * seg); } } while (0)
    pr_q[0] = pr_q[1] = (u32x4){0u, 0u, 0u, 0u};
    RET_LOAD(0, c0 == 0);
    for (int ck = 0; ck < c1; ++ck) {
        const int t0 = ck * 128; const bool full = ck >= c0;
        if (full) {
#pragma unroll
            for (int dt = 0; dt < 4; ++dt) *(LAS u32x2*)(STs + tile_off(16 * wave + fr, 16 * dt + 4 * fq, 2)) = (u32x2){pk2(accS[dt][0], accS[dt][1]), pk2(accS[dt][2], accS[dt][3])};
        }
        {
            float c[8], s[8];
#pragma unroll
            for (int i = 0; i < 4; ++i) { const f32x4 v = pr_cs[i]; c[2 * i] = v.x; s[2 * i] = v.y; c[2 * i + 1] = v.z; s[2 * i + 1] = v.w; }
            if (full) {
                const u32x4 w1 = pr_q[0], w2 = pr_q[1];
                const float x1[8] = {bflo(w1.x), bfhi(w1.x), bflo(w1.y), bfhi(w1.y), bflo(w1.z), bfhi(w1.z), bflo(w1.w), bfhi(w1.w)};
                const float x2[8] = {bflo(w2.x), bfhi(w2.x), bflo(w2.y), bfhi(w2.y), bflo(w2.z), bfhi(w2.z), bflo(w2.w), bfhi(w2.w)};
                float r1[8], r2[8];
#pragma unroll
                for (int i = 0; i < 8; ++i) { r1[i] = x1[i] * c[i] - x2[i] * s[i]; r2[i] = x1[i] * s[i] + x2[i] * c[i]; }
                *(LAS u32x4*)(Qs + tile_off(tok, 8 * seg, 2)) = (u32x4){pk2(r1[0], r1[1]), pk2(r1[2], r1[3]), pk2(r1[4], r1[5]), pk2(r1[6], r1[7])};
                *(LAS u32x4*)(Qs + tile_off(tok, 32 + 8 * seg, 2)) = (u32x4){pk2(r2[0], r2[1]), pk2(r2[2], r2[3]), pk2(r2[4], r2[5]), pk2(r2[6], r2[7])};
            }
            {
                const u32x4 w1 = pr_k[0], w2 = pr_k[1];
                const float x1[8] = {bflo(w1.x), bfhi(w1.x), bflo(w1.y), bfhi(w1.y), bflo(w1.z), bfhi(w1.z), bflo(w1.w), bfhi(w1.w)};
                const float x2[8] = {bflo(w2.x), bfhi(w2.x), bflo(w2.y), bfhi(w2.y), bflo(w2.z), bfhi(w2.z), bflo(w2.w), bfhi(w2.w)};
                float r1[8], r2[8];
#pragma unroll
                for (int i = 0; i < 8; ++i) { r1[i] = (x1[i] * c[i] - x2[i] * s[i]) * 0.125f; r2[i] = (x1[i] * s[i] + x2[i] * c[i]) * 0.125f; }
                if (full) {
                    *(LAS u32x4*)(Ks + tile_off(tok, 8 * seg, 2)) = (u32x4){pk2(r1[0], r1[1]), pk2(r1[2], r1[3]), pk2(r1[4], r1[5]), pk2(r1[6], r1[7])};
                    *(LAS u32x4*)(Ks + tile_off(tok, 32 + 8 * seg, 2)) = (u32x4){pk2(r2[0], r2[1]), pk2(r2[2], r2[3]), pk2(r2[4], r2[5]), pk2(r2[6], r2[7])};
                }
#pragma unroll
                for (int i = 0; i < 8; ++i) { r1[i] *= zeta; r2[i] *= zeta; }
                *(LAS u32x4*)(Kz + tok * SKZ + 16 * seg) = (u32x4){pk2(r1[0], r1[1]), pk2(r1[2], r1[3]), pk2(r1[4], r1[5]), pk2(r1[6], r1[7])};
                *(LAS u32x4*)(Kz + tok * SKZ + 64 + 16 * seg) = (u32x4){pk2(r2[0], r2[1]), pk2(r2[2], r2[3]), pk2(r2[4], r2[5]), pk2(r2[6], r2[7])};
            }
#pragma unroll
            for (int q = 0; q < 4; ++q) *(LAS u32x4*)(Vs + tok * SVS + 64 * seg + 16 * q) = pr_v[q];
        }
        __syncthreads();
        if (ck + 1 < c1) RET_LOAD(ck + 1, ck + 1 >= c0);
        if (full) {
            bf16x8 qf[2];
#pragma unroll
            for (int ks = 0; ks < 2; ++ks) qf[ks] = lds_frag(Qs, tile_off(16 * wave + fr, 32 * ks + 8 * fq, 2));
            int irow = 16 * wave + fr; float lgv = lgm; asm volatile("" : "+v"(irow), "+v"(lgv));
#pragma unroll
            for (int jt = 0; jt < 8; ++jt) {
                u32x2 pw = (u32x2){0u, 0u};
                if (jt <= wave) {
                    f32x4 sc = (f32x4){0.f, 0.f, 0.f, 0.f};
#pragma unroll
                    for (int ks = 0; ks < 2; ++ks) sc = MFMA16(lds_frag(Ks, tile_off(16 * jt + fr, 32 * ks + 8 * fq, 2)), qf[ks], sc);
                    float p[4];
#pragma unroll
                    for (int r = 0; r < 4; ++r) { const int dij = irow - (16 * jt + 4 * fq + r); p[r] = (dij >= 0) ? sc[r] * __builtin_amdgcn_exp2f((float)dij * lgv) : 0.f; }
                    pw = (u32x2){pk2(p[0], p[1]), pk2(p[2], p[3])};
                }
                *(LAS u32x2*)(Ps + tile_off(irow, 16 * jt + 4 * fq, 4)) = pw;
            }
            __syncthreads();
            bf16x8 pf[4];
#pragma unroll
            for (int ks = 0; ks < 4; ++ks) pf[ks] = lds_frag(Ps, tile_off(16 * wave + fr, 32 * ks + 8 * fq, 4));
            const float xi = __builtin_amdgcn_exp2f((float)(irow + 1) * lgv);
            float o[8][4]; float sum = 0.f;
#pragma unroll
            for (int et = 0; et < 8; ++et) {
                f32x4 ao = (f32x4){0.f, 0.f, 0.f, 0.f}, ac = (f32x4){0.f, 0.f, 0.f, 0.f};
#pragma unroll
                for (int ks = 0; ks < 4; ++ks) if (32 * ks <= 16 * wave + 15) ao = MFMA16(tr_frag(Vs, SVS, 32 * ks, 16 * et, lane), pf[ks], ao);
#pragma unroll
                for (int ks = 0; ks < 2; ++ks) ac = MFMA16(lds_frag(STs, tile_off(16 * et + fr, 32 * ks + 8 * fq, 2)), qf[ks], ac);
#pragma unroll
                for (int r = 0; r < 4; ++r) { o[et][r] = ao[r] + xi * ac[r]; sum += o[et][r]; }
            }
            sum += shfl_x(sum, 16, lane); sum += shfl_x(sum, 32, lane);
            const float mean = sum * (1.0f / 128.0f); float var = 0.f;
#pragma unroll
            for (int et = 0; et < 8; ++et)
#pragma unroll
                for (int r = 0; r < 4; ++r) { const float d = o[et][r] - mean; var += d * d; }
            var += shfl_x(var, 16, lane); var += shfl_x(var, 32, lane);
            const float rstd = 1.0f / sqrtf(var * (1.0f / 128.0f) + EPS);
            {
                const size_t rowo = (size_t)(b * SEQ + t0 + irow);
#pragma unroll
                for (int et = 0; et < 8; ++et) {
                    const u32x2 gw = *(const u32x2*)(PROJ + rowo * D_IN + OFF_G + h * 128 + 16 * et + 4 * fq);
                    const f32x4 gn = *(const f32x4*)(rg + 16 * et + 4 * fq);
                    const float g[4] = {bflo(gw.x), bfhi(gw.x), bflo(gw.y), bfhi(gw.y)};
                    float y[4];
#pragma unroll
                    for (int r = 0; r < 4; ++r) y[r] = (o[et][r] - mean) * rstd * gn[r] * (g[r] * sigmoidf_(g[r]));
                    *(u32x2*)(Y + rowo * D + 1024 + h * 128 + 16 * et + 4 * fq) = (u32x2){pk2(y[0], y[1]), pk2(y[2], y[3])};
                }
            }
        }
        {
            bf16x8 vf[4];
#pragma unroll
            for (int ks = 0; ks < 4; ++ks) vf[ks] = tr_frag(Vs, SVS, 32 * ks, 16 * wave, lane);
#pragma unroll
            for (int dt = 0; dt < 4; ++dt) { accS[dt] = accS[dt] * cdec;
#pragma unroll
                for (int ks = 0; ks < 4; ++ks) accS[dt] = MFMA16(tr_frag(Kz, SKZ, 32 * ks, 16 * dt, lane), vf[ks], accS[dt]); }
        }
        __syncthreads();
    }
#undef RET_LOAD
}

__device__ __forceinline__ void ylru_phase(const Ctx& F, int l, const float* gain) {
    const int gw = F.vcu * 8 + F.wave, NGW = F.G * 8;
    const float* HLRU = (const float*)(F.ws + WS_HID); const float* SSP = (const float*)(F.ws + WS_SSP); const bf16* PROJ = (const bf16*)(F.ws + WS_PROJ); bf16* Y = (bf16*)(F.ws + WS_H);
    f32x4 gv[4];
#pragma unroll
    for (int j = 0; j < 4; ++j) gv[j] = ((const f32x4*)(gain + (size_t)l * D_RNN))[F.lane + 64 * j];
    for (int m = gw; m < T; m += NGW) {
        float ss = 0.f;
#pragma unroll
        for (int n = 0; n < 16; ++n) ss += SSP[(size_t)n * T + m];
        const float rstd = 1.0f / sqrtf(ss * (1.0f / D_RNN) + EPS);
#pragma unroll
        for (int j = 0; j < 4; ++j) { const f32x4 hh = ((const f32x4*)(HLRU + (size_t)m * D_RNN))[F.lane + 64 * j];
            const u32x2 gw2 = ((const u32x2*)(PROJ + (size_t)m * D_IN + OFF_GATE))[F.lane + 64 * j];
            const float g[4] = {bflo(gw2.x), bfhi(gw2.x), bflo(gw2.y), bfhi(gw2.y)}; float y[4];
#pragma unroll
            for (int r = 0; r < 4; ++r) { const float x = g[r]; const float ge = x * sigmoidf_(1.5957691216f * (x + 0.044715f * x * x * x)); y[r] = hh[r] * rstd * gv[j][r] * ge; }
            ((u32x2*)(Y + (size_t)m * D))[F.lane + 64 * j] = (u32x2){pk2(y[0], y[1]), pk2(y[2], y[3])}; }
    }
}

constexpr int NPHASE = 20;
struct Args { const float* in[22]; float* out; unsigned char* ws; int ph_lo, ph_hi, li, pad; };
__global__ void __launch_bounds__(512, 2) fwd(Args args) {
    extern __shared__ __attribute__((aligned(16))) unsigned char lds_raw[];
    Ctx F;
    F.lds = (LAS unsigned char*)lds_raw; F.lctl = (LAS unsigned*)(F.lds + LDSCTL_OFF);
    F.tid = threadIdx.x; F.lane = F.tid & 63; F.wave = __builtin_amdgcn_readfirstlane(F.tid >> 6);
    F.G = gridDim.x; { const int bx = blockIdx.x; F.vcu = (F.G % 8 == 0) ? (bx % 8) * (F.G / 8) + bx / 8 : bx; }
    F.out = args.out; F.ws = args.ws;
    for (int u = F.tid; u < (LDS_BYTES - LDSCTL_OFF) / 4; u += 512) F.lctl[u] = 0u;
    __syncthreads();
    unsigned* ctl = (unsigned*)(args.ws + WS_CTL);
    XcdBarrier bar = xcd_barrier_post(ctl + CW_BAR + args.li * XCD_BAR_WORDS, (volatile LAS unsigned*)(F.lctl + LC_BAR));
    const int lo = args.ph_lo, hi = args.ph_hi;
#define IN(k) (lo <= (k) && (k) < hi)
#define SEAM(k) do { if ((k) + 1 < hi) xcd_barrier(bar); } while (0)
    bf16* Hb = (bf16*)(args.ws + WS_H); bf16* PROJ = (bf16*)(args.ws + WS_PROJ); bf16* HID = (bf16*)(args.ws + WS_HID);

    if (IN(0)) REPEAT(REP_P0) { const Ctx P = fresh(F); p0_prologue(P); norm_phase<false, true>(P, inp(0), inp(1), Hb, nullptr); SEAM(0); }

    for (int l = 0; l < 2; ++l) {
        const int pb = 1 + 9 * l;
        const float* Xin = (l == 0) ? inp(0) : args.out;
        if (IN(pb + 0) && l == 1) REPEAT(REP_NORM) { const Ctx P = fresh(F); norm_phase<false, true>(P, Xin, inp(1) + (size_t)l * D, Hb, nullptr); SEAM(pb + 0); }
        if (IN(pb + 1)) REPEAT(REP_GIN) {
            const Ctx P = fresh(F);
            int Gv = F.G, cv = (int)blockIdx.x; bool gemm = true;
            if (l == 0) {
                const int xcd = (int)blockIdx.x % 8, idx = (int)blockIdx.x / 8, per = F.G / 8, nc = (F.G % 8 == 0 && per > GIN0_NC) ? GIN0_NC : 0;
                int cc = F.vcu, cg = F.G; bool conv = true;
                if (nc != 0) { if (idx >= per - nc) { cc = (idx - (per - nc)) * 8 + xcd; cg = nc * 8; gemm = false; } else { conv = false; Gv = (per - nc) * 8; cv = idx * 8 + xcd; } }
                if (conv) p0_convert(P, args.in, cc, cg);
            }
            if (gemm) {
                pg8::Gemm g{Hb, args.ws + WS_WIN + (size_t)l * D_IN * D, D}; pg8::GroupOrder S; S.init(T / 256, D_IN / 256, Gv, cv, nullptr);
                pg8::EpiOut<true> E{nullptr, nullptr, PROJ, D_IN, 1, (const float*)(args.ws + WS_SA), (const float*)(args.ws + WS_SW) + 2 * D_FF + (size_t)l * D_IN};
                pg8::gemm_phase<pg8::EpiOut<true>, pg8::GroupOrder, true, true, 2>(P.lds, P.tid, g, S, E);
            }
            SEAM(pb + 1);
        }
        if (IN(pb + 2)) REPEAT(REP_MIX) {
            const Ctx P = fresh(F);
            for (int u = blockIdx.x; u < 128; u += F.G) REPEAT(REP_RET) { const int bh = u & 63, th = u >> 6; ret_unit(P, l, bh >> 3, bh & 7, th ? 9 : 0, th ? 16 : 9, args.in); }
            { int u0 = (int)blockIdx.x - 128; if (u0 < 0) u0 += F.G; for (int u = u0; u < 128; u += F.G) REPEAT(REP_LRU) { const int bn = u & 63; lru_unit(P, l, bn >> 3, bn & 7, u >> 6, args.in); } }
            SEAM(pb + 2);
        }
        if (IN(pb + 4)) {
            const Ctx P = fresh(F);
            pg8::Gemm g{Hb, (const bf16*)(args.ws + WS_WOUT) + (size_t)l * D * D, 2 * D}; pg8::RowScaleOrder S; S.init(T / 256, D / 256, F.G, (int)blockIdx.x, nullptr);
            S.ssp = (const float*)(args.ws + WS_SSP); S.rs = (LAS float*)(P.lds + pg8::RS_OFF); S.tid = P.tid;
            pg8::EpiOut<false> E{Xin, args.out, nullptr, D, 0, nullptr, nullptr};
            pg8::gemm_phase<pg8::EpiOut<false>, pg8::RowScaleOrder, true, true, 0, true>(P.lds, P.tid, g, S, E);
            SEAM(pb + 4);
        }
        if (IN(pb + 5)) REPEAT(REP_NORM) {
            const Ctx P = fresh(F);
            if (l == 0) { norm_phase<false, true>(P, args.out, inp(13) + (size_t)l * D, Hb, nullptr); }
            else norm_phase<true>(P, args.out, inp(13) + (size_t)l * D, Hb, inp(17));
            SEAM(pb + 5);
        }
        if (IN(pb + 6) && l == 1) REPEAT(REP_GATHER) { const Ctx P = fresh(F); moe_tables(P); slot_tables(P); SEAM(pb + 6); }
        if (IN(pb + 7)) REPEAT(REP_GGU) {
            const Ctx P = fresh(F);
            if (l == 0) {
                pg8::Gemm g{Hb, args.ws + WS_WGU_D, D}; pg8::GroupOrder S; S.init(T / 256, 2 * D_FF / 256, F.G, (int)blockIdx.x, nullptr);
                pg8::EpiSwiglu<true, true> E{HID, D_FF, (const float*)(args.ws + WS_SA), (const float*)(args.ws + WS_SW)};
                pg8::gemm_phase<pg8::EpiSwiglu<true, true>, pg8::GroupOrder, true, true, 2>(P.lds, P.tid, g, S, E);
            } else {
                if (!MK_ONE_LAUNCH || lo > pb + 6) moe_tables(P);
                pg8::Gemm g{Hb, args.ws + WS_WGU_M, D, (const unsigned*)(args.ws + WS_ROUTE + RT_ROWOF)};
                pg8::GroupOrder S; S.init((int)P.lctl[LC_NMT], 2 * D_FF / 256, F.G, (int)blockIdx.x, (const LAS int*)(P.lctl + LC_TEXP));
                pg8::EpiSwiglu<true> E{HID, D_FF, nullptr, nullptr};
                pg8::gemm_phase<pg8::EpiSwiglu<true>, pg8::GroupOrder, true, true, 1, false, false, true>(P.lds, P.tid, g, S, E);
            }
            SEAM(pb + 7);
        }
        if (IN(pb + 8)) {
            const Ctx P = fresh(F);
            if (l == 0) {
                pg8::Gemm g{HID, args.ws + WS_WDN_D, D_FF}; pg8::GroupOrder S; S.init(T / 256, D / 256, F.G, (int)blockIdx.x, nullptr);
                pg8::EpiOut<false> E{args.out, args.out, nullptr, D, 0, nullptr, nullptr};
                pg8::gemm_phase<pg8::EpiOut<false>, pg8::GroupOrder, true, true, 1>(P.lds, P.tid, g, S, E);
            } else {
                if (!MK_ONE_LAUNCH || lo > pb + 6) moe_tables(P);
                static_assert((D_FF / 128 / 2) % 2 == 0, "half of K is a whole number of K-tile pairs");
                pg8::Gemm g{HID, args.ws + WS_WDN_M, D_FF}; pg8::SplitOrder S; S.init((int)P.lctl[LC_NMT], D / 256, F.G, (int)blockIdx.x, (const LAS int*)(P.lctl + LC_TEXP)); S.init2();
                pg8::EpiOut<false, true> E{nullptr, nullptr, PROJ, D, 1, nullptr, nullptr, (bf16*)(args.ws + WS_H)};
                pg8::gemm_phase<pg8::EpiOut<false, true>, pg8::SplitOrder, true, true, 1, false, true>(P.lds, P.tid, g, S, E);
            }
            SEAM(pb + 8);
        }
    }
    if (IN(19)) { const Ctx P = fresh(F); if (!MK_ONE_LAUNCH || lo > 16) moe_tables(P); final_phase(P, inp(21)); }
#undef IN
#undef SEAM
}

extern "C" void kernel_launch(void* const* d_in, const int* in_sizes, int n_in, void* d_out, int out_size, void* d_ws, size_t ws_size, hipStream_t stream) {
    static int grid = 0;
    if (grid == 0) {
        if (n_in != 22 || in_sizes[0] != T * D || out_size != T * D || ws_size < WS_END) { fprintf(stderr, "kernel_launch: unexpected shapes (n_in %d, in0 %d, out %d, ws %zu < %zu); nothing launched\n", n_in, n_in > 0 ? in_sizes[0] : -1, out_size, ws_size, (size_t)WS_END); grid = -1; return; }
        int dev = 0, cus = 0, per_cu = 0;
        if (hipGetDevice(&dev) != hipSuccess || hipDeviceGetAttribute(&cus, hipDeviceAttributeMultiprocessorCount, dev) != hipSuccess) { grid = -1; return; }
        if (hipFuncSetAttribute((const void*)fwd, hipFuncAttributeMaxDynamicSharedMemorySize, LDS_BYTES) != hipSuccess) { fprintf(stderr, "kernel_launch: hipFuncSetAttribute failed\n"); grid = -1; return; }
        if (hipOccupancyMaxActiveBlocksPerMultiprocessor(&per_cu, (const void*)fwd, 512, LDS_BYTES) != hipSuccess || per_cu < 1) fprintf(stderr, "kernel_launch: occupancy query reports %d\n", per_cu);
        (void)hipGetLastError();
        grid = cus < 256 ? cus : 256;
    }
    if (grid < 0) return;
    if (hipMemsetAsync((char*)d_ws + WS_CTL, 0, CTL_ZERO_BYTES, stream) != hipSuccess) return;
    Args a{};
    for (int i = 0; i < 22; ++i) a.in[i] = (const float*)d_in[i];
    a.out = (float*)d_out; a.ws = (unsigned char*)d_ws; a.pad = 0;
#if MK_ONE_LAUNCH
    a.ph_lo = 0; a.ph_hi = NPHASE; a.li = 0;
    hipLaunchKernelGGL(fwd, dim3(grid), dim3(512), LDS_BYTES, stream, a);
#else
    int li = 0;
    for (int p = 0; p < NPHASE; ++p) {
        if (p == 1 || p == 1 + 6 || p == 4 || p == 13) continue;
        a.ph_lo = p; a.ph_hi = p + 1; a.li = li++;
        hipLaunchKernelGGL(fwd, dim3(grid), dim3(512), LDS_BYTES, stream, a);
    }
#endif
}
```

```cpp
#include <hip/hip_runtime.h>
#include <cstdio>
#include <cstdint>

#ifndef MK_ONE_LAUNCH
#define MK_ONE_LAUNCH 1
#endif

#ifndef REP_P0
#define REP_P0 1
#endif
#ifndef REP_NORM
#define REP_NORM 1
#endif
#ifndef REP_GIN
#define REP_GIN 1
#endif
#ifndef REP_MIX
#define REP_MIX 1
#endif
#ifndef REP_YLRU
#define REP_YLRU 1
#endif
#ifndef REP_GATHER
#define REP_GATHER 1
#endif
#ifndef REP_GGU
#define REP_GGU 1
#endif
#ifndef REP_RET
#define REP_RET 1
#endif
#ifndef REP_LRU
#define REP_LRU 1
#endif
#define REPEAT(n) for (int rep_ = 0; rep_ < (n); ++rep_)
#ifndef GIN0_NC
#define GIN0_NC 20
#endif
#define LAS __attribute__((address_space(3)))
#define GAS __attribute__((address_space(1)))
typedef unsigned short bf16;
typedef short bf16x8 __attribute__((ext_vector_type(8)));
typedef float f32x4 __attribute__((ext_vector_type(4)));
typedef float f32x2 __attribute__((ext_vector_type(2)));
typedef unsigned u32x4 __attribute__((ext_vector_type(4)));
typedef unsigned u32x2 __attribute__((ext_vector_type(2)));

constexpr int BATCH = 8, SEQ = 2048, T = BATCH * SEQ, D = 2048, D_IN = 5120, D_RNN = 1024, NH = 8, DK = 64, DV = 128, D_FF = 5632, NE = 8;
constexpr int OFF_GATE = 1024, OFF_Q = 2048, OFF_K = 2560, OFF_V = 3072, OFF_G = 4096;
constexpr float EPS = 1e-6f;
constexpr int MAXMT = 136;
constexpr int MPAD = MAXMT * 256;

constexpr size_t MiB = 1u << 20;
constexpr size_t WS_CTL = 0, CTL_ZERO_BYTES = 1 * MiB;
constexpr size_t WS_ROPE = 1 * MiB;
constexpr size_t WS_WLRU = 2 * MiB;
constexpr size_t WS_SSP = 3 * MiB;
constexpr size_t WS_ROUTE = 4 * MiB;
constexpr size_t RT_TOPE = 0, RT_TOPG = 65536, RT_TOPR = 65536 * 3, RT_SLOT = 65536 * 5, RT_CNTB = 65536 * 7, RT_ROWOF = 65536 * 8;
constexpr size_t WS_SA = 5 * MiB;
constexpr size_t WS_SW = 6 * MiB;
constexpr size_t WS_WIN = 8 * MiB;
constexpr size_t WS_WOUT = 48 * MiB;
constexpr size_t WS_WGU_D = 64 * MiB;
constexpr size_t WS_WDN_D = 108 * MiB;
constexpr size_t WS_WGU_M = 130 * MiB;
constexpr size_t WS_WDN_M = 482 * MiB;
constexpr size_t WS_H = 658 * MiB;
constexpr size_t WS_PROJ = 722 * MiB;
constexpr size_t WS_HID = 882 * MiB;
constexpr size_t WS_END = 1256 * MiB;
static_assert(WS_WIN + (size_t)2 * D_IN * D * 2 <= WS_WOUT && WS_WOUT + (size_t)2 * D * D * 2 <= WS_WGU_D && WS_WGU_D + (size_t)2 * D_FF * D * 2 <= WS_WDN_D &&
              WS_WDN_D + (size_t)D * D_FF * 2 <= WS_WGU_M && WS_WGU_M + (size_t)NE * 2 * D_FF * D * 2 <= WS_WDN_M && WS_WDN_M + (size_t)NE * D * D_FF * 2 <= WS_H &&
              WS_H + (size_t)T * D * 2 <= WS_PROJ && WS_PROJ + (size_t)T * D_IN * 2 <= WS_HID && WS_PROJ + (size_t)MPAD * D * 2 <= WS_HID && WS_HID + (size_t)MPAD * D_FF * 2 <= WS_END, "d_ws map");
constexpr int CW_TMO = 0;
constexpr int CW_BAR = 4096;

constexpr int RING_BYTES = 131072;
constexpr int LDSCTL_OFF = 140 * 1024;
constexpr int LDS_BYTES = 147456;
constexpr int LC_BAR = 0, LC_TB = 16, LC_PRE = 32, LC_TOT = 40, LC_NMT = 48, LC_TEXP = 64, LC_SPLIT = 256;

#define RLX_AGENT __ATOMIC_RELAXED, __HIP_MEMORY_SCOPE_AGENT
__device__ __forceinline__ unsigned f2bf(float f) { unsigned u = __builtin_bit_cast(unsigned, f); return (u + 0x7fffu + ((u >> 16) & 1u)) >> 16; }
__device__ __forceinline__ unsigned pk2(float lo, float hi) { return f2bf(lo) | (f2bf(hi) << 16); }
__device__ __forceinline__ float bflo(unsigned w) { return __builtin_bit_cast(float, w << 16); }
__device__ __forceinline__ float bfhi(unsigned w) { return __builtin_bit_cast(float, w & 0xffff0000u); }
__device__ __forceinline__ float shfl_idx(float v, int src) { return __builtin_bit_cast(float, __builtin_amdgcn_ds_bpermute(src << 2, __builtin_bit_cast(int, v))); }
__device__ __forceinline__ float shfl_x(float v, int o, int lane) { return shfl_idx(v, lane ^ o); }
__device__ __forceinline__ unsigned shfl_u(unsigned v, int src) { return (unsigned)__builtin_amdgcn_ds_bpermute(src << 2, (int)v); }
__device__ __forceinline__ float wave_sum(float v, int lane) {
#pragma unroll
    for (int o = 1; o < 64; o <<= 1) v += shfl_x(v, o, lane);
    return v;
}
__device__ __forceinline__ float sigmoidf_(float x) { return __builtin_amdgcn_rcpf(1.0f + __expf(-x)); }
__device__ __forceinline__ int tile_off(int r, int c, int kc32) { const int ob = (r & 15) * 64 + (c & 31) * 2; return ((r >> 4) * kc32 + (c >> 5)) * 1024 + (ob ^ (((ob >> 9) & 1) << 5)); }
__device__ __forceinline__ bf16x8 lds_frag(LAS unsigned char* base, int off) { return *(const LAS bf16x8*)(base + off); }
#define MFMA16(a, b, c) __builtin_amdgcn_mfma_f32_16x16x32_bf16((a), (b), (c), 0, 0, 0)

namespace pg8 {
constexpr int BM = 256, BK = 64, HALF = 128, HTB = HALF * BK * 2, STAGE_BYTES = 8 * HTB, NXCD = 8, WGM = 8;
__host__ __device__ __forceinline__ int lds_byte(int r, int c) { const int st = (r >> 4) * 2 + (c >> 5), rr = r & 15, cc = c & 31, ob = rr * 64 + cc * 2; return st * 1024 + (ob ^ (((ob >> 9) & 1) << 5)); }
__host__ __device__ __forceinline__ void stage_rc(int b, int& R, int& C) { const int st = b / 1024, sb = b % 1024, swz = sb ^ (((sb >> 9) & 1) << 5); R = (st >> 1) * 16 + swz / 64; C = (st & 1) * 32 + (swz % 64) / 2; }
__host__ __device__ __forceinline__ int perm32(int rho) { const int n = rho >> 4, i = rho & 15; return 8 * (i >> 2) + 4 * n + (i & 3); }

struct Unit { int pm, pn, pb, kh; };
struct Gemm { const void* A; const void* Bt; int Kb; const unsigned* arow; };

struct GroupOrder {
    int nM, nN, nwg, G, c; const LAS int* texp;
    __device__ void init(int nM_, int nN_, int G_, int c_, const LAS int* texp_) { nM = nM_; nN = nN_; nwg = nM * nN; G = G_; c = c_; texp = texp_; }
    __device__ bool next(int i, Unit& u) const { return unit_at((long)i * G + c, u); }
    __device__ bool unit_at(long L, Unit& u) const {
        if (L >= nwg) return false;
        int wgid = (int)L; { const int q = nwg / NXCD, r = nwg % NXCD, xcd = wgid % NXCD, off = wgid / NXCD; wgid = (xcd < r ? xcd * (q + 1) : r * (q + 1) + (xcd - r) * q) + off; }
        const int nig = WGM * nN, gid = wgid / nig, fm = gid * WGM, gsz = (nM - fm) < WGM ? (nM - fm) : WGM;
        u.pm = fm + ((wgid % nig) % gsz); u.pn = (wgid % nig) / gsz;
        u.pb = (texp ? __builtin_amdgcn_readfirstlane(texp[u.pm]) : 0) * nN + u.pn; return true;
    }
    struct Pre {};
    __device__ __forceinline__ void a_issue(const Unit&, Pre&) const {}
    __device__ __forceinline__ void a_finish(const Unit&, int, const Pre&) const {}
    __device__ __forceinline__ void done(const Unit&) const {}
};
struct SplitOrder : GroupOrder {
    int R, rem;
    __device__ void init2() { R = nwg / G; rem = nwg - R * G; if (2 * rem > G) rem = 0; }
    __device__ bool next(int i, Unit& u) const {
        if (rem == 0 || i < R) { const bool ok = GroupOrder::next(i, u); u.kh = 0; return ok; }
        if (i > R || c >= 2 * rem) return false;
        const bool ok = unit_at((long)R * G + (c >> 1), u); u.kh = ((c >> 1) << 2) | (1 + (c & 1)); return ok;
    }
};
constexpr int RS_OFF = 131072;
struct RowScaleOrder : GroupOrder {
    const float* ssp; LAS float* rs; int tid;
    struct Pre { f32x4 a, b; };
    __device__ __forceinline__ void a_issue(const Unit& u, Pre& p) const {
        const int r = tid & 255, h = tid >> 8; const f32x4* q = (const f32x4*)(ssp + (size_t)(u.pm * BM + r) * 16 + h * 8);
        p.a = q[0]; p.b = q[1];
    }
    __device__ __forceinline__ void a_finish(const Unit&, int par, const Pre& p) const {
        const int r = tid & 255, h = tid >> 8; const f32x4 t4 = p.a + p.b;
        rs[(par * 2 + h) * 256 + r] = (t4[0] + t4[1]) + (t4[2] + t4[3]);
    }
};
struct ScaleOrder : GroupOrder {
    const float* SA; const float* SW; int cols; LAS float* st; int tid;
    struct Pre { float v; };
    __device__ bool next(int i, Unit& u) const { const bool ok = GroupOrder::next(i, u); u.kh = i & 1; return ok; }
    __device__ __forceinline__ void a_issue(const Unit& u, Pre& p) const {
        const int t = tid;
        p.v = t < 256 ? SA[u.pm * BM + t] : (cols == 0 ? SW[u.pn * BM + t - 256] : (t < 384 ? SW[u.pn * HALF + t - 256] : SW[cols + u.pn * HALF + t - 384]));
    }
    __device__ __forceinline__ void a_finish(const Unit&, int par, const Pre& p) const { st[par * 512 + tid] = p.v; }
};
__device__ __forceinline__ float rs_scale(const LAS float* rs, int par, int r, float inv) { return 1.0f / sqrtf((rs[(par * 2) * 256 + r] + rs[(par * 2 + 1) * 256 + r]) * inv + EPS); }

__device__ __forceinline__ unsigned cvt_pk_bf16(float lo, float hi) { unsigned r; asm volatile("v_cvt_pk_bf16_f32 %0, %1, %2" : "=v"(r) : "v"(lo), "v"(hi)); return r; }

template <bool INI8 = false, bool KS = false> struct EpiOut {
    static constexpr bool PERM = true;
    const float* base; float* C; bf16* O; int ldc; int mode; const float* SA; const float* SW;
    bf16* O2;
    const LAS float* st;
    __device__ __forceinline__ void operator()(const f32x4 (&acc)[2][2][4][2], const Unit& u, int wr, int wc, int fr, int fq) const {
        int row0 = u.pm * BM + wr * 64 + fr, col0 = u.pn * BM + wc * 32 + 8 * fq;
        if (mode == 1) {
            bf16* O = this->O; int ldc = this->ldc;
            if constexpr (KS) { if ((u.kh & 3) == 2) { O = O2 + (size_t)(u.kh >> 2) * (BM * BM); ldc = BM; row0 = wr * 64 + fr; col0 = wc * 32 + 8 * fq; } }
            float sw[2][8];
            if constexpr (INI8) {
#pragma unroll
                for (int bj = 0; bj < 2; ++bj)
#pragma unroll
                    for (int j = 0; j < 8; ++j) sw[bj][j] = st ? st[512 * u.kh + 256 + wc * 32 + 8 * fq + bj * HALF + j] : SW[col0 + bj * HALF + j]; }
#pragma unroll
            for (int ai = 0; ai < 2; ++ai)
#pragma unroll
                for (int m = 0; m < 4; ++m) {
                    const size_t off = (size_t)(row0 + ai * HALF + m * 16) * ldc + col0;
                    float sa = 1.0f; if constexpr (INI8) sa = st ? st[512 * u.kh + wr * 64 + fr + ai * HALF + m * 16] : SA[row0 + ai * HALF + m * 16];
#pragma unroll
                    for (int bj = 0; bj < 2; ++bj) { float f[8];
#pragma unroll
                        for (int j = 0; j < 4; ++j) { const float a0 = acc[ai][bj][m][0][j], a1 = acc[ai][bj][m][1][j];
                            if constexpr (INI8) { f[j] = (float)__builtin_bit_cast(int, a0) * (sa * sw[bj][j]); f[4 + j] = (float)__builtin_bit_cast(int, a1) * (sa * sw[bj][4 + j]); }
                            else { f[j] = a0; f[4 + j] = a1; } }
                        u32x4 w; w.x = cvt_pk_bf16(f[0], f[1]); w.y = cvt_pk_bf16(f[2], f[3]); w.z = cvt_pk_bf16(f[4], f[5]); w.w = cvt_pk_bf16(f[6], f[7]);
                        *(u32x4*)(O + off + bj * HALF) = w; }
                }
        } else {
#pragma unroll
            for (int ai = 0; ai < 2; ++ai) {
                f32x4 bb[4][2][2];
#pragma unroll
                for (int m = 0; m < 4; ++m) { const size_t off = (size_t)(row0 + ai * HALF + m * 16) * ldc + col0;
#pragma unroll
                    for (int bj = 0; bj < 2; ++bj) { bb[m][bj][0] = *(const f32x4*)(base + off + bj * HALF); bb[m][bj][1] = *(const f32x4*)(base + off + bj * HALF + 4); } }
#pragma unroll
                for (int m = 0; m < 4; ++m) { const size_t off = (size_t)(row0 + ai * HALF + m * 16) * ldc + col0;
#pragma unroll
                    for (int bj = 0; bj < 2; ++bj) { *(f32x4*)(C + off + bj * HALF) = bb[m][bj][0] + acc[ai][bj][m][0]; *(f32x4*)(C + off + bj * HALF + 4) = bb[m][bj][1] + acc[ai][bj][m][1]; } }
                asm volatile("" ::: "memory");
            }
        }
    }
};
__device__ __forceinline__ float clamp448(float x) { return __builtin_amdgcn_fmed3f(x, -448.0f, 448.0f); }
__device__ __forceinline__ unsigned pk4_fp8(float a, float b, float c, float d) { unsigned w = 0; w = __builtin_amdgcn_cvt_pk_fp8_f32(clamp448(a), clamp448(b), w, false); w = __builtin_amdgcn_cvt_pk_fp8_f32(clamp448(c), clamp448(d), w, true); return w; }
template <bool OUT8, bool INI8 = false> struct EpiSwiglu {
    static constexpr bool PERM = true;
    void* O; int ldc; const float* SA; const float* SW;
    const LAS float* st;
    __device__ __forceinline__ void operator()(const f32x4 (&acc)[2][2][4][2], const Unit& u, int wr, int wc, int fr, int fq) const {
        const int row0 = u.pm * BM + wr * 64 + fr, col0 = u.pn * HALF + wc * 32 + 8 * fq;
        float swg[8], swu[8];
        if constexpr (INI8) {
#pragma unroll
            for (int j = 0; j < 8; ++j) { swg[j] = st ? st[512 * u.kh + 256 + wc * 32 + 8 * fq + j] : SW[col0 + j]; swu[j] = st ? st[512 * u.kh + 384 + wc * 32 + 8 * fq + j] : SW[ldc + col0 + j]; } }
#pragma unroll
        for (int ai = 0; ai < 2; ++ai)
#pragma unroll
            for (int m = 0; m < 4; ++m) {
                float h[8]; float sa = 1.0f; if constexpr (INI8) sa = st ? st[512 * u.kh + wr * 64 + fr + ai * HALF + m * 16] : SA[row0 + ai * HALF + m * 16];
#pragma unroll
                for (int n = 0; n < 2; ++n)
#pragma unroll
                    for (int j = 0; j < 4; ++j) { float g = acc[ai][0][m][n][j], up = acc[ai][1][m][n][j];
                        if constexpr (INI8) { g = (float)__builtin_bit_cast(int, g) * (sa * swg[4 * n + j]); up = (float)__builtin_bit_cast(int, up) * (sa * swu[4 * n + j]); } h[n * 4 + j] = g * __builtin_amdgcn_rcpf(1.0f + __builtin_amdgcn_exp2f(-1.44269504f * g)) * up; }
                if constexpr (OUT8) { *(u32x2*)((unsigned char*)O + (size_t)(row0 + ai * HALF + m * 16) * ldc + col0) = (u32x2){pk4_fp8(h[0], h[1], h[2], h[3]), pk4_fp8(h[4], h[5], h[6], h[7])}; }
                else { u32x4 w; w.x = cvt_pk_bf16(h[0], h[1]); w.y = cvt_pk_bf16(h[2], h[3]); w.z = cvt_pk_bf16(h[4], h[5]); w.w = cvt_pk_bf16(h[6], h[7]);
                    *(u32x4*)((bf16*)O + (size_t)(row0 + ai * HALF + m * 16) * ldc + col0) = w; }
            }
    }
};

typedef int i32x4 __attribute__((ext_vector_type(4)));
typedef int i32x8 __attribute__((ext_vector_type(8)));
template <class Epi, class Sched, bool ALIGN_EPI, bool SP2, int KIND  , bool MIDK = false, bool KSPLIT = false, bool GA = false>
__device__ __forceinline__ void gemm_phase(LAS unsigned char* lds, const int tid, const Gemm g, const Sched& S, const Epi& E) {
    const int wid = __builtin_amdgcn_readfirstlane(tid >> 6), lane = tid & 63, wr = wid >> 2, wc = wid & 3, fr = lane & 15, fq = lane >> 4;
    const int K = g.Kb, nt = K / 128;
    unsigned voffA[2], voffB[2];
#pragma unroll
    for (int i = 0; i < 2; ++i) { int R, C; stage_rc(tid * 16 + i * 8192, R, C); const int Rb = Epi::PERM ? ((R & ~31) + perm32(R & 31)) : R;
        voffA[i] = (unsigned)(R * K + C * 2); voffB[i] = (unsigned)(Rb * K + C * 2); }
    int rA0 = 0; unsigned colA = 0; { int R, C; stage_rc(tid * 16, R, C); rA0 = R; colA = (unsigned)(C * 2); }
    unsigned gofC[2][2], gofN[2][2], gofX[2][2]; (void)gofC; (void)gofN; (void)gofX; (void)rA0; (void)colA;
    LAS unsigned* atab = (LAS unsigned*)(lds + RS_OFF);
    const size_t kstep = (size_t)(BK * 2);
    const size_t hstep = (size_t)HALF * K;
    const size_t tstep = 2 * hstep;
    const unsigned ldsw = (unsigned)wid * 1024u;
    const int aoff = lds_byte(wr * 64 + fr, fq * 8), boff = lds_byte(wc * 32 + fr, fq * 8);
#define PG8_SA(b, h) (((b) * 2 + (h)) * HTB)
#define PG8_SB(b, h) ((4 + (b) * 2 + (h)) * HTB)
#define PG8_STAGE(bufoff, gbase, voff) do { _Pragma("unroll") for (int _i = 0; _i < 2; ++_i) \
        __builtin_amdgcn_global_load_lds((const unsigned*)((const char*)(gbase) + (voff)[_i]), (LAS unsigned*)(lds + (bufoff) + ldsw + _i * 8192), 16, 0, 0); } while (0)
#define PG8_STAGE_A(b, h, base, offs) do { if constexpr (GA) { PG8_STAGE(PG8_SA(b, h), (base), (offs)[h]); } else { PG8_STAGE(PG8_SA(b, h), (base) + (h) * hstep, voffA); } } while (0)
#define PG8_LDA(dst, b, h) do { _Pragma("unroll") for (int m = 0; m < 4; ++m) _Pragma("unroll") for (int k = 0; k < 2; ++k) dst[m][k] = *(const LAS bf16x8*)(lds + PG8_SA(b, h) + aoff + m * 2048 + k * 1024); } while (0)
#define PG8_LDB(dst, b, h) do { _Pragma("unroll") for (int n = 0; n < 2; ++n) _Pragma("unroll") for (int k = 0; k < 2; ++k) dst[n][k] = *(const LAS bf16x8*)(lds + PG8_SB(b, h) + boff + n * 2048 + k * 1024); } while (0)
#define PG8_CAT(x) __builtin_shufflevector(__builtin_bit_cast(i32x4, (x)[0]), __builtin_bit_cast(i32x4, (x)[1]), 0, 1, 2, 3, 4, 5, 6, 7)
#define PG8_MMA(ai, bj, At, Bt) do { __builtin_amdgcn_s_setprio(1); _Pragma("unroll") for (int m = 0; m < 4; ++m) _Pragma("unroll") for (int n = 0; n < 2; ++n) { \
        if constexpr (KIND == 1) { const i32x8 bw_ = PG8_CAT(Bt[n]), aw_ = PG8_CAT(At[m]); \
            asm volatile("v_mfma_scale_f32_16x16x128_f8f6f4 %0, %1, %2, %0, %3, %4 op_sel_hi:[0,0,0]" : "+v"(acc[ai][bj][m][n]) : "v"(bw_), "v"(aw_), "v"(sc_w), "v"(sc_a)); } \
        else if constexpr (KIND == 2) { _Pragma("unroll") for (int k = 0; k < 2; ++k) acc[ai][bj][m][n] = __builtin_bit_cast(f32x4, __builtin_amdgcn_mfma_i32_16x16x64_i8( \
            __builtin_bit_cast(i32x4, Bt[n][k]), __builtin_bit_cast(i32x4, At[m][k]), __builtin_bit_cast(i32x4, acc[ai][bj][m][n]), 0, 0, 0)); } \
        else { _Pragma("unroll") for (int k = 0; k < 2; ++k) acc[ai][bj][m][n] = __builtin_amdgcn_mfma_f32_16x16x32_bf16(Bt[n][k], At[m][k], acc[ai][bj][m][n], 0, 0, 0); } } \
        __builtin_amdgcn_s_setprio(0); } while (0)
#define PG8_WAIT_V(n) asm volatile("s_waitcnt vmcnt(" #n ")" ::: "memory")
#define PG8_WAIT_L(n) asm volatile("s_waitcnt lgkmcnt(" #n ")" ::: "memory")
#define PG8_BAR __builtin_amdgcn_s_barrier()
#define PG8_SCHED __builtin_amdgcn_sched_barrier(0)
    Unit cur, nxt; int ui = 0;
    if (!S.next(0, cur)) return;
    const int sc_w = 0x79797979, sc_a = 0x7f7f7f7f; (void)sc_w; (void)sc_a;
    f32x4 acc[2][2][4][2];
#pragma unroll
    for (int a = 0; a < 2; ++a)
#pragma unroll
        for (int b = 0; b < 2; ++b)
#pragma unroll
            for (int m = 0; m < 4; ++m)
#pragma unroll
                for (int n = 0; n < 2; ++n) acc[a][b][m][n] = (f32x4){0.f, 0.f, 0.f, 0.f};
    bf16x8 At[4][2], B0[2][2], B1[2][2];
    const char* cA = (const char*)g.A + (GA ? (size_t)0 : (size_t)cur.pm * tstep); const char* cB = (const char*)g.Bt + (size_t)cur.pb * tstep;
    if constexpr (GA) {
        static_assert(SP2 && !KSPLIT && !MIDK, "gathered A: SP2 schedule only");
#pragma unroll
        for (int h = 0; h < 2; ++h)
#pragma unroll
            for (int i = 0; i < 2; ++i) { gofC[h][i] = g.arow[cur.pm * BM + h * HALF + rA0 + 64 * i] * (unsigned)K + colA; gofN[h][i] = gofC[h][i]; }
    }
    if constexpr (KSPLIT) { if ((cur.kh & 3) == 2) { cA += (size_t)(nt / 2) * kstep; cB += (size_t)(nt / 2) * kstep; } }
    { typename Sched::Pre pre0; S.a_issue(cur, pre0); S.a_finish(cur, 0, pre0); }
    if constexpr (SP2) {
        PG8_STAGE(PG8_SB(0, 0), cB, voffB); PG8_STAGE(PG8_SB(0, 1), cB + hstep, voffB); PG8_STAGE_A(0, 0, cA, gofC); PG8_STAGE_A(0, 1, cA, gofC);
        if (wr == 1) PG8_BAR;
        PG8_WAIT_V(2); PG8_BAR;
        PG8_STAGE(PG8_SB(1, 0), cB + kstep, voffB); PG8_STAGE_A(1, 0, cA + kstep, gofC); PG8_STAGE(PG8_SB(1, 1), cB + hstep + kstep, voffB);
        PG8_WAIT_V(6); PG8_BAR;
    } else {
        PG8_STAGE(PG8_SB(0, 0), cB, voffB); PG8_STAGE(PG8_SA(0, 0), cA, voffA); PG8_STAGE(PG8_SB(0, 1), cB + hstep, voffB); PG8_STAGE(PG8_SA(0, 1), cA + hstep, voffA);
        if (wr == 1) PG8_BAR;
        PG8_WAIT_V(4); PG8_BAR;
        PG8_STAGE(PG8_SB(1, 0), cB + kstep, voffB); PG8_STAGE(PG8_SA(1, 0), cA + kstep, voffA); PG8_STAGE(PG8_SB(1, 1), cB + hstep + kstep, voffB);
        PG8_WAIT_V(6); PG8_BAR;
    }
    for (;;) {
        const bool has_next = S.next(ui + 1, nxt);
        const char* nA = (has_next && !GA) ? (const char*)g.A + (size_t)nxt.pm * tstep : cA; const char* nB = has_next ? (const char*)g.Bt + (size_t)nxt.pb * tstep : cB;
        if constexpr (GA) { if (has_next && wid == 0)
            __builtin_amdgcn_global_load_lds(g.arow + (size_t)nxt.pm * BM + lane * 4, atab + ((ui + 1) & 1) * BM, 16, 0, 0); }
        int unt = nt;
        if constexpr (KSPLIT) { if (has_next && (nxt.kh & 3) == 2) { nA += (size_t)(nt / 2) * kstep; nB += (size_t)(nt / 2) * kstep; } if (cur.kh & 3) unt = nt / 2; }
        for (int t = 0; t < unt; t += 2) {
            const bool last = (t == unt - 2);
            const char* a1 = cA + (size_t)(t + 1) * kstep;
            const char* a2 = last ? nA : cA + (size_t)(t + 2) * kstep; const char* b2 = last ? nB : cB + (size_t)(t + 2) * kstep;
            const char* a3 = a2 + kstep; const char* b3 = b2 + kstep;
            if constexpr (GA) {
                if (t == 2 && has_next) {
#pragma unroll
                    for (int h = 0; h < 2; ++h)
#pragma unroll
                        for (int i = 0; i < 2; ++i) gofN[h][i] = atab[((ui + 1) & 1) * BM + h * HALF + rA0 + 64 * i] * (unsigned)K + colA; }
#pragma unroll
                for (int h = 0; h < 2; ++h)
#pragma unroll
                    for (int i = 0; i < 2; ++i) gofX[h][i] = last ? gofN[h][i] : gofC[h][i];
            }
            if constexpr (MIDK) { if (t == nt / 2) {
                const LAS float* rs = (const LAS float*)(lds + RS_OFF);
#pragma unroll
                for (int ai = 0; ai < 2; ++ai)
#pragma unroll
                    for (int m = 0; m < 4; ++m) { const float sc = rs_scale(rs, ui & 1, ai * HALF + wr * 64 + m * 16 + fr, 1.0f / D_RNN);
#pragma unroll
                        for (int bj = 0; bj < 2; ++bj)
#pragma unroll
                            for (int n = 0; n < 2; ++n) acc[ai][bj][m][n] = acc[ai][bj][m][n] * sc; } } }
            if constexpr (SP2) {
            PG8_LDB(B0, 0, 0); PG8_LDB(B1, 0, 1); PG8_SCHED; PG8_LDA(At, 0, 0); PG8_STAGE_A(1, 1, a1, gofC);
            PG8_WAIT_V(8); PG8_WAIT_L(0); PG8_BAR; PG8_MMA(0, 0, At, B0); PG8_MMA(0, 1, At, B1); PG8_BAR; PG8_SCHED;
            PG8_LDA(At, 0, 1); PG8_STAGE(PG8_SB(0, 0), b2, voffB); PG8_STAGE(PG8_SB(0, 1), b2 + hstep, voffB); PG8_STAGE_A(0, 0, a2, gofX);
            PG8_WAIT_V(8); PG8_WAIT_L(0); PG8_BAR; PG8_MMA(1, 0, At, B0); PG8_MMA(1, 1, At, B1); PG8_BAR; PG8_SCHED;
            PG8_LDB(B0, 1, 0); PG8_LDB(B1, 1, 1); PG8_SCHED; PG8_LDA(At, 1, 0); PG8_STAGE_A(0, 1, a2, gofX);
            PG8_WAIT_V(8); PG8_WAIT_L(0); PG8_BAR; PG8_MMA(0, 0, At, B0); PG8_MMA(0, 1, At, B1); PG8_BAR; PG8_SCHED;
            PG8_LDA(At, 1, 1); PG8_STAGE(PG8_SB(1, 0), b3, voffB); PG8_STAGE(PG8_SB(1, 1), b3 + hstep, voffB); PG8_STAGE_A(1, 0, a3, gofX);
            PG8_WAIT_V(8); PG8_WAIT_L(0); PG8_BAR; PG8_MMA(1, 0, At, B0); PG8_MMA(1, 1, At, B1); PG8_BAR; PG8_SCHED;
            } else {
            PG8_LDB(B0, 0, 0); PG8_SCHED; PG8_LDA(At, 0, 0); PG8_STAGE(PG8_SA(1, 1), a1 + hstep, voffA);
            PG8_WAIT_L(8); PG8_BAR; PG8_WAIT_L(0); PG8_MMA(0, 0, At, B0); PG8_BAR; PG8_SCHED;
            PG8_LDB(B1, 0, 1); PG8_STAGE(PG8_SB(0, 0), b2, voffB);
            PG8_BAR; PG8_WAIT_L(0); PG8_MMA(0, 1, At, B1); PG8_BAR;
            PG8_LDA(At, 0, 1); PG8_STAGE(PG8_SA(0, 0), a2, voffA);
            PG8_BAR; PG8_WAIT_L(0); PG8_MMA(1, 0, At, B0); PG8_BAR; PG8_SCHED;
            PG8_STAGE(PG8_SB(0, 1), b2 + hstep, voffB);
            PG8_WAIT_V(6); PG8_BAR; PG8_MMA(1, 1, At, B1); PG8_BAR;
            PG8_LDB(B0, 1, 0); PG8_SCHED; PG8_LDA(At, 1, 0); PG8_STAGE(PG8_SA(0, 1), a2 + hstep, voffA);
            PG8_WAIT_L(8); PG8_BAR; PG8_WAIT_L(0); PG8_MMA(0, 0, At, B0); PG8_BAR; PG8_SCHED;
            PG8_LDB(B1, 1, 1); PG8_STAGE(PG8_SB(1, 0), b3, voffB);
            PG8_BAR; PG8_WAIT_L(0); PG8_MMA(0, 1, At, B1); PG8_BAR;
            PG8_LDA(At, 1, 1); PG8_STAGE(PG8_SA(1, 0), a3, voffA);
            PG8_BAR; PG8_WAIT_L(0); PG8_MMA(1, 0, At, B0); PG8_BAR; PG8_SCHED;
            PG8_STAGE(PG8_SB(1, 1), b3 + hstep, voffB);
            PG8_WAIT_V(6); PG8_BAR; PG8_MMA(1, 1, At, B1); PG8_BAR;
            }
        }
        if constexpr (ALIGN_EPI) { if (wr == 0) PG8_BAR; }
        if constexpr (KIND == 1) asm volatile("s_nop 15\n\ts_nop 15" ::: "memory");
        typename Sched::Pre pre; if (has_next) S.a_issue(nxt, pre);
        E(acc, cur, wr, wc, fr, fq); S.done(cur);
        if (has_next) S.a_finish(nxt, (ui + 1) & 1, pre);
        if (!has_next) break;
#pragma unroll
        for (int a = 0; a < 2; ++a)
#pragma unroll
            for (int b = 0; b < 2; ++b)
#pragma unroll
                for (int m = 0; m < 4; ++m)
#pragma unroll
                    for (int n = 0; n < 2; ++n) acc[a][b][m][n] = (f32x4){0.f, 0.f, 0.f, 0.f};
        cur = nxt; cA = nA; cB = nB; ++ui;
        if constexpr (GA) {
#pragma unroll
            for (int h = 0; h < 2; ++h)
#pragma unroll
                for (int i = 0; i < 2; ++i) gofC[h][i] = gofN[h][i]; }
        if constexpr (ALIGN_EPI) { if (wr == 1) PG8_BAR; }
    }
    PG8_WAIT_V(0);
    if constexpr (!ALIGN_EPI) { if (wr == 0) PG8_BAR; }
    PG8_BAR;
#undef PG8_SA
#undef PG8_SB
#undef PG8_STAGE
#undef PG8_LDA
#undef PG8_STAGE_A
#undef PG8_LDB
#undef PG8_MMA
#undef PG8_CAT
#undef PG8_WAIT_V
#undef PG8_WAIT_L
#undef PG8_BAR
#undef PG8_SCHED
}
}

#define XB_TMO      128
#define XB_XCNT(j)  (256  + 64 * (j))
#define XB_XSUB(j)  (1280 + 64 * (j))
#define XB_XGEN(j)  (2304 + 64 * (j))
#define XB_TOP      3328
#define XB_TOPGEN   3392
#define XCD_BAR_WORDS 3456
#define XB_SPIN_CAP (1u << 18)
__device__ __forceinline__ unsigned xb_ld(unsigned* p)              { return __hip_atomic_load(p, __ATOMIC_RELAXED, __HIP_MEMORY_SCOPE_AGENT); }
__device__ __forceinline__ unsigned xb_add(unsigned* p, unsigned v) { return __hip_atomic_fetch_add(p, v, __ATOMIC_RELAXED, __HIP_MEMORY_SCOPE_AGENT); }
__device__ __forceinline__ unsigned xb_xcc_id() { return (unsigned)__builtin_amdgcn_s_getreg((3 << 11) | 20) & 0xFu; }
#define XB_SPIN(cond, bar) do { unsigned _sp = 0; while (cond) { __builtin_amdgcn_s_sleep(1); \
    if ((++_sp & 255u) == 0u) { if (xb_ld(&(bar)[XB_TMO])) break; if (_sp > XB_SPIN_CAP) { atomicAdd(&(bar)[XB_TMO], 1u); break; } } } } while (0)
struct XcdBarrier { unsigned* bar; unsigned x; volatile LAS unsigned* st; };
__device__ __forceinline__ XcdBarrier xcd_barrier_post(unsigned* bar, volatile LAS unsigned* st) {
    XcdBarrier b; b.bar = bar; b.x = xb_xcc_id(); b.st = st;
    if (threadIdx.x == 0) (void)xb_add(&bar[XB_XCNT(b.x)], 1u);
    return b;
}
__device__ __forceinline__ void xcd_barrier_complete(unsigned* bar, unsigned x, unsigned& nloc, unsigned& nx) {
    const unsigned G = gridDim.x * gridDim.y * gridDim.z;
    unsigned sum, cnt, mine, sp = 0u;
    for (;;) {
        sum = 0u; cnt = 0u; mine = 0u;
#pragma unroll
        for (unsigned j = 0; j < 16; ++j) { const unsigned c = xb_ld(&bar[XB_XCNT(j)]); sum += c; cnt += (c > 0u) ? 1u : 0u; mine = (j == x) ? c : mine; }
        if (sum == G) break;
        __builtin_amdgcn_s_sleep(1);
        if ((++sp & 255u) == 0u) { if (xb_ld(&bar[XB_TMO])) break; if (sp > XB_SPIN_CAP) { atomicAdd(&bar[XB_TMO], 1u); break; } }
    }
    nloc = mine > 0u ? mine : 1u; nx = cnt > 0u ? cnt : 1u;
}
__device__ __forceinline__ void xcd_barrier(const XcdBarrier& b) {
    asm volatile("s_waitcnt vmcnt(0)" ::: "memory");
    __syncthreads();
    if (threadIdx.x == 0) {
        unsigned* bar = b.bar;
        __builtin_amdgcn_s_waitcnt(0);
        unsigned nloc = b.st[0], nx = b.st[1];
        if (nloc == 0u) { xcd_barrier_complete(bar, b.x, nloc, nx); b.st[0] = nloc; b.st[1] = nx; }
        const unsigned old = xb_add(&bar[XB_XSUB(b.x)], 1u);
        const unsigned gen = old / nloc;
        if (old + 1u == (gen + 1u) * nloc) {
            __builtin_amdgcn_fence(__ATOMIC_RELEASE, "agent");
            asm volatile("s_waitcnt vmcnt(0)" ::: "memory");
            const unsigned og = xb_add(&bar[XB_TOP], 1u);
            const unsigned tg = og / nx;
            if (og + 1u == (tg + 1u) * nx) xb_add(&bar[XB_TOPGEN], 1u);
            else XB_SPIN(xb_ld(&bar[XB_TOPGEN]) == tg, bar);
            __builtin_amdgcn_fence(__ATOMIC_ACQUIRE, "agent");
            xb_add(&bar[XB_XGEN(b.x)], 1u);
            asm volatile("s_waitcnt vmcnt(0)" ::: "memory");
        } else {
            XB_SPIN(xb_ld(&bar[XB_XGEN(b.x)]) == gen, bar);
            __builtin_amdgcn_fence(__ATOMIC_ACQUIRE, "agent");
            asm volatile("s_waitcnt vmcnt(0)" ::: "memory");
        }
    }
    __syncthreads();
}

__device__ __forceinline__ void p0_transpose_item(const float* W, int K, int N, bf16* WT, int kb, int nb, int drow0, LAS float* scr, int lane) {
    const int k0 = 64 * kb, n0 = 32 * nb;
#pragma unroll 8
    for (int i = 0; i < 32; ++i) { const int kk = 2 * i + (lane >> 5); scr[kk * 33 + (lane & 31)] = W[(size_t)(k0 + kk) * N + n0 + (lane & 31)]; }
    asm volatile("s_waitcnt lgkmcnt(0)" ::: "memory");
    const int c = lane & 7;
#pragma unroll
    for (int j = 0; j < 4; ++j) { const int n = (lane >> 3) + 8 * j; const LAS float* s = scr + (8 * c) * 33 + n;
        u32x4 o; o.x = pk2(s[0 * 33], s[1 * 33]); o.y = pk2(s[2 * 33], s[3 * 33]); o.z = pk2(s[4 * 33], s[5 * 33]); o.w = pk2(s[6 * 33], s[7 * 33]);
        *(u32x4*)(WT + (size_t)(drow0 + n) * K + k0 + 8 * c) = o; }
    asm volatile("s_waitcnt lgkmcnt(0)" ::: "memory");
}

__device__ __forceinline__ void p0_transpose_item_fp8(const float* W, int K, int N, unsigned char* WT, int kb, int nb, int drow0, LAS float* scr, int lane) {
    const int k0 = 64 * kb, n0 = 32 * nb;
#pragma unroll 8
    for (int i = 0; i < 32; ++i) { const int kk = 2 * i + (lane >> 5); scr[kk * 33 + (lane & 31)] = W[(size_t)(k0 + kk) * N + n0 + (lane & 31)]; }
    asm volatile("s_waitcnt lgkmcnt(0)" ::: "memory");
    const int c = lane & 3;
#pragma unroll
    for (int j = 0; j < 2; ++j) { const int n = (lane >> 2) + 16 * j; const LAS float* s = scr + (16 * c) * 33 + n;
        u32x4 o; o.x = pg8::pk4_fp8(64.f * s[0 * 33], 64.f * s[1 * 33], 64.f * s[2 * 33], 64.f * s[3 * 33]); o.y = pg8::pk4_fp8(64.f * s[4 * 33], 64.f * s[5 * 33], 64.f * s[6 * 33], 64.f * s[7 * 33]);
        o.z = pg8::pk4_fp8(64.f * s[8 * 33], 64.f * s[9 * 33], 64.f * s[10 * 33], 64.f * s[11 * 33]); o.w = pg8::pk4_fp8(64.f * s[12 * 33], 64.f * s[13 * 33], 64.f * s[14 * 33], 64.f * s[15 * 33]);
        *(u32x4*)(WT + (size_t)(drow0 + n) * K + k0 + 16 * c) = o; }
    asm volatile("s_waitcnt lgkmcnt(0)" ::: "memory");
}

__device__ __forceinline__ const float* inp(int i) {
    int off = i * 8; asm volatile("" : "+s"(off));
    const __attribute__((address_space(4))) char* ka = (const __attribute__((address_space(4))) char*)__builtin_amdgcn_kernarg_segment_ptr();
    return *(const float* const __attribute__((address_space(4)))*)(ka + off);
}

struct Ctx {
    LAS unsigned char* lds; LAS unsigned* lctl;
    int tid, lane, wave, vcu, G;
    float* out; unsigned char* ws;
};

__device__ __forceinline__ Ctx fresh(const Ctx& F) { Ctx R = F; int ln, wv = F.wave; asm volatile("v_mbcnt_lo_u32_b32 %0, -1, 0\n\tv_mbcnt_hi_u32_b32 %0, -1, %0" : "=v"(ln)); asm volatile("" : "+s"(wv));
    R.lane = ln; R.wave = wv; R.tid = wv * 64 + ln; return R; }

constexpr int I_IN = (D / 64) * (D_IN / 64), I_OUT = (D / 64) * (D / 64), I_GU = (D / 64) * (D_FF / 64), I_DN = (D_FF / 64) * (D / 64), I_LRU = 2 * 2;
constexpr int E0 = 2 * I_IN, E1 = E0 + 2 * I_OUT, E2 = E1 + I_GU, E3 = E2 + I_GU, E4 = E3 + I_DN, E5 = E4 + NE * I_GU, E6 = E5 + NE * I_GU, E7 = E6 + NE * I_DN, E8 = E7 + 32 * I_LRU;
struct CvDesc { const f32x4* src; unsigned char* dst; int N4, K, fp8; };
__device__ __forceinline__ CvDesc cv_desc(const Ctx& F, const float* const* in, int it) {
    const int n4 = F.lane & 15, kq = F.lane >> 4;
    const float* W; unsigned char* WT; int K, N, kb, nb, gu = 0, fp8 = 0;
    if (it < E0) { const int l = it / I_IN, r = it % I_IN, nblk = D_IN / 64; kb = r / nblk; nb = r % nblk; W = inp(2) + (size_t)l * D * D_IN; K = D; N = D_IN; WT = F.ws + WS_WIN + (size_t)l * D_IN * D * 2; }
    else if (it < E1) { const int q = it - E0, l = q / I_OUT, r = q % I_OUT, nblk = D / 64; kb = r / nblk; nb = r % nblk; W = inp(12) + (size_t)l * D * D; K = D; N = D; WT = F.ws + WS_WOUT + (size_t)l * D * D * 2; }
    else if (it < E3) { const int q = it - E1, up = q / I_GU, r = q % I_GU, nblk = D_FF / 64; kb = r / nblk; nb = r % nblk; W = up ? inp(15) : inp(14); K = D; N = D_FF; WT = F.ws + WS_WGU_D; gu = 1 + up; }
    else if (it < E4) { const int r = it - E3, nblk = D / 32; kb = r / nblk; nb = r % nblk; W = inp(16); K = D_FF; N = D; WT = F.ws + WS_WDN_D; fp8 = 1; }
    else if (it < E6) { const int q = it - E4, up = q / (NE * I_GU), q2 = q % (NE * I_GU), e = q2 / I_GU, r = q2 % I_GU, nblk = D_FF / 32; kb = r / nblk; nb = r % nblk;
        W = (up ? inp(19) : inp(18)) + (size_t)e * D * D_FF; K = D; N = D_FF; WT = F.ws + WS_WGU_M + (size_t)e * 2 * D_FF * D; gu = 1 + up; fp8 = 1; }
    else if (it < E7) { const int q = it - E6, e = q / I_DN, r = q % I_DN, nblk = D / 32; kb = r / nblk; nb = r % nblk; W = inp(20) + (size_t)e * D_FF * D; K = D_FF; N = D; WT = F.ws + WS_WDN_M + (size_t)e * D * D_FF; fp8 = 1; }
    else { const int q = it - E7, mi = q / I_LRU, r = q % I_LRU; kb = r / 2; nb = r % 2;
        const int mat = (mi / 8) & 1, n = mi & 7, l = mi / 16; W = (mat ? inp(7) : inp(5)) + (size_t)(l * 8 + n) * 16384; K = 128; N = 128; WT = F.ws + WS_WLRU + (size_t)mi * 16384 * 2; }
    const int k0 = fp8 ? 128 * kb + 16 * (F.lane >> 3) : 64 * kb + 16 * kq, nn = fp8 ? 32 * nb + 4 * (F.lane & 7) : 64 * nb + 4 * n4;
    const int drow = gu ? ((nn >> 7) * 256 + (nn & 127) + (gu - 1) * 128) : nn;
    CvDesc d; d.src = (const f32x4*)(W + (size_t)k0 * N + nn); d.N4 = N / 4; d.K = K; d.fp8 = fp8; d.dst = WT + ((size_t)drow * K + k0) * (fp8 ? 1 : 2); return d;
}
__device__ __forceinline__ void cv_load(const CvDesc& d, f32x4 (&x)[16]) {
#pragma unroll
    for (int j = 0; j < 16; ++j) x[j] = d.src[(size_t)j * d.N4];
}
__device__ __forceinline__ void cv_store(const CvDesc& d, const f32x4 (&x)[16]) {
    if (d.fp8) {
#pragma unroll
        for (int c = 0; c < 4; ++c) { u32x4 o;
            o.x = pg8::pk4_fp8(64.f * x[0][c], 64.f * x[1][c], 64.f * x[2][c], 64.f * x[3][c]); o.y = pg8::pk4_fp8(64.f * x[4][c], 64.f * x[5][c], 64.f * x[6][c], 64.f * x[7][c]);
            o.z = pg8::pk4_fp8(64.f * x[8][c], 64.f * x[9][c], 64.f * x[10][c], 64.f * x[11][c]); o.w = pg8::pk4_fp8(64.f * x[12][c], 64.f * x[13][c], 64.f * x[14][c], 64.f * x[15][c]);
            *(u32x4*)(d.dst + (size_t)c * d.K) = o; }
    } else {
#pragma unroll
        for (int c = 0; c < 4; ++c) { u32x4 o0, o1;
            o0.x = pk2(x[0][c], x[1][c]); o0.y = pk2(x[2][c], x[3][c]); o0.z = pk2(x[4][c], x[5][c]); o0.w = pk2(x[6][c], x[7][c]);
            o1.x = pk2(x[8][c], x[9][c]); o1.y = pk2(x[10][c], x[11][c]); o1.z = pk2(x[12][c], x[13][c]); o1.w = pk2(x[14][c], x[15][c]);
            u32x4* dst = (u32x4*)(d.dst + (size_t)c * d.K * 2); dst[0] = o0; dst[1] = o1; }
    }
}
__device__ __forceinline__ void convert_items(const Ctx& F, const float* const* in, int lo, int hi, int w0, int nw) {
    int it = lo + w0; if (it >= hi) return;
    CvDesc cur = cv_desc(F, in, it); f32x4 x[16]; cv_load(cur, x);
    for (;;) {
        const int nx = it + nw; const bool more = nx < hi;
        CvDesc nxt = cur; f32x4 y[16];
        if (more) { nxt = cv_desc(F, in, nx); cv_load(nxt, y); }
        cv_store(cur, x);
        if (!more) break;
#pragma unroll
        for (int j = 0; j < 16; ++j) x[j] = y[j];
        cur = nxt; it = nx;
    }
}
__device__ __forceinline__ void w_quant_item(const Ctx& F, const float* W, int N, int nb, float* SW, unsigned char* WT, int gu) {
    const int n4 = F.lane & 7, nn = 32 * nb + 4 * n4, k0 = 256 * F.wave + 32 * (F.lane >> 3);
    const f32x4* src = (const f32x4*)(W + (size_t)k0 * N + nn);
    f32x4 x[32];
#pragma unroll
    for (int j = 0; j < 32; ++j) x[j] = src[(size_t)j * (N / 4)];
    f32x4 mx = (f32x4){0.f, 0.f, 0.f, 0.f};
#pragma unroll
    for (int j = 0; j < 32; ++j) mx = __builtin_elementwise_max(mx, __builtin_elementwise_abs(x[j]));
#pragma unroll
    for (int c = 0; c < 4; ++c) { float v = mx[c]; v = fmaxf(v, shfl_idx(v, F.lane ^ 8)); v = fmaxf(v, shfl_idx(v, F.lane ^ 16)); v = fmaxf(v, shfl_idx(v, F.lane ^ 32)); mx[c] = v; }
    LAS f32x4* cmx = (LAS f32x4*)F.lds;
    if ((F.lane >> 3) == 0) cmx[F.wave * 8 + n4] = mx;
    __syncthreads();
    f32x4 m = cmx[n4];
#pragma unroll
    for (int w = 1; w < 8; ++w) m = __builtin_elementwise_max(m, cmx[w * 8 + n4]);
    __syncthreads();
    const int drow = gu ? ((nn >> 7) * 256 + (nn & 127) + (gu - 1) * 128) : nn;
#pragma unroll
    for (int c = 0; c < 4; ++c) { const float cm = fmaxf(m[c], 1e-30f), inv = 127.0f / cm; unsigned w[8];
#pragma unroll
        for (int q = 0; q < 8; ++q) { unsigned pk = 0;
#pragma unroll
            for (int b = 0; b < 4; ++b) { const int v = (int)rintf(x[4 * q + b][c] * inv); pk |= ((unsigned)v & 0xffu) << (8 * b); }
            w[q] = pk; }
        u32x4* dst = (u32x4*)(WT + (size_t)(drow + c) * D + k0);
        dst[0] = (u32x4){w[0], w[1], w[2], w[3]}; dst[1] = (u32x4){w[4], w[5], w[6], w[7]};
        if (F.wave == 0 && (F.lane >> 3) == 0) SW[nn + c] = cm * (1.0f / 127.0f); }
}
constexpr int QI_GU = D_FF / 32, QI_IN = D_IN / 32, QI_ALL = 2 * QI_GU + 2 * QI_IN;
__device__ __forceinline__ void i8_quantize_items(const Ctx& F, int first, int count, int c, int G) {
    float* SW = (float*)(F.ws + WS_SW);
    for (int it = first + c; it < first + count; it += G) {
        if (it < 2 * QI_GU) { const int up = it >= QI_GU, nb = it - up * QI_GU; w_quant_item(F, up ? inp(15) : inp(14), D_FF, nb, SW + up * D_FF, F.ws + WS_WGU_D, 1 + up); }
        else { const int q = it - 2 * QI_GU, l = q >= QI_IN, nb = q - l * QI_IN; w_quant_item(F, inp(2) + (size_t)l * D * D_IN, D_IN, nb, SW + 2 * D_FF + l * D_IN, F.ws + WS_WIN + (size_t)l * D_IN * D, 0); }
    }
}
__device__ __forceinline__ void p0_convert(const Ctx& F, const float* const* in, int c, int G) {
    i8_quantize_items(F, 0, 2 * QI_GU, c, G); i8_quantize_items(F, 2 * QI_GU + QI_IN, QI_IN, c, G);
    const int gw = c * 8 + F.wave, NGW = G * 8;
    convert_items(F, in, E0, E1, gw, NGW); convert_items(F, in, E3, E8, gw, NGW);
}
__device__ __forceinline__ void p0_prologue(const Ctx& F) {
    i8_quantize_items(F, 2 * QI_GU, QI_IN, F.vcu, F.G);
    f32x2* ROPE = (f32x2*)(F.ws + WS_ROPE);
    for (int i = (F.vcu * 512 + F.tid); i < SEQ * 32; i += F.G * 512) {
        const int s = i >> 5, j = i & 31;
        const float invf = exp2f(-(float)j * (13.287712379549449f / 32.0f));
        const float ang = (float)s * invf;
        const float nrev = rintf(ang * 0.15915494309189535f);
        float r = fmaf(-nrev, 6.28125f, ang); r = fmaf(-nrev, 0.0019353071795864769f, r);
        ROPE[i] = (f32x2){cosf(r), sinf(r)};
    }
}

template <bool ROUTE, bool OUTI8 = false>
__device__ __forceinline__ void norm_phase(const Ctx& F, const float* X, const float* gain, bf16* H, const float* router) {
    const int gw = F.vcu * 8 + F.wave, NGW = F.G * 8;
    f32x4 gv[8];
#pragma unroll
    for (int j = 0; j < 8; ++j) gv[j] = ((const f32x4*)gain)[F.lane + 64 * j];
    LAS float* RT = (LAS float*)F.lds;
    LAS unsigned* lst = (LAS unsigned*)(F.lds + 65536);
    unsigned* TOPE = (unsigned*)(F.ws + WS_ROUTE + RT_TOPE); float* TOPG = (float*)(F.ws + WS_ROUTE + RT_TOPG);
    unsigned* TOPR = (unsigned*)(F.ws + WS_ROUTE + RT_TOPR); unsigned* CNTB = (unsigned*)(F.ws + WS_ROUTE + RT_CNTB);
    if (ROUTE) {
        for (int i = F.tid; i < D * NE; i += 512) { const int c = i >> 3, e = i & 7; RT[e * D + c] = router[i]; }
        __syncthreads();
    }
    int it = 0;
    f32x4 v[8];
    if (gw < T) { const f32x4* xr = (const f32x4*)(X + (size_t)gw * D) + F.lane;
#pragma unroll
        for (int j = 0; j < 8; ++j) v[j] = xr[64 * j]; }
    for (int m = gw; m < T; m += NGW, ++it) {
        f32x4 vn[8];
        if (m + NGW < T) { const f32x4* xr = (const f32x4*)(X + (size_t)(m + NGW) * D) + F.lane;
#pragma unroll
            for (int j = 0; j < 8; ++j) vn[j] = xr[64 * j]; }
        else {
#pragma unroll
            for (int j = 0; j < 8; ++j) vn[j] = v[j]; }
        float ss = 0.f;
#pragma unroll
        for (int j = 0; j < 8; ++j) ss += (v[j].x * v[j].x + v[j].y * v[j].y) + (v[j].z * v[j].z + v[j].w * v[j].w);
        ss = wave_sum(ss, F.lane);
        const float rstd = 1.0f / sqrtf(ss * (1.0f / D) + EPS);
        if (OUTI8) {
            float mx = 0.f;
#pragma unroll
            for (int j = 0; j < 8; ++j) { v[j] = v[j] * rstd * gv[j]; mx = fmaxf(mx, fmaxf(fmaxf(fabsf(v[j].x), fabsf(v[j].y)), fmaxf(fabsf(v[j].z), fabsf(v[j].w)))); }
#pragma unroll
            for (int o = 1; o < 64; o <<= 1) mx = fmaxf(mx, shfl_x(mx, o, F.lane));
            mx = fmaxf(mx, 1e-30f); const float inv = 127.0f / mx;
            if (F.lane == 0) ((float*)(F.ws + WS_SA))[m] = mx * (1.0f / 127.0f);
            unsigned* o4 = (unsigned*)((unsigned char*)H + (size_t)m * D) + F.lane;
#pragma unroll
            for (int j = 0; j < 8; ++j) { const int a = (int)rintf(v[j].x * inv), b2 = (int)rintf(v[j].y * inv), c = (int)rintf(v[j].z * inv), d = (int)rintf(v[j].w * inv);
                o4[64 * j] = ((unsigned)a & 0xffu) | (((unsigned)b2 & 0xffu) << 8) | (((unsigned)c & 0xffu) << 16) | (((unsigned)d & 0xffu) << 24); }
        } else if (ROUTE) {
            unsigned* o4 = (unsigned*)((unsigned char*)H + (size_t)m * D) + F.lane;
#pragma unroll
            for (int j = 0; j < 8; ++j) { v[j] = v[j] * rstd * gv[j]; o4[64 * j] = pg8::pk4_fp8(v[j].x, v[j].y, v[j].z, v[j].w); }
        } else {
            u32x2* o8 = (u32x2*)(H + (size_t)m * D) + F.lane;
#pragma unroll
            for (int j = 0; j < 8; ++j) { v[j] = v[j] * rstd * gv[j]; o8[64 * j] = (u32x2){pk2(v[j].x, v[j].y), pk2(v[j].z, v[j].w)}; }
        }
        if (ROUTE) {
            float lg[8];
#pragma unroll
            for (int e = 0; e < 8; ++e) { float a = 0.f;
#pragma unroll
                for (int j = 0; j < 8; ++j) { const f32x4 r = ((const LAS f32x4*)(RT + e * D))[F.lane + 64 * j]; a += (v[j].x * r.x + v[j].y * r.y) + (v[j].z * r.z + v[j].w * r.w); }
                lg[e] = wave_sum(a, F.lane); }
            float v1 = -3.0e38f, v2 = -3.0e38f; int e1 = 0, e2 = 0;
#pragma unroll
            for (int e = 0; e < 8; ++e) { const float x = lg[e]; if (x > v1) { v2 = v1; e2 = e1; v1 = x; e1 = e; } else if (x > v2) { v2 = x; e2 = e; } }
            const float g2 = 1.0f / (1.0f + expf(v1 - v2)), g1 = 1.0f - g2;
            if (F.lane == 0) { TOPE[m] = (unsigned)e1 | ((unsigned)e2 << 8); TOPG[2 * m] = g1; TOPG[2 * m + 1] = g2; lst[it * 8 + F.wave] = (unsigned)e1 | ((unsigned)e2 << 8); }
        }
#pragma unroll
        for (int j = 0; j < 8; ++j) v[j] = vn[j];
    }
    if (ROUTE) {
        __syncthreads();
        if (F.tid < NE) {
            const unsigned e = F.tid; unsigned cnt = 0;
            const int niter = (T + NGW - 1) / NGW;
            for (int i = 0; i < niter; ++i)
                for (int w = 0; w < 8; ++w) { const int m = F.vcu * 8 + w + i * NGW; if (m < T) { const unsigned ent = lst[i * 8 + w];
                    if ((ent & 0xffu) == e) TOPR[2 * m] = cnt++;
                    if (((ent >> 8) & 0xffu) == e) TOPR[2 * m + 1] = cnt++; } }
            CNTB[F.vcu * 8 + e] = cnt;
        }
    }
}

__device__ __forceinline__ void moe_tables(const Ctx& F) {
    const unsigned* CNTB = (const unsigned*)(F.ws + WS_ROUTE + RT_CNTB);
    {
        const int e = F.wave; unsigned tot = 0, pre = 0;
        for (int b = F.lane; b < F.G; b += 64) { const unsigned c = CNTB[b * 8 + e]; tot += c; pre += (b < F.vcu) ? c : 0u; }
#pragma unroll
        for (int o = 1; o < 64; o <<= 1) { tot += shfl_u(tot, F.lane ^ o); pre += shfl_u(pre, F.lane ^ o); }
        if (F.lane == 0) { F.lctl[LC_PRE + e] = pre; F.lctl[LC_TOT + e] = tot; }
    }
    __syncthreads();
    if (F.tid == 0) { unsigned tb = 0; for (int e = 0; e < NE; ++e) { F.lctl[LC_TB + e] = tb; tb += (F.lctl[LC_TOT + e] + 255u) >> 8; }
        F.lctl[LC_TB + 8] = tb; F.lctl[LC_NMT] = tb; }
    __syncthreads();
    if (F.tid < MAXMT) { unsigned e = 0;
#pragma unroll
        for (int k = 1; k < NE; ++k) e += ((unsigned)F.tid >= F.lctl[LC_TB + k]) ? 1u : 0u;
        F.lctl[LC_TEXP + F.tid] = e; }
    __syncthreads();
}

__device__ __forceinline__ void slot_tables(const Ctx& F) {
    const int gw = F.vcu * 8 + F.wave, NGW = F.G * 8;
    const unsigned* TOPE = (const unsigned*)(F.ws + WS_ROUTE + RT_TOPE); const unsigned* TOPR = (const unsigned*)(F.ws + WS_ROUTE + RT_TOPR); unsigned* SLOT = (unsigned*)(F.ws + WS_ROUTE + RT_SLOT);
    unsigned* ROWOF = (unsigned*)(F.ws + WS_ROUTE + RT_ROWOF);
    for (int m0 = gw; m0 < T; m0 += 32 * NGW) {
        const int m = m0 + (F.lane >> 1) * NGW, k = F.lane & 1;
        if (m < T) { const unsigned e = (TOPE[m] >> (8 * k)) & 0xffu; const unsigned slot = F.lctl[LC_TB + e] * 256u + F.lctl[LC_PRE + e] + TOPR[2 * m + k];
            SLOT[2 * m + k] = slot; ROWOF[slot] = (unsigned)m; }
    }
    if (F.vcu == 0) {
        for (int e = 0; e < NE; ++e) { const unsigned lo = F.lctl[LC_TB + e] * 256u + F.lctl[LC_TOT + e], hi = F.lctl[LC_TB + e + 1] * 256u;
            for (unsigned i = lo + F.tid; i < hi; i += 512) ROWOF[i] = 0u; }
    }
}

__device__ __forceinline__ void final_phase(const Ctx& F, const float* gain) {
    const int gw = F.vcu * 8 + F.wave, NGW = F.G * 8;
    const float* TOPG = (const float*)(F.ws + WS_ROUTE + RT_TOPG); const unsigned* SLOT = (const unsigned*)(F.ws + WS_ROUTE + RT_SLOT);
    const bf16* OS = (const bf16*)(F.ws + WS_PROJ); const bf16* OS2 = (const bf16*)(F.ws + WS_H);
    LAS unsigned char* SPL = (LAS unsigned char*)(F.lctl + LC_SPLIT);
    { pg8::SplitOrder S; S.init((int)F.lctl[LC_NMT], D / 256, F.G, 0, nullptr); S.init2();
      for (int i = F.tid; i < MAXMT * 8; i += 512) SPL[i] = 0xffu;
      __syncthreads();
      if (F.tid < S.rem) { pg8::Unit u; if (S.unit_at((long)S.R * S.G + F.tid, u)) SPL[u.pm * 8 + u.pn] = (unsigned char)F.tid; }
      __syncthreads(); }
    f32x4 gv[8];
#pragma unroll
    for (int j = 0; j < 8; ++j) gv[j] = ((const f32x4*)gain)[F.lane + 64 * j];
    float g1 = 0.f, g2 = 0.f, ng1 = 0.f, ng2 = 0.f; unsigned s1 = 0, s2 = 0, ns1 = 0, ns2 = 0;
    f32x4 xv[8]; u32x2 av[8], bv[8];
    if (gw < T) { g1 = TOPG[2 * gw]; g2 = TOPG[2 * gw + 1]; s1 = SLOT[2 * gw]; s2 = SLOT[2 * gw + 1];
        const f32x4* xr0 = (const f32x4*)(F.out + (size_t)gw * D) + F.lane; const u32x2* o1 = (const u32x2*)(OS + (size_t)s1 * D) + F.lane; const u32x2* o2 = (const u32x2*)(OS + (size_t)s2 * D) + F.lane;
#pragma unroll
        for (int j = 0; j < 8; ++j) { xv[j] = xr0[64 * j]; av[j] = o1[64 * j]; bv[j] = o2[64 * j]; } }
    if (gw + NGW < T) { const int mn = gw + NGW; ng1 = TOPG[2 * mn]; ng2 = TOPG[2 * mn + 1]; ns1 = SLOT[2 * mn]; ns2 = SLOT[2 * mn + 1]; }
    for (int m = gw; m < T; m += NGW) {
        f32x4* xr = (f32x4*)(F.out + (size_t)m * D) + F.lane;
        f32x4 xn[8]; u32x2 an[8], bn[8]; float fg1 = 0.f, fg2 = 0.f; unsigned fs1 = 0, fs2 = 0;
        if (m + NGW < T) { const f32x4* xrn = (const f32x4*)(F.out + (size_t)(m + NGW) * D) + F.lane; const u32x2* o1 = (const u32x2*)(OS + (size_t)ns1 * D) + F.lane; const u32x2* o2 = (const u32x2*)(OS + (size_t)ns2 * D) + F.lane;
#pragma unroll
            for (int j = 0; j < 8; ++j) { xn[j] = xrn[64 * j]; an[j] = o1[64 * j]; bn[j] = o2[64 * j]; } }
        else {
#pragma unroll
            for (int j = 0; j < 8; ++j) { xn[j] = xv[j]; an[j] = av[j]; bn[j] = bv[j]; } }
        if (m + 2 * NGW < T) { const int mf = m + 2 * NGW; fg1 = TOPG[2 * mf]; fg2 = TOPG[2 * mf + 1]; fs1 = SLOT[2 * mf]; fs2 = SLOT[2 * mf + 1]; }
        f32x4 v[8]; float ss = 0.f;
#pragma unroll
        for (int j = 0; j < 8; ++j) { const u32x2 a = av[j], b = bv[j]; v[j] = xv[j];
            float va[4] = {bflo(a.x), bfhi(a.x), bflo(a.y), bfhi(a.y)}, vb[4] = {bflo(b.x), bfhi(b.x), bflo(b.y), bfhi(b.y)};
            const unsigned q1 = SPL[(s1 >> 8) * 8 + j], q2 = SPL[(s2 >> 8) * 8 + j];
            if (q1 != 0xffu) { const u32x2 c = ((const u32x2*)(OS2 + ((size_t)q1 * 256 + (s1 & 255u)) * 256))[F.lane]; va[0] += bflo(c.x); va[1] += bfhi(c.x); va[2] += bflo(c.y); va[3] += bfhi(c.y); }
            if (q2 != 0xffu) { const u32x2 c = ((const u32x2*)(OS2 + ((size_t)q2 * 256 + (s2 & 255u)) * 256))[F.lane]; vb[0] += bflo(c.x); vb[1] += bfhi(c.x); vb[2] += bflo(c.y); vb[3] += bfhi(c.y); }
            v[j].x += g1 * va[0] + g2 * vb[0]; v[j].y += g1 * va[1] + g2 * vb[1]; v[j].z += g1 * va[2] + g2 * vb[2]; v[j].w += g1 * va[3] + g2 * vb[3];
            ss += (v[j].x * v[j].x + v[j].y * v[j].y) + (v[j].z * v[j].z + v[j].w * v[j].w); }
        ss = wave_sum(ss, F.lane);
        const float rstd = 1.0f / sqrtf(ss * (1.0f / D) + EPS);
#pragma unroll
        for (int j = 0; j < 8; ++j) xr[64 * j] = v[j] * rstd * gv[j];
#pragma unroll
        for (int j = 0; j < 8; ++j) { xv[j] = xn[j]; av[j] = an[j]; bv[j] = bn[j]; }
        g1 = ng1; g2 = ng2; s1 = ns1; s2 = ns2; ng1 = fg1; ng2 = fg2; ns1 = fs1; ns2 = fs2;
    }
}

__device__ __forceinline__ void lru_unit(const Ctx& F, int l, int b, int n, int hf, const float* const* in) {
    asm volatile("" : "+s"(l), "+s"(b), "+s"(n), "+s"(hf));
    const int tid = F.tid, wave = F.wave, lane = F.lane, fr = lane & 15, fq = lane >> 4, nt = wave & 3, mh = wave >> 2;
    LAS unsigned char* XC = F.lds; LAS float* EX = (LAS float*)(F.lds + 32768);
    LAS float* HS = EX + 256;
    static_assert(32768 + (256 + 128 * 68) * 4 <= LDSCTL_OFF, "RG-LRU LDS map");
    const bf16* PROJ = (const bf16*)(F.ws + WS_PROJ); bf16* Y = (bf16*)(F.ws + WS_H); float* SSP = (float*)(F.ws + WS_SSP);
    const bf16* WL = (const bf16*)(F.ws + WS_WLRU) + (size_t)l * 2 * 8 * 16384;
    const int os_g = tid & 7, os_tok = tid >> 3;
    float gn[8]; { const f32x4 a = *(const f32x4*)(inp(10) + (size_t)l * D_RNN + n * 128 + hf * 64 + 8 * os_g), c = *(const f32x4*)(inp(10) + (size_t)l * D_RNN + n * 128 + hf * 64 + 8 * os_g + 4);
        gn[0] = a.x; gn[1] = a.y; gn[2] = a.z; gn[3] = a.w; gn[4] = c.x; gn[5] = c.y; gn[6] = c.z; gn[7] = c.w; }
    const int cg = tid & 15, tl = tid >> 4, cch = n * 128 + cg * 8;
    const int prow0 = ((tl >> 4) << 6) | ((tl & 3) << 4) | (((tl >> 2) & 3) << 2);
    float cw[4][8], cb[8];
#pragma unroll
    for (int tap = 0; tap < 4; ++tap) { const f32x4 a = *(const f32x4*)(inp(3) + (size_t)(l * 4 + tap) * D_RNN + cch), c = *(const f32x4*)(inp(3) + (size_t)(l * 4 + tap) * D_RNN + cch + 4);
        cw[tap][0] = a.x; cw[tap][1] = a.y; cw[tap][2] = a.z; cw[tap][3] = a.w; cw[tap][4] = c.x; cw[tap][5] = c.y; cw[tap][6] = c.z; cw[tap][7] = c.w; }
    { const f32x4 a = *(const f32x4*)(inp(4) + (size_t)l * D_RNN + cch), c = *(const f32x4*)(inp(4) + (size_t)l * D_RNN + cch + 4);
        cb[0] = a.x; cb[1] = a.y; cb[2] = a.z; cb[3] = a.w; cb[4] = c.x; cb[5] = c.y; cb[6] = c.z; cb[7] = c.w; }
    const int lc = hf * 64 + nt * 16 + fr, gc = n * 128 + lc;
    const float ba_c = inp(6)[l * D_RNN + gc], bx_c = inp(8)[l * D_RNN + gc];
    const float sp8 = 8.0f * log1pf(expf(-inp(9)[l * D_RNN + gc]));
    bf16x8 Wa[4], Wx[4];
#pragma unroll
    for (int ks = 0; ks < 4; ++ks) { Wa[ks] = *(const bf16x8*)(WL + (size_t)((0 * 8 + n) * 128 + lc) * 128 + 32 * ks + 8 * fq);
                                     Wx[ks] = *(const bf16x8*)(WL + (size_t)((1 * 8 + n) * 128 + lc) * 128 + 32 * ks + 8 * fq); }
    float Hc = 0.f;
    u32x4 xr[7];
#pragma unroll
    for (int r = 0; r < 7; ++r) { const int t = 4 * tl - 3 + r; xr[r] = (u32x4){0u, 0u, 0u, 0u}; if (t >= 0) xr[r] = *(const u32x4*)(PROJ + (size_t)(b * SEQ + t) * D_IN + cch); }
    for (int ck = 0; ck < SEQ / 128; ++ck) {
        const int t0 = ck * 128;
        {
            float xv[7][8];
#pragma unroll
            for (int r = 0; r < 7; ++r) { const u32x4 w = xr[r];
                xv[r][0] = bflo(w.x); xv[r][1] = bfhi(w.x); xv[r][2] = bflo(w.y); xv[r][3] = bfhi(w.y); xv[r][4] = bflo(w.z); xv[r][5] = bfhi(w.z); xv[r][6] = bflo(w.w); xv[r][7] = bfhi(w.w); }
#pragma unroll
            for (int q = 0; q < 4; ++q) { float y[8];
#pragma unroll
                for (int c = 0; c < 8; ++c) { float a = cb[c];
#pragma unroll
                    for (int tap = 0; tap < 4; ++tap) a += cw[tap][c] * xv[q + tap][c];
                    y[c] = a; }
                *(LAS u32x4*)(XC + tile_off(prow0 + q, 8 * cg, 4)) = (u32x4){pk2(y[0], y[1]), pk2(y[2], y[3]), pk2(y[4], y[5]), pk2(y[6], y[7])}; }
        }
        __syncthreads();
        if (ck + 1 < SEQ / 128) {
#pragma unroll
            for (int r = 0; r < 7; ++r) xr[r] = *(const u32x4*)(PROJ + (size_t)(b * SEQ + t0 + 128 + 4 * tl - 3 + r) * D_IN + cch);
        }
        u32x4 gpre[2];
#pragma unroll
        for (int j = 0; j < 2; ++j) gpre[j] = *(const u32x4*)(PROJ + (size_t)(b * SEQ + t0 + os_tok + 64 * j) * D_IN + OFF_GATE + n * 128 + hf * 64 + 8 * os_g);
        float av[16], bv[16];
#pragma unroll
        for (int mi = 0; mi < 4; ++mi) {
            const int mt = 4 * mh + mi;
            f32x4 aa = (f32x4){0.f, 0.f, 0.f, 0.f}, ax = (f32x4){0.f, 0.f, 0.f, 0.f};
#pragma unroll
            for (int ks = 0; ks < 4; ++ks) { const bf16x8 xf = lds_frag(XC, tile_off(16 * mt + fr, 32 * ks + 8 * fq, 4)); aa = MFMA16(xf, Wa[ks], aa); ax = MFMA16(xf, Wx[ks], ax); }
#pragma unroll
            for (int i = 0; i < 4; ++i) { const int tok = 64 * mh + 16 * fq + 4 * mi + i;
                const float r = sigmoidf_(aa[i] + ba_c), ig = sigmoidf_(ax[i] + bx_c);
                const float a = __expf(-sp8 * r); float mult = sqrtf(fmaxf(1.0f - a * a, 0.f));
                if (ck == 0 && tok == 0) mult = 1.0f;
                const float xcv = __builtin_bit_cast(float, (unsigned)(*(const LAS unsigned short*)(XC + tile_off(16 * mt + 4 * fq + i, lc, 4))) << 16);
                av[4 * mi + i] = a; bv[4 * mi + i] = mult * ig * xcv; }
        }
        float P = av[0], Q = bv[0];
#pragma unroll
        for (int k = 1; k < 16; ++k) { P *= av[k]; Q = Q * av[k] + bv[k]; }
        { const float P1 = shfl_idx(P, lane - 16), Q1 = shfl_idx(Q, lane - 16); if (fq >= 1) { Q = P * Q1 + Q; P = P * P1; } }
        { const float P2 = shfl_idx(P, lane - 32), Q2 = shfl_idx(Q, lane - 32); if (fq >= 2) { Q = P * Q2 + Q; P = P * P2; } }
        float Pex = shfl_idx(P, lane - 16), Qex = shfl_idx(Q, lane - 16); if (fq == 0) { Pex = 1.0f; Qex = 0.f; }
        const float Pc = shfl_idx(P, fr + 48), Qc = shfl_idx(Q, fr + 48);
        if (fq == 0) { EX[((mh * 4 + nt) * 16 + fr) * 2] = Pc; EX[((mh * 4 + nt) * 16 + fr) * 2 + 1] = Qc; }
        __syncthreads();
        const float P0 = EX[((0 * 4 + nt) * 16 + fr) * 2], Q0 = EX[((0 * 4 + nt) * 16 + fr) * 2 + 1], P1h = EX[((1 * 4 + nt) * 16 + fr) * 2], Q1h = EX[((1 * 4 + nt) * 16 + fr) * 2 + 1];
        const float Hmid = P0 * Hc + Q0;
        const float Hw = (mh == 0) ? Hc : Hmid;
        Hc = P1h * Hmid + Q1h;
        {
            float h = Pex * Hw + Qex;
#pragma unroll
            for (int k = 0; k < 16; ++k) { h = av[k] * h + bv[k]; HS[(64 * mh + 16 * fq + k) * 68 + nt * 16 + fr] = h; }
        }
        __syncthreads();
#pragma unroll
        for (int j = 0; j < 2; ++j) { const int tk = os_tok + 64 * j; const size_t row = (size_t)(b * SEQ + t0 + tk);
            const u32x4 gw = gpre[j];
            const f32x4 h0 = *(const LAS f32x4*)(HS + tk * 68 + 8 * os_g), h1 = *(const LAS f32x4*)(HS + tk * 68 + 8 * os_g + 4);
            const float hh[8] = {h0.x, h0.y, h0.z, h0.w, h1.x, h1.y, h1.z, h1.w};
            {
                float ss = ((hh[0] * hh[0] + hh[1] * hh[1]) + (hh[2] * hh[2] + hh[3] * hh[3])) + ((hh[4] * hh[4] + hh[5] * hh[5]) + (hh[6] * hh[6] + hh[7] * hh[7]));
                ss += shfl_x(ss, 1, lane); ss += shfl_x(ss, 2, lane); ss += shfl_x(ss, 4, lane);
                if (os_g == 0) SSP[row * 16 + (n * 2 + hf)] = ss; }
            const float g[8] = {bflo(gw.x), bfhi(gw.x), bflo(gw.y), bfhi(gw.y), bflo(gw.z), bfhi(gw.z), bflo(gw.w), bfhi(gw.w)}; float y[8];
#pragma unroll
            for (int r = 0; r < 8; ++r) { const float x = g[r]; y[r] = hh[r] * gn[r] * (x * sigmoidf_(1.5957691216f * (x + 0.044715f * x * x * x))); }
            *(u32x4*)(Y + row * D + n * 128 + hf * 64 + 8 * os_g) = (u32x4){pk2(y[0], y[1]), pk2(y[2], y[3]), pk2(y[4], y[5]), pk2(y[6], y[7])}; }
    }
    __syncthreads();
}

typedef short s16x4 __attribute__((ext_vector_type(4)));
__device__ __forceinline__ bf16x8 tr_frag(LAS unsigned char* base, int stride, int krow0, int col0, int lane) {
    const int g = lane >> 4, i = lane & 15, q = i >> 2, p = i & 3;
    const s16x4 lo = __builtin_amdgcn_ds_read_tr16_b64_v4i16((LAS s16x4*)(base + (krow0 + 8 * g + q) * stride + (col0 + 4 * p) * 2));
    const s16x4 hi = __builtin_amdgcn_ds_read_tr16_b64_v4i16((LAS s16x4*)(base + (krow0 + 8 * g + 4 + q) * stride + (col0 + 4 * p) * 2));
    return __builtin_shufflevector(lo, hi, 0, 1, 2, 3, 4, 5, 6, 7);
}
constexpr int SKZ = 144, SVS = 288;
__device__ __forceinline__ void ret_unit(const Ctx& F, int l, int b, int h, int c0, int c1, const float* const* in) {
    asm volatile("" : "+s"(l), "+s"(b), "+s"(h), "+s"(c0), "+s"(c1));
    const int tid = F.tid, wave = F.wave, lane = F.lane, fr = lane & 15, fq = lane >> 4;
    LAS unsigned char* Qs = F.lds; LAS unsigned char* Ks = F.lds + 16384; LAS unsigned char* Kz = F.lds + 32768; LAS unsigned char* Vs = Kz + 128 * SKZ;
    LAS unsigned char* Ps = Vs + 128 * SVS; LAS unsigned char* STs = Ps + 32768;
    static_assert(32768 + 128 * SKZ + 128 * SVS + 32768 + 16384 <= LDSCTL_OFF, "retention LDS map");
    const bf16* PROJ = (const bf16*)(F.ws + WS_PROJ); bf16* Y = (bf16*)(F.ws + WS_H); const f32x2* ROPE = (const f32x2*)(F.ws + WS_ROPE);
    const float* rg = inp(11) + (size_t)l * 1024 + h * 128;
    const float lgm = log2f(1.0f - exp2f(-5.0f - (float)h));
    const float cdec = exp2f(128.0f * lgm);
    const int tok = tid >> 2, seg = tid & 3;
    const float zeta = exp2f((float)(127 - tok) * lgm);
    f32x4 accS[4];
#pragma unroll
    for (int dt = 0; dt < 4; ++dt) accS[dt] = (f32x4){0.f, 0.f, 0.f, 0.f};
    f32x4 pr_cs[4]; u32x4 pr_k[2], pr_v[4], pr_q[2];
#define RET_LOAD(ckk, want_q) do { const size_t ro_ = (size_t)(b * SEQ + (ckk) * 128 + tok) * D_IN; const f32x4* cs_ = (const f32x4*)(ROPE + (size_t)((ckk) * 128 + tok) * 32 + 8 * seg); \
        _Pragma("unroll") for (int i_ = 0; i_ < 4; ++i_) pr_cs[i_] = cs_[i_]; \
        pr_k[0] = *(const u32x4*)(PROJ + ro_ + OFF_K + h * 64 + 8 * seg); pr_k[1] = *(const u32x4*)(PROJ + ro_ + OFF_K + h * 64 + 32 + 8 * seg); \
        _Pragma("unroll") for (int q_ = 0; q_ < 4; ++q_) pr_v[q_] = *(const u32x4*)(PROJ + ro_ + OFF_V + h * 128 + 32 * seg + 8 * q_); \
        if (want_q) { pr_q[0] = *(const u32x4*)(PROJ + ro_ + OFF_Q + h * 64 + 8 * seg); pr_q[1] = *(const u32x4*)(PROJ + ro_ + OFF_Q + h * 64 + 32 + 8 * seg); } } while (0)
    pr_q[0] = pr_q[1] = (u32x4){0u, 0u, 0u, 0u};
    RET_LOAD(0, c0 == 0);
    for (int ck = 0; ck < c1; ++ck) {
        const int t0 = ck * 128; const bool full = ck >= c0;
        if (full) {
#pragma unroll
            for (int dt = 0; dt < 4; ++dt) *(LAS u32x2*)(STs + tile_off(16 * wave + fr, 16 * dt + 4 * fq, 2)) = (u32x2){pk2(accS[dt][0], accS[dt][1]), pk2(accS[dt][2], accS[dt][3])};
        }
        {
            float c[8], s[8];
#pragma unroll
            for (int i = 0; i < 4; ++i) { const f32x4 v = pr_cs[i]; c[2 * i] = v.x; s[2 * i] = v.y; c[2 * i + 1] = v.z; s[2 * i + 1] = v.w; }
            if (full) {
                const u32x4 w1 = pr_q[0], w2 = pr_q[1];
                const float x1[8] = {bflo(w1.x), bfhi(w1.x), bflo(w1.y), bfhi(w1.y), bflo(w1.z), bfhi(w1.z), bflo(w1.w), bfhi(w1.w)};
                const float x2[8] = {bflo(w2.x), bfhi(w2.x), bflo(w2.y), bfhi(w2.y), bflo(w2.z), bfhi(w2.z), bflo(w2.w), bfhi(w2.w)};
                float r1[8], r2[8];
#pragma unroll
                for (int i = 0; i < 8; ++i) { r1[i] = x1[i] * c[i] - x2[i] * s[i]; r2[i] = x1[i] * s[i] + x2[i] * c[i]; }
                *(LAS u32x4*)(Qs + tile_off(tok, 8 * seg, 2)) = (u32x4){pk2(r1[0], r1[1]), pk2(r1[2], r1[3]), pk2(r1[4], r1[5]), pk2(r1[6], r1[7])};
                *(LAS u32x4*)(Qs + tile_off(tok, 32 + 8 * seg, 2)) = (u32x4){pk2(r2[0], r2[1]), pk2(r2[2], r2[3]), pk2(r2[4], r2[5]), pk2(r2[6], r2[7])};
            }
            {
                const u32x4 w1 = pr_k[0], w2 = pr_k[1];
                const float x1[8] = {bflo(w1.x), bfhi(w1.x), bflo(w1.y), bfhi(w1.y), bflo(w1.z), bfhi(w1.z), bflo(w1.w), bfhi(w1.w)};
                const float x2[8] = {bflo(w2.x), bfhi(w2.x), bflo(w2.y), bfhi(w2.y), bflo(w2.z), bfhi(w2.z), bflo(w2.w), bfhi(w2.w)};
                float r1[8], r2[8];
#pragma unroll
                for (int i = 0; i < 8; ++i) { r1[i] = (x1[i] * c[i] - x2[i] * s[i]) * 0.125f; r2[i] = (x1[i] * s[i] + x2[i] * c[i]) * 0.125f; }
                if (full) {
                    *(LAS u32x4*)(Ks + tile_off(tok, 8 * seg, 2)) = (u32x4){pk2(r1[0], r1[1]), pk2(r1[2], r1[3]), pk2(r1[4], r1[5]), pk2(r1[6], r1[7])};
                    *(LAS u32x4*)(Ks + tile_off(tok, 32 + 8 * seg, 2)) = (u32x4){pk2(r2[0], r2[1]), pk2(r2[2], r2[3]), pk2(r2[4], r2[5]), pk2(r2[6], r2[7])};
                }
#pragma unroll
                for (int i = 0; i < 8; ++i) { r1[i] *= zeta; r2[i] *= zeta; }
                *(LAS u32x4*)(Kz + tok * SKZ + 16 * seg) = (u32x4){pk2(r1[0], r1[1]), pk2(r1[2], r1[3]), pk2(r1[4], r1[5]), pk2(r1[6], r1[7])};
                *(LAS u32x4*)(Kz + tok * SKZ + 64 + 16 * seg) = (u32x4){pk2(r2[0], r2[1]), pk2(r2[2], r2[3]), pk2(r2[4], r2[5]), pk2(r2[6], r2[7])};
            }
#pragma unroll
            for (int q = 0; q < 4; ++q) *(LAS u32x4*)(Vs + tok * SVS + 64 * seg + 16 * q) = pr_v[q];
        }
        __syncthreads();
        if (ck + 1 < c1) RET_LOAD(ck + 1, ck + 1 >= c0);
        if (full) {
            bf16x8 qf[2];
#pragma unroll
            for (int ks = 0; ks < 2; ++ks) qf[ks] = lds_frag(Qs, tile_off(16 * wave + fr, 32 * ks + 8 * fq, 2));
            int irow = 16 * wave + fr; float lgv = lgm; asm volatile("" : "+v"(irow), "+v"(lgv));
#pragma unroll
            for (int jt = 0; jt < 8; ++jt) {
                u32x2 pw = (u32x2){0u, 0u};
                if (jt <= wave) {
                    f32x4 sc = (f32x4){0.f, 0.f, 0.f, 0.f};
#pragma unroll
                    for (int ks = 0; ks < 2; ++ks) sc = MFMA16(lds_frag(Ks, tile_off(16 * jt + fr, 32 * ks + 8 * fq, 2)), qf[ks], sc);
                    float p[4];
#pragma unroll
                    for (int r = 0; r < 4; ++r) { const int dij = irow - (16 * jt + 4 * fq + r); p[r] = (dij >= 0) ? sc[r] * __builtin_amdgcn_exp2f((float)dij * lgv) : 0.f; }
                    pw = (u32x2){pk2(p[0], p[1]), pk2(p[2], p[3])};
                }
                *(LAS u32x2*)(Ps + tile_off(irow, 16 * jt + 4 * fq, 4)) = pw;
            }
            __syncthreads();
            bf16x8 pf[4];
#pragma unroll
            for (int ks = 0; ks < 4; ++ks) pf[ks] = lds_frag(Ps, tile_off(16 * wave + fr, 32 * ks + 8 * fq, 4));
            const float xi = __builtin_amdgcn_exp2f((float)(irow + 1) * lgv);
            float o[8][4]; float sum = 0.f;
#pragma unroll
            for (int et = 0; et < 8; ++et) {
                f32x4 ao = (f32x4){0.f, 0.f, 0.f, 0.f}, ac = (f32x4){0.f, 0.f, 0.f, 0.f};
#pragma unroll
                for (int ks = 0; ks < 4; ++ks) if (32 * ks <= 16 * wave + 15) ao = MFMA16(tr_frag(Vs, SVS, 32 * ks, 16 * et, lane), pf[ks], ao);
#pragma unroll
                for (int ks = 0; ks < 2; ++ks) ac = MFMA16(lds_frag(STs, tile_off(16 * et + fr, 32 * ks + 8 * fq, 2)), qf[ks], ac);
#pragma unroll
                for (int r = 0; r < 4; ++r) { o[et][r] = ao[r] + xi * ac[r]; sum += o[et][r]; }
            }
            sum += shfl_x(sum, 16, lane); sum += shfl_x(sum, 32, lane);
            const float mean = sum * (1.0f / 128.0f); float var = 0.f;
#pragma unroll
            for (int et = 0; et < 8; ++et)
#pragma unroll
                for (int r = 0; r < 4; ++r) { const float d = o[et][r] - mean; var += d * d; }
            var += shfl_x(var, 16, lane); var += shfl_x(var, 32, lane);
            const float rstd = 1.0f / sqrtf(var * (1.0f / 128.0f) + EPS);
            {
                const size_t rowo = (size_t)(b * SEQ + t0 + irow);
#pragma unroll
                for (int et = 0; et < 8; ++et) {
                    const u32x2 gw = *(const u32x2*)(PROJ + rowo * D_IN + OFF_G + h * 128 + 16 * et + 4 * fq);
                    const f32x4 gn = *(const f32x4*)(rg + 16 * et + 4 * fq);
                    const float g[4] = {bflo(gw.x), bfhi(gw.x), bflo(gw.y), bfhi(gw.y)};
                    float y[4];
#pragma unroll
                    for (int r = 0; r < 4; ++r) y[r] = (o[et][r] - mean) * rstd * gn[r] * (g[r] * sigmoidf_(g[r]));
                    *(u32x2*)(Y + rowo * D + 1024 + h * 128 + 16 * et + 4 * fq) = (u32x2){pk2(y[0], y[1]), pk2(y[2], y[3])};
                }
            }
        }
        {
            bf16x8 vf[4];
#pragma unroll
            for (int ks = 0; ks < 4; ++ks) vf[ks] = tr_frag(Vs, SVS, 32 * ks, 16 * wave, lane);
#pragma unroll
            for (int dt = 0; dt < 4; ++dt) { accS[dt] = accS[dt] * cdec;
#pragma unroll
                for (int ks = 0; ks < 4; ++ks) accS[dt] = MFMA16(tr_frag(Kz, SKZ, 32 * ks, 16 * dt, lane), vf[ks], accS[dt]); }
        }
        __syncthreads();
    }
#undef RET_LOAD
}

__device__ __forceinline__ void ylru_phase(const Ctx& F, int l, const float* gain) {
    const int gw = F.vcu * 8 + F.wave, NGW = F.G * 8;
    const float* HLRU = (const float*)(F.ws + WS_HID); const float* SSP = (const float*)(F.ws + WS_SSP); const bf16* PROJ = (const bf16*)(F.ws + WS_PROJ); bf16* Y = (bf16*)(F.ws + WS_H);
    f32x4 gv[4];
#pragma unroll
    for (int j = 0; j < 4; ++j) gv[j] = ((const f32x4*)(gain + (size_t)l * D_RNN))[F.lane + 64 * j];
    for (int m = gw; m < T; m += NGW) {
        float ss = 0.f;
#pragma unroll
        for (int n = 0; n < 16; ++n) ss += SSP[(size_t)n * T + m];
        const float rstd = 1.0f / sqrtf(ss * (1.0f / D_RNN) + EPS);
#pragma unroll
        for (int j = 0; j < 4; ++j) { const f32x4 hh = ((const f32x4*)(HLRU + (size_t)m * D_RNN))[F.lane + 64 * j];
            const u32x2 gw2 = ((const u32x2*)(PROJ + (size_t)m * D_IN + OFF_GATE))[F.lane + 64 * j];
            const float g[4] = {bflo(gw2.x), bfhi(gw2.x), bflo(gw2.y), bfhi(gw2.y)}; float y[4];
#pragma unroll
            for (int r = 0; r < 4; ++r) { const float x = g[r]; const float ge = x * sigmoidf_(1.5957691216f * (x + 0.044715f * x * x * x)); y[r] = hh[r] * rstd * gv[j][r] * ge; }
            ((u32x2*)(Y + (size_t)m * D))[F.lane + 64 * j] = (u32x2){pk2(y[0], y[1]), pk2(y[2], y[3])}; }
    }
}

constexpr int NPHASE = 20;
struct Args { const float* in[22]; float* out; unsigned char* ws; int ph_lo, ph_hi, li, pad; };
__global__ void __launch_bounds__(512, 2) fwd(Args args) {
    extern __shared__ __attribute__((aligned(16))) unsigned char lds_raw[];
    Ctx F;
    F.lds = (LAS unsigned char*)lds_raw; F.lctl = (LAS unsigned*)(F.lds + LDSCTL_OFF);
    F.tid = threadIdx.x; F.lane = F.tid & 63; F.wave = __builtin_amdgcn_readfirstlane(F.tid >> 6);
    F.G = gridDim.x; { const int bx = blockIdx.x; F.vcu = (F.G % 8 == 0) ? (bx % 8) * (F.G / 8) + bx / 8 : bx; }
    F.out = args.out; F.ws = args.ws;
    for (int u = F.tid; u < (LDS_BYTES - LDSCTL_OFF) / 4; u += 512) F.lctl[u] = 0u;
    __syncthreads();
    unsigned* ctl = (unsigned*)(args.ws + WS_CTL);
    XcdBarrier bar = xcd_barrier_post(ctl + CW_BAR + args.li * XCD_BAR_WORDS, (volatile LAS unsigned*)(F.lctl + LC_BAR));
    const int lo = args.ph_lo, hi = args.ph_hi;
#define IN(k) (lo <= (k) && (k) < hi)
#define SEAM(k) do { if ((k) + 1 < hi) xcd_barrier(bar); } while (0)
    bf16* Hb = (bf16*)(args.ws + WS_H); bf16* PROJ = (bf16*)(args.ws + WS_PROJ); bf16* HID = (bf16*)(args.ws + WS_HID);

    if (IN(0)) REPEAT(REP_P0) { const Ctx P = fresh(F); p0_prologue(P); norm_phase<false, true>(P, inp(0), inp(1), Hb, nullptr); SEAM(0); }

    for (int l = 0; l < 2; ++l) {
        const int pb = 1 + 9 * l;
        const float* Xin = (l == 0) ? inp(0) : args.out;
        if (IN(pb + 0) && l == 1) REPEAT(REP_NORM) { const Ctx P = fresh(F); norm_phase<false, true>(P, Xin, inp(1) + (size_t)l * D, Hb, nullptr); SEAM(pb + 0); }
        if (IN(pb + 1)) REPEAT(REP_GIN) {
            const Ctx P = fresh(F);
            int Gv = F.G, cv = (int)blockIdx.x; bool gemm = true;
            if (l == 0) {
                const int xcd = (int)blockIdx.x % 8, idx = (int)blockIdx.x / 8, per = F.G / 8, nc = (F.G % 8 == 0 && per > GIN0_NC) ? GIN0_NC : 0;
                int cc = F.vcu, cg = F.G; bool conv = true;
                if (nc != 0) { if (idx >= per - nc) { cc = (idx - (per - nc)) * 8 + xcd; cg = nc * 8; gemm = false; } else { conv = false; Gv = (per - nc) * 8; cv = idx * 8 + xcd; } }
                if (conv) p0_convert(P, args.in, cc, cg);
            }
            if (gemm) {
                pg8::Gemm g{Hb, args.ws + WS_WIN + (size_t)l * D_IN * D, D}; pg8::ScaleOrder S; S.init(T / 256, D_IN / 256, Gv, cv, nullptr);
                S.SA = (const float*)(args.ws + WS_SA); S.SW = (const float*)(args.ws + WS_SW) + 2 * D_FF + (size_t)l * D_IN; S.cols = 0; S.st = (LAS float*)(P.lds + pg8::RS_OFF); S.tid = P.tid;
                pg8::EpiOut<true> E{nullptr, nullptr, PROJ, D_IN, 1, S.SA, S.SW, nullptr, S.st};
                pg8::gemm_phase<pg8::EpiOut<true>, pg8::ScaleOrder, true, true, 2>(P.lds, P.tid, g, S, E);
            }
            SEAM(pb + 1);
        }
        if (IN(pb + 2)) REPEAT(REP_MIX) {
            const Ctx P = fresh(F);
            for (int u = blockIdx.x; u < 128; u += F.G) REPEAT(REP_RET) { const int bh = u & 63, th = u >> 6; ret_unit(P, l, bh >> 3, bh & 7, th ? 9 : 0, th ? 16 : 9, args.in); }
            { int u0 = (int)blockIdx.x - 128; if (u0 < 0) u0 += F.G; for (int u = u0; u < 128; u += F.G) REPEAT(REP_LRU) { const int bn = u & 63; lru_unit(P, l, bn >> 3, bn & 7, u >> 6, args.in); } }
            SEAM(pb + 2);
        }
        if (IN(pb + 4)) {
            const Ctx P = fresh(F);
            pg8::Gemm g{Hb, (const bf16*)(args.ws + WS_WOUT) + (size_t)l * D * D, 2 * D}; pg8::RowScaleOrder S; S.init(T / 256, D / 256, F.G, (int)blockIdx.x, nullptr);
            S.ssp = (const float*)(args.ws + WS_SSP); S.rs = (LAS float*)(P.lds + pg8::RS_OFF); S.tid = P.tid;
            pg8::EpiOut<false> E{Xin, args.out, nullptr, D, 0, nullptr, nullptr};
            pg8::gemm_phase<pg8::EpiOut<false>, pg8::RowScaleOrder, true, true, 0, true>(P.lds, P.tid, g, S, E);
            SEAM(pb + 4);
        }
        if (IN(pb + 5)) REPEAT(REP_NORM) {
            const Ctx P = fresh(F);
            if (l == 0) { norm_phase<false, true>(P, args.out, inp(13) + (size_t)l * D, Hb, nullptr); }
            else norm_phase<true>(P, args.out, inp(13) + (size_t)l * D, Hb, inp(17));
            SEAM(pb + 5);
        }
        if (IN(pb + 6) && l == 1) REPEAT(REP_GATHER) { const Ctx P = fresh(F); moe_tables(P); slot_tables(P); SEAM(pb + 6); }
        if (IN(pb + 7)) REPEAT(REP_GGU) {
            const Ctx P = fresh(F);
            if (l == 0) {
                pg8::Gemm g{Hb, args.ws + WS_WGU_D, D}; pg8::ScaleOrder S; S.init(T / 256, 2 * D_FF / 256, F.G, (int)blockIdx.x, nullptr);
                S.SA = (const float*)(args.ws + WS_SA); S.SW = (const float*)(args.ws + WS_SW); S.cols = D_FF; S.st = (LAS float*)(P.lds + pg8::RS_OFF); S.tid = P.tid;
                pg8::EpiSwiglu<true, true> E{HID, D_FF, S.SA, S.SW, S.st};
                pg8::gemm_phase<pg8::EpiSwiglu<true, true>, pg8::ScaleOrder, true, true, 2>(P.lds, P.tid, g, S, E);
            } else {
                if (!MK_ONE_LAUNCH || lo > pb + 6) moe_tables(P);
                pg8::Gemm g{Hb, args.ws + WS_WGU_M, D, (const unsigned*)(args.ws + WS_ROUTE + RT_ROWOF)};
                pg8::GroupOrder S; S.init((int)P.lctl[LC_NMT], 2 * D_FF / 256, F.G, (int)blockIdx.x, (const LAS int*)(P.lctl + LC_TEXP));
                pg8::EpiSwiglu<true> E{HID, D_FF, nullptr, nullptr};
                pg8::gemm_phase<pg8::EpiSwiglu<true>, pg8::GroupOrder, true, true, 1, false, false, true>(P.lds, P.tid, g, S, E);
            }
            SEAM(pb + 7);
        }
        if (IN(pb + 8)) {
            const Ctx P = fresh(F);
            if (l == 0) {
                pg8::Gemm g{HID, args.ws + WS_WDN_D, D_FF}; pg8::GroupOrder S; S.init(T / 256, D / 256, F.G, (int)blockIdx.x, nullptr);
                pg8::EpiOut<false> E{args.out, args.out, nullptr, D, 0, nullptr, nullptr};
                pg8::gemm_phase<pg8::EpiOut<false>, pg8::GroupOrder, true, true, 1>(P.lds, P.tid, g, S, E);
            } else {
                if (!MK_ONE_LAUNCH || lo > pb + 6) moe_tables(P);
                static_assert((D_FF / 128 / 2) % 2 == 0, "half of K is a whole number of K-tile pairs");
                pg8::Gemm g{HID, args.ws + WS_WDN_M, D_FF}; pg8::SplitOrder S; S.init((int)P.lctl[LC_NMT], D / 256, F.G, (int)blockIdx.x, (const LAS int*)(P.lctl + LC_TEXP)); S.init2();
                pg8::EpiOut<false, true> E{nullptr, nullptr, PROJ, D, 1, nullptr, nullptr, (bf16*)(args.ws + WS_H)};
                pg8::gemm_phase<pg8::EpiOut<false, true>, pg8::SplitOrder, true, true, 1, false, true>(P.lds, P.tid, g, S, E);
            }
            SEAM(pb + 8);
        }
    }
    if (IN(19)) { const Ctx P = fresh(F); if (!MK_ONE_LAUNCH || lo > 16) moe_tables(P); final_phase(P, inp(21)); }
#undef IN
#undef SEAM
}

extern "C" void kernel_launch(void* const* d_in, const int* in_sizes, int n_in, void* d_out, int out_size, void* d_ws, size_t ws_size, hipStream_t stream) {
    static int grid = 0;
    if (grid == 0) {
        if (n_in != 22 || in_sizes[0] != T * D || out_size != T * D || ws_size < WS_END) { fprintf(stderr, "kernel_launch: unexpected shapes (n_in %d, in0 %d, out %d, ws %zu < %zu); nothing launched\n", n_in, n_in > 0 ? in_sizes[0] : -1, out_size, ws_size, (size_t)WS_END); grid = -1; return; }
        int dev = 0, cus = 0, per_cu = 0;
        if (hipGetDevice(&dev) != hipSuccess || hipDeviceGetAttribute(&cus, hipDeviceAttributeMultiprocessorCount, dev) != hipSuccess) { grid = -1; return; }
        if (hipFuncSetAttribute((const void*)fwd, hipFuncAttributeMaxDynamicSharedMemorySize, LDS_BYTES) != hipSuccess) { fprintf(stderr, "kernel_launch: hipFuncSetAttribute failed\n"); grid = -1; return; }
        if (hipOccupancyMaxActiveBlocksPerMultiprocessor(&per_cu, (const void*)fwd, 512, LDS_BYTES) != hipSuccess || per_cu < 1) fprintf(stderr, "kernel_launch: occupancy query reports %d\n", per_cu);
        (void)hipGetLastError();
        grid = cus < 256 ? cus : 256;
    }
    if (grid < 0) return;
    if (hipMemsetAsync((char*)d_ws + WS_CTL, 0, CTL_ZERO_BYTES, stream) != hipSuccess) return;
    Args a{};
    for (int i = 0; i < 22; ++i) a.in[i] = (const float*)d_in[i];
    a.out = (float*)d_out; a.ws = (unsigned char*)d_ws; a.pad = 0;
#if MK_ONE_LAUNCH
    a.ph_lo = 0; a.ph_hi = NPHASE; a.li = 0;
    hipLaunchKernelGGL(fwd, dim3(grid), dim3(512), LDS_BYTES, stream, a);
#else
    int li = 0;
    for (int p = 0; p < NPHASE; ++p) {
        if (p == 1 || p == 1 + 6 || p == 4 || p == 13) continue;
        a.ph_lo = p; a.ph_hi = p + 1; a.li = li++;
        hipLaunchKernelGGL(fwd, dim3(grid), dim3(512), LDS_BYTES, stream, a);
    }
#endif
}
```

```cpp
#include <hip/hip_runtime.h>
#include <cstdio>
#include <cstdint>

#ifndef MK_ONE_LAUNCH
#define MK_ONE_LAUNCH 1
#endif

#ifndef REP_P0
#define REP_P0 1
#endif
#ifndef REP_NORM
#define REP_NORM 1
#endif
#ifndef REP_GIN
#define REP_GIN 1
#endif
#ifndef REP_MIX
#define REP_MIX 1
#endif
#ifndef REP_YLRU
#define REP_YLRU 1
#endif
#ifndef REP_GATHER
#define REP_GATHER 1
#endif
#ifndef REP_GGU
#define REP_GGU 1
#endif
#ifndef REP_RET
#define REP_RET 1
#endif
#ifndef REP_LRU
#define REP_LRU 1
#endif
#define REPEAT(n) for (int rep_ = 0; rep_ < (n); ++rep_)
#ifndef GIN0_NC
#define GIN0_NC 20
#endif
#define LAS __attribute__((address_space(3)))
#define GAS __attribute__((address_space(1)))
typedef unsigned short bf16;
typedef short bf16x8 __attribute__((ext_vector_type(8)));
typedef float f32x4 __attribute__((ext_vector_type(4)));
typedef float f32x2 __attribute__((ext_vector_type(2)));
typedef unsigned u32x4 __attribute__((ext_vector_type(4)));
typedef unsigned u32x2 __attribute__((ext_vector_type(2)));

constexpr int BATCH = 8, SEQ = 2048, T = BATCH * SEQ, D = 2048, D_IN = 5120, D_RNN = 1024, NH = 8, DK = 64, DV = 128, D_FF = 5632, NE = 8;
constexpr int OFF_GATE = 1024, OFF_Q = 2048, OFF_K = 2560, OFF_V = 3072, OFF_G = 4096;
constexpr float EPS = 1e-6f;
constexpr int MAXMT = 136;
constexpr int MPAD = MAXMT * 256;

constexpr size_t MiB = 1u << 20;
constexpr size_t WS_CTL = 0, CTL_ZERO_BYTES = 1 * MiB;
constexpr size_t WS_ROPE = 1 * MiB;
constexpr size_t WS_WLRU = 2 * MiB;
constexpr size_t WS_SSP = 3 * MiB;
constexpr size_t WS_ROUTE = 4 * MiB;
constexpr size_t RT_TOPE = 0, RT_TOPG = 65536, RT_TOPR = 65536 * 3, RT_SLOT = 65536 * 5, RT_CNTB = 65536 * 7, RT_ROWOF = 65536 * 8;
constexpr size_t WS_SA = 5 * MiB;
constexpr size_t WS_SW = 6 * MiB;
constexpr size_t WS_WIN = 8 * MiB;
constexpr size_t WS_WOUT = 48 * MiB;
constexpr size_t WS_WGU_D = 64 * MiB;
constexpr size_t WS_WDN_D = 108 * MiB;
constexpr size_t WS_WGU_M = 130 * MiB;
constexpr size_t WS_WDN_M = 482 * MiB;
constexpr size_t WS_XR = 400 * MiB;
constexpr size_t WS_H = 658 * MiB;
constexpr size_t WS_PROJ = 722 * MiB;
constexpr size_t WS_HID = 882 * MiB;
constexpr size_t WS_END = 1256 * MiB;
static_assert(WS_WIN + (size_t)2 * D_IN * D * 2 <= WS_WOUT && WS_WOUT + (size_t)2 * D * D * 2 <= WS_WGU_D && WS_WGU_D + (size_t)2 * D_FF * D * 2 <= WS_WDN_D &&
              WS_WDN_D + (size_t)D * D_FF * 2 <= WS_WGU_M && WS_WGU_M + (size_t)NE * 2 * D_FF * D * 2 <= WS_WDN_M && WS_WDN_M + (size_t)NE * D * D_FF * 2 <= WS_H &&
              WS_H + (size_t)T * D * 2 <= WS_PROJ && WS_PROJ + (size_t)T * D_IN * 2 <= WS_HID && WS_PROJ + (size_t)MPAD * D * 2 <= WS_HID && WS_HID + (size_t)MPAD * D_FF * 2 <= WS_END, "d_ws map");
static_assert(WS_WGU_M + (size_t)NE * 2 * D_FF * D <= WS_XR && WS_XR + (size_t)T * D * 2 <= WS_WDN_M, "residual stream inside the free half of the expert gate/up region");
constexpr int CW_TMO = 0;
constexpr int CW_BAR = 4096;

constexpr int RING_BYTES = 131072;
constexpr int LDSCTL_OFF = 140 * 1024;
constexpr int LDS_BYTES = 147456;
constexpr int LC_BAR = 0, LC_TB = 16, LC_PRE = 32, LC_TOT = 40, LC_NMT = 48, LC_TEXP = 64, LC_SPLIT = 256;

#define RLX_AGENT __ATOMIC_RELAXED, __HIP_MEMORY_SCOPE_AGENT
__device__ __forceinline__ unsigned f2bf(float f) { unsigned u = __builtin_bit_cast(unsigned, f); return (u + 0x7fffu + ((u >> 16) & 1u)) >> 16; }
__device__ __forceinline__ unsigned pk2(float lo, float hi) { return f2bf(lo) | (f2bf(hi) << 16); }
__device__ __forceinline__ float bflo(unsigned w) { return __builtin_bit_cast(float, w << 16); }
__device__ __forceinline__ float bfhi(unsigned w) { return __builtin_bit_cast(float, w & 0xffff0000u); }
__device__ __forceinline__ float shfl_idx(float v, int src) { return __builtin_bit_cast(float, __builtin_amdgcn_ds_bpermute(src << 2, __builtin_bit_cast(int, v))); }
__device__ __forceinline__ float shfl_x(float v, int o, int lane) { return shfl_idx(v, lane ^ o); }
__device__ __forceinline__ unsigned shfl_u(unsigned v, int src) { return (unsigned)__builtin_amdgcn_ds_bpermute(src << 2, (int)v); }
__device__ __forceinline__ float wave_sum(float v, int lane) {
#pragma unroll
    for (int o = 1; o < 64; o <<= 1) v += shfl_x(v, o, lane);
    return v;
}
__device__ __forceinline__ float sigmoidf_(float x) { return __builtin_amdgcn_rcpf(1.0f + __expf(-x)); }
__device__ __forceinline__ int tile_off(int r, int c, int kc32) { const int ob = (r & 15) * 64 + (c & 31) * 2; return ((r >> 4) * kc32 + (c >> 5)) * 1024 + (ob ^ (((ob >> 9) & 1) << 5)); }
__device__ __forceinline__ bf16x8 lds_frag(LAS unsigned char* base, int off) { return *(const LAS bf16x8*)(base + off); }
#define MFMA16(a, b, c) __builtin_amdgcn_mfma_f32_16x16x32_bf16((a), (b), (c), 0, 0, 0)

namespace pg8 {
constexpr int BM = 256, BK = 64, HALF = 128, HTB = HALF * BK * 2, STAGE_BYTES = 8 * HTB, NXCD = 8, WGM = 8;
__host__ __device__ __forceinline__ int lds_byte(int r, int c) { const int st = (r >> 4) * 2 + (c >> 5), rr = r & 15, cc = c & 31, ob = rr * 64 + cc * 2; return st * 1024 + (ob ^ (((ob >> 9) & 1) << 5)); }
__host__ __device__ __forceinline__ void stage_rc(int b, int& R, int& C) { const int st = b / 1024, sb = b % 1024, swz = sb ^ (((sb >> 9) & 1) << 5); R = (st >> 1) * 16 + swz / 64; C = (st & 1) * 32 + (swz % 64) / 2; }
__host__ __device__ __forceinline__ int perm32(int rho) { const int n = rho >> 4, i = rho & 15; return 8 * (i >> 2) + 4 * n + (i & 3); }

struct Unit { int pm, pn, pb, kh; };
struct Gemm { const void* A; const void* Bt; int Kb; const unsigned* arow; };

struct GroupOrder {
    int nM, nN, nwg, G, c; const LAS int* texp;
    __device__ void init(int nM_, int nN_, int G_, int c_, const LAS int* texp_) { nM = nM_; nN = nN_; nwg = nM * nN; G = G_; c = c_; texp = texp_; }
    __device__ bool next(int i, Unit& u) const { return unit_at((long)i * G + c, u); }
    __device__ bool unit_at(long L, Unit& u) const {
        if (L >= nwg) return false;
        int wgid = (int)L; { const int q = nwg / NXCD, r = nwg % NXCD, xcd = wgid % NXCD, off = wgid / NXCD; wgid = (xcd < r ? xcd * (q + 1) : r * (q + 1) + (xcd - r) * q) + off; }
        const int nig = WGM * nN, gid = wgid / nig, fm = gid * WGM, gsz = (nM - fm) < WGM ? (nM - fm) : WGM;
        u.pm = fm + ((wgid % nig) % gsz); u.pn = (wgid % nig) / gsz;
        u.pb = (texp ? __builtin_amdgcn_readfirstlane(texp[u.pm]) : 0) * nN + u.pn; return true;
    }
    struct Pre {};
    __device__ __forceinline__ void a_issue(const Unit&, Pre&) const {}
    __device__ __forceinline__ void a_finish(const Unit&, int, const Pre&) const {}
    __device__ __forceinline__ void done(const Unit&) const {}
};
struct SplitOrder : GroupOrder {
    int R, rem;
    __device__ void init2() { R = nwg / G; rem = nwg - R * G; if (2 * rem > G) rem = 0; }
    __device__ bool next(int i, Unit& u) const {
        if (rem == 0 || i < R) { const bool ok = GroupOrder::next(i, u); u.kh = 0; return ok; }
        if (i > R || c >= 2 * rem) return false;
        const bool ok = unit_at((long)R * G + (c >> 1), u); u.kh = ((c >> 1) << 2) | (1 + (c & 1)); return ok;
    }
};
constexpr int RS_OFF = 131072;
struct RowScaleOrder : GroupOrder {
    const float* ssp; LAS float* rs; int tid;
    struct Pre { f32x4 a, b; };
    __device__ __forceinline__ void a_issue(const Unit& u, Pre& p) const {
        const int r = tid & 255, h = tid >> 8; const f32x4* q = (const f32x4*)(ssp + (size_t)(u.pm * BM + r) * 16 + h * 8);
        p.a = q[0]; p.b = q[1];
    }
    __device__ __forceinline__ void a_finish(const Unit&, int par, const Pre& p) const {
        const int r = tid & 255, h = tid >> 8; const f32x4 t4 = p.a + p.b;
        rs[(par * 2 + h) * 256 + r] = (t4[0] + t4[1]) + (t4[2] + t4[3]);
    }
};
struct ScaleOrder : GroupOrder {
    const float* SA; const float* SW; int cols; LAS float* st; int tid;
    struct Pre { float v; };
    __device__ bool next(int i, Unit& u) const { const bool ok = GroupOrder::next(i, u); u.kh = i & 1; return ok; }
    __device__ __forceinline__ void a_issue(const Unit& u, Pre& p) const {
        const int t = tid;
        p.v = t < 256 ? SA[u.pm * BM + t] : (cols == 0 ? SW[u.pn * BM + t - 256] : (t < 384 ? SW[u.pn * HALF + t - 256] : SW[cols + u.pn * HALF + t - 384]));
    }
    __device__ __forceinline__ void a_finish(const Unit&, int par, const Pre& p) const { st[par * 512 + tid] = p.v; }
};
__device__ __forceinline__ float rs_scale(const LAS float* rs, int par, int r, float inv) { return 1.0f / sqrtf((rs[(par * 2) * 256 + r] + rs[(par * 2 + 1) * 256 + r]) * inv + EPS); }

__device__ __forceinline__ unsigned cvt_pk_bf16(float lo, float hi) { unsigned r; asm volatile("v_cvt_pk_bf16_f32 %0, %1, %2" : "=v"(r) : "v"(lo), "v"(hi)); return r; }

template <bool INI8 = false, bool KS = false> struct EpiOut {
    static constexpr bool PERM = true;
    const void* base; bf16* C; bf16* O; int ldc; int mode; const float* SA; const float* SW;
    bf16* O2;
    const LAS float* st;
    __device__ __forceinline__ void operator()(const f32x4 (&acc)[2][2][4][2], const Unit& u, int wr, int wc, int fr, int fq) const {
        int row0 = u.pm * BM + wr * 64 + fr, col0 = u.pn * BM + wc * 32 + 8 * fq;
        if (mode == 1) {
            bf16* O = this->O; int ldc = this->ldc;
            if constexpr (KS) { if ((u.kh & 3) == 2) { O = O2 + (size_t)(u.kh >> 2) * (BM * BM); ldc = BM; row0 = wr * 64 + fr; col0 = wc * 32 + 8 * fq; } }
            float sw[2][8];
            if constexpr (INI8) {
#pragma unroll
                for (int bj = 0; bj < 2; ++bj)
#pragma unroll
                    for (int j = 0; j < 8; ++j) sw[bj][j] = st ? st[512 * u.kh + 256 + wc * 32 + 8 * fq + bj * HALF + j] : SW[col0 + bj * HALF + j]; }
#pragma unroll
            for (int ai = 0; ai < 2; ++ai)
#pragma unroll
                for (int m = 0; m < 4; ++m) {
                    const size_t off = (size_t)(row0 + ai * HALF + m * 16) * ldc + col0;
                    float sa = 1.0f; if constexpr (INI8) sa = st ? st[512 * u.kh + wr * 64 + fr + ai * HALF + m * 16] : SA[row0 + ai * HALF + m * 16];
#pragma unroll
                    for (int bj = 0; bj < 2; ++bj) { float f[8];
#pragma unroll
                        for (int j = 0; j < 4; ++j) { const float a0 = acc[ai][bj][m][0][j], a1 = acc[ai][bj][m][1][j];
                            if constexpr (INI8) { f[j] = (float)__builtin_bit_cast(int, a0) * (sa * sw[bj][j]); f[4 + j] = (float)__builtin_bit_cast(int, a1) * (sa * sw[bj][4 + j]); }
                            else { f[j] = a0; f[4 + j] = a1; } }
                        u32x4 w; w.x = cvt_pk_bf16(f[0], f[1]); w.y = cvt_pk_bf16(f[2], f[3]); w.z = cvt_pk_bf16(f[4], f[5]); w.w = cvt_pk_bf16(f[6], f[7]);
                        *(u32x4*)(O + off + bj * HALF) = w; }
                }
        } else if (mode == 0) {
            const float* bf = (const float*)base;
#pragma unroll
            for (int ai = 0; ai < 2; ++ai) {
                f32x4 bb[4][2][2];
#pragma unroll
                for (int m = 0; m < 4; ++m) { const size_t off = (size_t)(row0 + ai * HALF + m * 16) * ldc + col0;
#pragma unroll
                    for (int bj = 0; bj < 2; ++bj) { bb[m][bj][0] = *(const f32x4*)(bf + off + bj * HALF); bb[m][bj][1] = *(const f32x4*)(bf + off + bj * HALF + 4); } }
#pragma unroll
                for (int m = 0; m < 4; ++m) { const size_t off = (size_t)(row0 + ai * HALF + m * 16) * ldc + col0;
#pragma unroll
                    for (int bj = 0; bj < 2; ++bj) { const f32x4 lo = bb[m][bj][0] + acc[ai][bj][m][0], hi = bb[m][bj][1] + acc[ai][bj][m][1];
                        u32x4 w; w.x = cvt_pk_bf16(lo[0], lo[1]); w.y = cvt_pk_bf16(lo[2], lo[3]); w.z = cvt_pk_bf16(hi[0], hi[1]); w.w = cvt_pk_bf16(hi[2], hi[3]);
                        *(u32x4*)(C + off + bj * HALF) = w; } }
                asm volatile("" ::: "memory");
            }
        } else {
            const bf16* bb16 = (const bf16*)base;
#pragma unroll
            for (int ai = 0; ai < 2; ++ai) {
                u32x4 bw[4][2];
#pragma unroll
                for (int m = 0; m < 4; ++m) { const size_t off = (size_t)(row0 + ai * HALF + m * 16) * ldc + col0;
#pragma unroll
                    for (int bj = 0; bj < 2; ++bj) bw[m][bj] = *(const u32x4*)(bb16 + off + bj * HALF); }
#pragma unroll
                for (int m = 0; m < 4; ++m) { const size_t off = (size_t)(row0 + ai * HALF + m * 16) * ldc + col0;
#pragma unroll
                    for (int bj = 0; bj < 2; ++bj) { const u32x4 r = bw[m][bj]; const f32x4 a0 = acc[ai][bj][m][0], a1 = acc[ai][bj][m][1];
                        u32x4 w; w.x = cvt_pk_bf16(bflo(r.x) + a0[0], bfhi(r.x) + a0[1]); w.y = cvt_pk_bf16(bflo(r.y) + a0[2], bfhi(r.y) + a0[3]);
                        w.z = cvt_pk_bf16(bflo(r.z) + a1[0], bfhi(r.z) + a1[1]); w.w = cvt_pk_bf16(bflo(r.w) + a1[2], bfhi(r.w) + a1[3]);
                        *(u32x4*)(C + off + bj * HALF) = w; } }
                asm volatile("" ::: "memory");
            }
            {
                asm volatile("" ::: "memory");
            }
        }
    }
};
__device__ __forceinline__ float clamp448(float x) { return __builtin_amdgcn_fmed3f(x, -448.0f, 448.0f); }
__device__ __forceinline__ unsigned pk4_fp8(float a, float b, float c, float d) { unsigned w = 0; w = __builtin_amdgcn_cvt_pk_fp8_f32(clamp448(a), clamp448(b), w, false); w = __builtin_amdgcn_cvt_pk_fp8_f32(clamp448(c), clamp448(d), w, true); return w; }
template <bool OUT8, bool INI8 = false> struct EpiSwiglu {
    static constexpr bool PERM = true;
    void* O; int ldc; const float* SA; const float* SW;
    const LAS float* st;
    __device__ __forceinline__ void operator()(const f32x4 (&acc)[2][2][4][2], const Unit& u, int wr, int wc, int fr, int fq) const {
        const int row0 = u.pm * BM + wr * 64 + fr, col0 = u.pn * HALF + wc * 32 + 8 * fq;
        float swg[8], swu[8];
        if constexpr (INI8) {
#pragma unroll
            for (int j = 0; j < 8; ++j) { swg[j] = st ? st[512 * u.kh + 256 + wc * 32 + 8 * fq + j] : SW[col0 + j]; swu[j] = st ? st[512 * u.kh + 384 + wc * 32 + 8 * fq + j] : SW[ldc + col0 + j]; } }
#pragma unroll
        for (int ai = 0; ai < 2; ++ai)
#pragma unroll
            for (int m = 0; m < 4; ++m) {
                float h[8]; float sa = 1.0f; if constexpr (INI8) sa = st ? st[512 * u.kh + wr * 64 + fr + ai * HALF + m * 16] : SA[row0 + ai * HALF + m * 16];
#pragma unroll
                for (int n = 0; n < 2; ++n)
#pragma unroll
                    for (int j = 0; j < 4; ++j) { float g = acc[ai][0][m][n][j], up = acc[ai][1][m][n][j];
                        if constexpr (INI8) { g = (float)__builtin_bit_cast(int, g) * (sa * swg[4 * n + j]); up = (float)__builtin_bit_cast(int, up) * (sa * swu[4 * n + j]); } h[n * 4 + j] = g * __builtin_amdgcn_rcpf(1.0f + __builtin_amdgcn_exp2f(-1.44269504f * g)) * up; }
                if constexpr (OUT8) { *(u32x2*)((unsigned char*)O + (size_t)(row0 + ai * HALF + m * 16) * ldc + col0) = (u32x2){pk4_fp8(h[0], h[1], h[2], h[3]), pk4_fp8(h[4], h[5], h[6], h[7])}; }
                else { u32x4 w; w.x = cvt_pk_bf16(h[0], h[1]); w.y = cvt_pk_bf16(h[2], h[3]); w.z = cvt_pk_bf16(h[4], h[5]); w.w = cvt_pk_bf16(h[6], h[7]);
                    *(u32x4*)((bf16*)O + (size_t)(row0 + ai * HALF + m * 16) * ldc + col0) = w; }
            }
    }
};

typedef int i32x4 __attribute__((ext_vector_type(4)));
typedef int i32x8 __attribute__((ext_vector_type(8)));
template <class Epi, class Sched, bool ALIGN_EPI, bool SP2, int KIND  , bool MIDK = false, bool KSPLIT = false, bool GA = false>
__device__ __forceinline__ void gemm_phase(LAS unsigned char* lds, const int tid, const Gemm g, const Sched& S, const Epi& E) {
    const int wid = __builtin_amdgcn_readfirstlane(tid >> 6), lane = tid & 63, wr = wid >> 2, wc = wid & 3, fr = lane & 15, fq = lane >> 4;
    const int K = g.Kb, nt = K / 128;
    unsigned voffA[2], voffB[2];
#pragma unroll
    for (int i = 0; i < 2; ++i) { int R, C; stage_rc(tid * 16 + i * 8192, R, C); const int Rb = Epi::PERM ? ((R & ~31) + perm32(R & 31)) : R;
        voffA[i] = (unsigned)(R * K + C * 2); voffB[i] = (unsigned)(Rb * K + C * 2); }
    int rA0 = 0; unsigned colA = 0; { int R, C; stage_rc(tid * 16, R, C); rA0 = R; colA = (unsigned)(C * 2); }
    unsigned gofC[2][2], gofN[2][2], gofX[2][2]; (void)gofC; (void)gofN; (void)gofX; (void)rA0; (void)colA;
    LAS unsigned* atab = (LAS unsigned*)(lds + RS_OFF);
    const size_t kstep = (size_t)(BK * 2);
    const size_t hstep = (size_t)HALF * K;
    const size_t tstep = 2 * hstep;
    const unsigned ldsw = (unsigned)wid * 1024u;
    const int aoff = lds_byte(wr * 64 + fr, fq * 8), boff = lds_byte(wc * 32 + fr, fq * 8);
#define PG8_SA(b, h) (((b) * 2 + (h)) * HTB)
#define PG8_SB(b, h) ((4 + (b) * 2 + (h)) * HTB)
#define PG8_STAGE(bufoff, gbase, voff) do { _Pragma("unroll") for (int _i = 0; _i < 2; ++_i) \
        __builtin_amdgcn_global_load_lds((const unsigned*)((const char*)(gbase) + (voff)[_i]), (LAS unsigned*)(lds + (bufoff) + ldsw + _i * 8192), 16, 0, 0); } while (0)
#define PG8_STAGE_A(b, h, base, offs) do { if constexpr (GA) { PG8_STAGE(PG8_SA(b, h), (base), (offs)[h]); } else { PG8_STAGE(PG8_SA(b, h), (base) + (h) * hstep, voffA); } } while (0)
#define PG8_LDA(dst, b, h) do { _Pragma("unroll") for (int m = 0; m < 4; ++m) _Pragma("unroll") for (int k = 0; k < 2; ++k) dst[m][k] = *(const LAS bf16x8*)(lds + PG8_SA(b, h) + aoff + m * 2048 + k * 1024); } while (0)
#define PG8_LDB(dst, b, h) do { _Pragma("unroll") for (int n = 0; n < 2; ++n) _Pragma("unroll") for (int k = 0; k < 2; ++k) dst[n][k] = *(const LAS bf16x8*)(lds + PG8_SB(b, h) + boff + n * 2048 + k * 1024); } while (0)
#define PG8_CAT(x) __builtin_shufflevector(__builtin_bit_cast(i32x4, (x)[0]), __builtin_bit_cast(i32x4, (x)[1]), 0, 1, 2, 3, 4, 5, 6, 7)
#define PG8_MMA(ai, bj, At, Bt) do { __builtin_amdgcn_s_setprio(1); _Pragma("unroll") for (int m = 0; m < 4; ++m) _Pragma("unroll") for (int n = 0; n < 2; ++n) { \
        if constexpr (KIND == 1) { const i32x8 bw_ = PG8_CAT(Bt[n]), aw_ = PG8_CAT(At[m]); \
            asm volatile("v_mfma_scale_f32_16x16x128_f8f6f4 %0, %1, %2, %0, %3, %4 op_sel_hi:[0,0,0]" : "+v"(acc[ai][bj][m][n]) : "v"(bw_), "v"(aw_), "v"(sc_w), "v"(sc_a)); } \
        else if constexpr (KIND == 2) { _Pragma("unroll") for (int k = 0; k < 2; ++k) acc[ai][bj][m][n] = __builtin_bit_cast(f32x4, __builtin_amdgcn_mfma_i32_16x16x64_i8( \
            __builtin_bit_cast(i32x4, Bt[n][k]), __builtin_bit_cast(i32x4, At[m][k]), __builtin_bit_cast(i32x4, acc[ai][bj][m][n]), 0, 0, 0)); } \
        else { _Pragma("unroll") for (int k = 0; k < 2; ++k) acc[ai][bj][m][n] = __builtin_amdgcn_mfma_f32_16x16x32_bf16(Bt[n][k], At[m][k], acc[ai][bj][m][n], 0, 0, 0); } } \
        __builtin_amdgcn_s_setprio(0); } while (0)
#define PG8_WAIT_V(n) asm volatile("s_waitcnt vmcnt(" #n ")" ::: "memory")
#define PG8_WAIT_L(n) asm volatile("s_waitcnt lgkmcnt(" #n ")" ::: "memory")
#define PG8_BAR __builtin_amdgcn_s_barrier()
#define PG8_SCHED __builtin_amdgcn_sched_barrier(0)
    Unit cur, nxt; int ui = 0;
    if (!S.next(0, cur)) return;
    const int sc_w = 0x79797979, sc_a = 0x7f7f7f7f; (void)sc_w; (void)sc_a;
    f32x4 acc[2][2][4][2];
#pragma unroll
    for (int a = 0; a < 2; ++a)
#pragma unroll
        for (int b = 0; b < 2; ++b)
#pragma unroll
            for (int m = 0; m < 4; ++m)
#pragma unroll
                for (int n = 0; n < 2; ++n) acc[a][b][m][n] = (f32x4){0.f, 0.f, 0.f, 0.f};
    bf16x8 At[4][2], B0[2][2], B1[2][2];
    const char* cA = (const char*)g.A + (GA ? (size_t)0 : (size_t)cur.pm * tstep); const char* cB = (const char*)g.Bt + (size_t)cur.pb * tstep;
    if constexpr (GA) {
        static_assert(SP2 && !KSPLIT && !MIDK, "gathered A: SP2 schedule only");
#pragma unroll
        for (int h = 0; h < 2; ++h)
#pragma unroll
            for (int i = 0; i < 2; ++i) { gofC[h][i] = g.arow[cur.pm * BM + h * HALF + rA0 + 64 * i] * (unsigned)K + colA; gofN[h][i] = gofC[h][i]; }
    }
    if constexpr (KSPLIT) { if ((cur.kh & 3) == 2) { cA += (size_t)(nt / 2) * kstep; cB += (size_t)(nt / 2) * kstep; } }
    { typename Sched::Pre pre0; S.a_issue(cur, pre0); S.a_finish(cur, 0, pre0); }
    if constexpr (SP2) {
        PG8_STAGE(PG8_SB(0, 0), cB, voffB); PG8_STAGE(PG8_SB(0, 1), cB + hstep, voffB); PG8_STAGE_A(0, 0, cA, gofC); PG8_STAGE_A(0, 1, cA, gofC);
        if (wr == 1) PG8_BAR;
        PG8_WAIT_V(2); PG8_BAR;
        PG8_STAGE(PG8_SB(1, 0), cB + kstep, voffB); PG8_STAGE_A(1, 0, cA + kstep, gofC); PG8_STAGE(PG8_SB(1, 1), cB + hstep + kstep, voffB);
        PG8_WAIT_V(6); PG8_BAR;
    } else {
        PG8_STAGE(PG8_SB(0, 0), cB, voffB); PG8_STAGE(PG8_SA(0, 0), cA, voffA); PG8_STAGE(PG8_SB(0, 1), cB + hstep, voffB); PG8_STAGE(PG8_SA(0, 1), cA + hstep, voffA);
        if (wr == 1) PG8_BAR;
        PG8_WAIT_V(4); PG8_BAR;
        PG8_STAGE(PG8_SB(1, 0), cB + kstep, voffB); PG8_STAGE(PG8_SA(1, 0), cA + kstep, voffA); PG8_STAGE(PG8_SB(1, 1), cB + hstep + kstep, voffB);
        PG8_WAIT_V(6); PG8_BAR;
    }
    for (;;) {
        const bool has_next = S.next(ui + 1, nxt);
        const char* nA = (has_next && !GA) ? (const char*)g.A + (size_t)nxt.pm * tstep : cA; const char* nB = has_next ? (const char*)g.Bt + (size_t)nxt.pb * tstep : cB;
        if constexpr (GA) { if (has_next && wid == 0)
            __builtin_amdgcn_global_load_lds(g.arow + (size_t)nxt.pm * BM + lane * 4, atab + ((ui + 1) & 1) * BM, 16, 0, 0); }
        int unt = nt;
        if constexpr (KSPLIT) { if (has_next && (nxt.kh & 3) == 2) { nA += (size_t)(nt / 2) * kstep; nB += (size_t)(nt / 2) * kstep; } if (cur.kh & 3) unt = nt / 2; }
        for (int t = 0; t < unt; t += 2) {
            const bool last = (t == unt - 2);
            const char* a1 = cA + (size_t)(t + 1) * kstep;
            const char* a2 = last ? nA : cA + (size_t)(t + 2) * kstep; const char* b2 = last ? nB : cB + (size_t)(t + 2) * kstep;
            const char* a3 = a2 + kstep; const char* b3 = b2 + kstep;
            if constexpr (GA) {
                if (t == 2 && has_next) {
#pragma unroll
                    for (int h = 0; h < 2; ++h)
#pragma unroll
                        for (int i = 0; i < 2; ++i) gofN[h][i] = atab[((ui + 1) & 1) * BM + h * HALF + rA0 + 64 * i] * (unsigned)K + colA; }
#pragma unroll
                for (int h = 0; h < 2; ++h)
#pragma unroll
                    for (int i = 0; i < 2; ++i) gofX[h][i] = last ? gofN[h][i] : gofC[h][i];
            }
            if constexpr (MIDK) { if (t == nt / 2) {
                const LAS float* rs = (const LAS float*)(lds + RS_OFF);
#pragma unroll
                for (int ai = 0; ai < 2; ++ai)
#pragma unroll
                    for (int m = 0; m < 4; ++m) { const float sc = rs_scale(rs, ui & 1, ai * HALF + wr * 64 + m * 16 + fr, 1.0f / D_RNN);
#pragma unroll
                        for (int bj = 0; bj < 2; ++bj)
#pragma unroll
                            for (int n = 0; n < 2; ++n) acc[ai][bj][m][n] = acc[ai][bj][m][n] * sc; } } }
            if constexpr (SP2) {
            PG8_LDB(B0, 0, 0); PG8_LDB(B1, 0, 1); PG8_SCHED; PG8_LDA(At, 0, 0); PG8_STAGE_A(1, 1, a1, gofC);
            PG8_WAIT_V(8); PG8_WAIT_L(0); PG8_BAR; PG8_MMA(0, 0, At, B0); PG8_MMA(0, 1, At, B1); PG8_BAR; PG8_SCHED;
            PG8_LDA(At, 0, 1); PG8_STAGE(PG8_SB(0, 0), b2, voffB); PG8_STAGE(PG8_SB(0, 1), b2 + hstep, voffB); PG8_STAGE_A(0, 0, a2, gofX);
            PG8_WAIT_V(8); PG8_WAIT_L(0); PG8_BAR; PG8_MMA(1, 0, At, B0); PG8_MMA(1, 1, At, B1); PG8_BAR; PG8_SCHED;
            PG8_LDB(B0, 1, 0); PG8_LDB(B1, 1, 1); PG8_SCHED; PG8_LDA(At, 1, 0); PG8_STAGE_A(0, 1, a2, gofX);
            PG8_WAIT_V(8); PG8_WAIT_L(0); PG8_BAR; PG8_MMA(0, 0, At, B0); PG8_MMA(0, 1, At, B1); PG8_BAR; PG8_SCHED;
            PG8_LDA(At, 1, 1); PG8_STAGE(PG8_SB(1, 0), b3, voffB); PG8_STAGE(PG8_SB(1, 1), b3 + hstep, voffB); PG8_STAGE_A(1, 0, a3, gofX);
            PG8_WAIT_V(8); PG8_WAIT_L(0); PG8_BAR; PG8_MMA(1, 0, At, B0); PG8_MMA(1, 1, At, B1); PG8_BAR; PG8_SCHED;
            } else {
            PG8_LDB(B0, 0, 0); PG8_SCHED; PG8_LDA(At, 0, 0); PG8_STAGE(PG8_SA(1, 1), a1 + hstep, voffA);
            PG8_WAIT_L(8); PG8_BAR; PG8_WAIT_L(0); PG8_MMA(0, 0, At, B0); PG8_BAR; PG8_SCHED;
            PG8_LDB(B1, 0, 1); PG8_STAGE(PG8_SB(0, 0), b2, voffB);
            PG8_BAR; PG8_WAIT_L(0); PG8_MMA(0, 1, At, B1); PG8_BAR;
            PG8_LDA(At, 0, 1); PG8_STAGE(PG8_SA(0, 0), a2, voffA);
            PG8_BAR; PG8_WAIT_L(0); PG8_MMA(1, 0, At, B0); PG8_BAR; PG8_SCHED;
            PG8_STAGE(PG8_SB(0, 1), b2 + hstep, voffB);
            PG8_WAIT_V(6); PG8_BAR; PG8_MMA(1, 1, At, B1); PG8_BAR;
            PG8_LDB(B0, 1, 0); PG8_SCHED; PG8_LDA(At, 1, 0); PG8_STAGE(PG8_SA(0, 1), a2 + hstep, voffA);
            PG8_WAIT_L(8); PG8_BAR; PG8_WAIT_L(0); PG8_MMA(0, 0, At, B0); PG8_BAR; PG8_SCHED;
            PG8_LDB(B1, 1, 1); PG8_STAGE(PG8_SB(1, 0), b3, voffB);
            PG8_BAR; PG8_WAIT_L(0); PG8_MMA(0, 1, At, B1); PG8_BAR;
            PG8_LDA(At, 1, 1); PG8_STAGE(PG8_SA(1, 0), a3, voffA);
            PG8_BAR; PG8_WAIT_L(0); PG8_MMA(1, 0, At, B0); PG8_BAR; PG8_SCHED;
            PG8_STAGE(PG8_SB(1, 1), b3 + hstep, voffB);
            PG8_WAIT_V(6); PG8_BAR; PG8_MMA(1, 1, At, B1); PG8_BAR;
            }
        }
        if constexpr (ALIGN_EPI) { if (wr == 0) PG8_BAR; }
        if constexpr (KIND == 1) asm volatile("s_nop 15\n\ts_nop 15" ::: "memory");
        typename Sched::Pre pre; if (has_next) S.a_issue(nxt, pre);
        E(acc, cur, wr, wc, fr, fq); S.done(cur);
        if (has_next) S.a_finish(nxt, (ui + 1) & 1, pre);
        if (!has_next) break;
#pragma unroll
        for (int a = 0; a < 2; ++a)
#pragma unroll
            for (int b = 0; b < 2; ++b)
#pragma unroll
                for (int m = 0; m < 4; ++m)
#pragma unroll
                    for (int n = 0; n < 2; ++n) acc[a][b][m][n] = (f32x4){0.f, 0.f, 0.f, 0.f};
        cur = nxt; cA = nA; cB = nB; ++ui;
        if constexpr (GA) {
#pragma unroll
            for (int h = 0; h < 2; ++h)
#pragma unroll
                for (int i = 0; i < 2; ++i) gofC[h][i] = gofN[h][i]; }
        if constexpr (ALIGN_EPI) { if (wr == 1) PG8_BAR; }
    }
    PG8_WAIT_V(0);
    if constexpr (!ALIGN_EPI) { if (wr == 0) PG8_BAR; }
    PG8_BAR;
#undef PG8_SA
#undef PG8_SB
#undef PG8_STAGE
#undef PG8_LDA
#undef PG8_STAGE_A
#undef PG8_LDB
#undef PG8_MMA
#undef PG8_CAT
#undef PG8_WAIT_V
#undef PG8_WAIT_L
#undef PG8_BAR
#undef PG8_SCHED
}
}

#define XB_TMO      128
#define XB_XCNT(j)  (256  + 64 * (j))
#define XB_XSUB(j)  (1280 + 64 * (j))
#define XB_XGEN(j)  (2304 + 64 * (j))
#define XB_TOP      3328
#define XB_TOPGEN   3392
#define XCD_BAR_WORDS 3456
#define XB_SPIN_CAP (1u << 18)
__device__ __forceinline__ unsigned xb_ld(unsigned* p)              { return __hip_atomic_load(p, __ATOMIC_RELAXED, __HIP_MEMORY_SCOPE_AGENT); }
__device__ __forceinline__ unsigned xb_add(unsigned* p, unsigned v) { return __hip_atomic_fetch_add(p, v, __ATOMIC_RELAXED, __HIP_MEMORY_SCOPE_AGENT); }
__device__ __forceinline__ unsigned xb_xcc_id() { return (unsigned)__builtin_amdgcn_s_getreg((3 << 11) | 20) & 0xFu; }
#define XB_SPIN(cond, bar) do { unsigned _sp = 0; while (cond) { __builtin_amdgcn_s_sleep(1); \
    if ((++_sp & 255u) == 0u) { if (xb_ld(&(bar)[XB_TMO])) break; if (_sp > XB_SPIN_CAP) { atomicAdd(&(bar)[XB_TMO], 1u); break; } } } } while (0)
struct XcdBarrier { unsigned* bar; unsigned x; volatile LAS unsigned* st; };
__device__ __forceinline__ XcdBarrier xcd_barrier_post(unsigned* bar, volatile LAS unsigned* st) {
    XcdBarrier b; b.bar = bar; b.x = xb_xcc_id(); b.st = st;
    if (threadIdx.x == 0) (void)xb_add(&bar[XB_XCNT(b.x)], 1u);
    return b;
}
__device__ __forceinline__ void xcd_barrier_complete(unsigned* bar, unsigned x, unsigned& nloc, unsigned& nx) {
    const unsigned G = gridDim.x * gridDim.y * gridDim.z;
    unsigned sum, cnt, mine, sp = 0u;
    for (;;) {
        sum = 0u; cnt = 0u; mine = 0u;
#pragma unroll
        for (unsigned j = 0; j < 16; ++j) { const unsigned c = xb_ld(&bar[XB_XCNT(j)]); sum += c; cnt += (c > 0u) ? 1u : 0u; mine = (j == x) ? c : mine; }
        if (sum == G) break;
        __builtin_amdgcn_s_sleep(1);
        if ((++sp & 255u) == 0u) { if (xb_ld(&bar[XB_TMO])) break; if (sp > XB_SPIN_CAP) { atomicAdd(&bar[XB_TMO], 1u); break; } }
    }
    nloc = mine > 0u ? mine : 1u; nx = cnt > 0u ? cnt : 1u;
}
__device__ __forceinline__ void xcd_barrier(const XcdBarrier& b) {
    asm volatile("s_waitcnt vmcnt(0)" ::: "memory");
    __syncthreads();
    if (threadIdx.x == 0) {
        unsigned* bar = b.bar;
        __builtin_amdgcn_s_waitcnt(0);
        unsigned nloc = b.st[0], nx = b.st[1];
        if (nloc == 0u) { xcd_barrier_complete(bar, b.x, nloc, nx); b.st[0] = nloc; b.st[1] = nx; }
        const unsigned old = xb_add(&bar[XB_XSUB(b.x)], 1u);
        const unsigned gen = old / nloc;
        if (old + 1u == (gen + 1u) * nloc) {
            __builtin_amdgcn_fence(__ATOMIC_RELEASE, "agent");
            asm volatile("s_waitcnt vmcnt(0)" ::: "memory");
            const unsigned og = xb_add(&bar[XB_TOP], 1u);
            const unsigned tg = og / nx;
            if (og + 1u == (tg + 1u) * nx) xb_add(&bar[XB_TOPGEN], 1u);
            else XB_SPIN(xb_ld(&bar[XB_TOPGEN]) == tg, bar);
            __builtin_amdgcn_fence(__ATOMIC_ACQUIRE, "agent");
            xb_add(&bar[XB_XGEN(b.x)], 1u);
            asm volatile("s_waitcnt vmcnt(0)" ::: "memory");
        } else {
            XB_SPIN(xb_ld(&bar[XB_XGEN(b.x)]) == gen, bar);
            __builtin_amdgcn_fence(__ATOMIC_ACQUIRE, "agent");
            asm volatile("s_waitcnt vmcnt(0)" ::: "memory");
        }
    }
    __syncthreads();
}

__device__ __forceinline__ void p0_transpose_item(const float* W, int K, int N, bf16* WT, int kb, int nb, int drow0, LAS float* scr, int lane) {
    const int k0 = 64 * kb, n0 = 32 * nb;
#pragma unroll 8
    for (int i = 0; i < 32; ++i) { const int kk = 2 * i + (lane >> 5); scr[kk * 33 + (lane & 31)] = W[(size_t)(k0 + kk) * N + n0 + (lane & 31)]; }
    asm volatile("s_waitcnt lgkmcnt(0)" ::: "memory");
    const int c = lane & 7;
#pragma unroll
    for (int j = 0; j < 4; ++j) { const int n = (lane >> 3) + 8 * j; const LAS float* s = scr + (8 * c) * 33 + n;
        u32x4 o; o.x = pk2(s[0 * 33], s[1 * 33]); o.y = pk2(s[2 * 33], s[3 * 33]); o.z = pk2(s[4 * 33], s[5 * 33]); o.w = pk2(s[6 * 33], s[7 * 33]);
        *(u32x4*)(WT + (size_t)(drow0 + n) * K + k0 + 8 * c) = o; }
    asm volatile("s_waitcnt lgkmcnt(0)" ::: "memory");
}

__device__ __forceinline__ void p0_transpose_item_fp8(const float* W, int K, int N, unsigned char* WT, int kb, int nb, int drow0, LAS float* scr, int lane) {
    const int k0 = 64 * kb, n0 = 32 * nb;
#pragma unroll 8
    for (int i = 0; i < 32; ++i) { const int kk = 2 * i + (lane >> 5); scr[kk * 33 + (lane & 31)] = W[(size_t)(k0 + kk) * N + n0 + (lane & 31)]; }
    asm volatile("s_waitcnt lgkmcnt(0)" ::: "memory");
    const int c = lane & 3;
#pragma unroll
    for (int j = 0; j < 2; ++j) { const int n = (lane >> 2) + 16 * j; const LAS float* s = scr + (16 * c) * 33 + n;
        u32x4 o; o.x = pg8::pk4_fp8(64.f * s[0 * 33], 64.f * s[1 * 33], 64.f * s[2 * 33], 64.f * s[3 * 33]); o.y = pg8::pk4_fp8(64.f * s[4 * 33], 64.f * s[5 * 33], 64.f * s[6 * 33], 64.f * s[7 * 33]);
        o.z = pg8::pk4_fp8(64.f * s[8 * 33], 64.f * s[9 * 33], 64.f * s[10 * 33], 64.f * s[11 * 33]); o.w = pg8::pk4_fp8(64.f * s[12 * 33], 64.f * s[13 * 33], 64.f * s[14 * 33], 64.f * s[15 * 33]);
        *(u32x4*)(WT + (size_t)(drow0 + n) * K + k0 + 16 * c) = o; }
    asm volatile("s_waitcnt lgkmcnt(0)" ::: "memory");
}

__device__ __forceinline__ const float* inp(int i) {
    int off = i * 8; asm volatile("" : "+s"(off));
    const __attribute__((address_space(4))) char* ka = (const __attribute__((address_space(4))) char*)__builtin_amdgcn_kernarg_segment_ptr();
    return *(const float* const __attribute__((address_space(4)))*)(ka + off);
}

struct Ctx {
    LAS unsigned char* lds; LAS unsigned* lctl;
    int tid, lane, wave, vcu, G;
    float* out; unsigned char* ws;
};

__device__ __forceinline__ Ctx fresh(const Ctx& F) { Ctx R = F; int ln, wv = F.wave; asm volatile("v_mbcnt_lo_u32_b32 %0, -1, 0\n\tv_mbcnt_hi_u32_b32 %0, -1, %0" : "=v"(ln)); asm volatile("" : "+s"(wv));
    R.lane = ln; R.wave = wv; R.tid = wv * 64 + ln; return R; }

constexpr int I_IN = (D / 64) * (D_IN / 64), I_OUT = (D / 64) * (D / 64), I_GU = (D / 64) * (D_FF / 64), I_DN = (D_FF / 64) * (D / 64), I_LRU = 2 * 2;
constexpr int E0 = 2 * I_IN, E1 = E0 + 2 * I_OUT, E2 = E1 + I_GU, E3 = E2 + I_GU, E4 = E3 + I_DN, E5 = E4 + NE * I_GU, E6 = E5 + NE * I_GU, E7 = E6 + NE * I_DN, E8 = E7 + 32 * I_LRU;
struct CvDesc { const f32x4* src; unsigned char* dst; int N4, K, fp8; };
__device__ __forceinline__ CvDesc cv_desc(const Ctx& F, const float* const* in, int it) {
    const int n4 = F.lane & 15, kq = F.lane >> 4;
    const float* W; unsigned char* WT; int K, N, kb, nb, gu = 0, fp8 = 0;
    if (it < E0) { const int l = it / I_IN, r = it % I_IN, nblk = D_IN / 64; kb = r / nblk; nb = r % nblk; W = inp(2) + (size_t)l * D * D_IN; K = D; N = D_IN; WT = F.ws + WS_WIN + (size_t)l * D_IN * D * 2; }
    else if (it < E1) { const int q = it - E0, l = q / I_OUT, r = q % I_OUT, nblk = D / 64; kb = r / nblk; nb = r % nblk; W = inp(12) + (size_t)l * D * D; K = D; N = D; WT = F.ws + WS_WOUT + (size_t)l * D * D * 2; }
    else if (it < E3) { const int q = it - E1, up = q / I_GU, r = q % I_GU, nblk = D_FF / 64; kb = r / nblk; nb = r % nblk; W = up ? inp(15) : inp(14); K = D; N = D_FF; WT = F.ws + WS_WGU_D; gu = 1 + up; }
    else if (it < E4) { const int r = it - E3, nblk = D / 32; kb = r / nblk; nb = r % nblk; W = inp(16); K = D_FF; N = D; WT = F.ws + WS_WDN_D; fp8 = 1; }
    else if (it < E6) { const int q = it - E4, up = q / (NE * I_GU), q2 = q % (NE * I_GU), e = q2 / I_GU, r = q2 % I_GU, nblk = D_FF / 32; kb = r / nblk; nb = r % nblk;
        W = (up ? inp(19) : inp(18)) + (size_t)e * D * D_FF; K = D; N = D_FF; WT = F.ws + WS_WGU_M + (size_t)e * 2 * D_FF * D; gu = 1 + up; fp8 = 1; }
    else if (it < E7) { const int q = it - E6, e = q / I_DN, r = q % I_DN, nblk = D / 32; kb = r / nblk; nb = r % nblk; W = inp(20) + (size_t)e * D_FF * D; K = D_FF; N = D; WT = F.ws + WS_WDN_M + (size_t)e * D * D_FF; fp8 = 1; }
    else { const int q = it - E7, mi = q / I_LRU, r = q % I_LRU; kb = r / 2; nb = r % 2;
        const int mat = (mi / 8) & 1, n = mi & 7, l = mi / 16; W = (mat ? inp(7) : inp(5)) + (size_t)(l * 8 + n) * 16384; K = 128; N = 128; WT = F.ws + WS_WLRU + (size_t)mi * 16384 * 2; }
    const int k0 = fp8 ? 128 * kb + 16 * (F.lane >> 3) : 64 * kb + 16 * kq, nn = fp8 ? 32 * nb + 4 * (F.lane & 7) : 64 * nb + 4 * n4;
    const int drow = gu ? ((nn >> 7) * 256 + (nn & 127) + (gu - 1) * 128) : nn;
    CvDesc d; d.src = (const f32x4*)(W + (size_t)k0 * N + nn); d.N4 = N / 4; d.K = K; d.fp8 = fp8; d.dst = WT + ((size_t)drow * K + k0) * (fp8 ? 1 : 2); return d;
}
__device__ __forceinline__ void cv_load(const CvDesc& d, f32x4 (&x)[16]) {
#pragma unroll
    for (int j = 0; j < 16; ++j) x[j] = d.src[(size_t)j * d.N4];
}
__device__ __forceinline__ void cv_store(const CvDesc& d, const f32x4 (&x)[16]) {
    if (d.fp8) {
#pragma unroll
        for (int c = 0; c < 4; ++c) { u32x4 o;
            o.x = pg8::pk4_fp8(64.f * x[0][c], 64.f * x[1][c], 64.f * x[2][c], 64.f * x[3][c]); o.y = pg8::pk4_fp8(64.f * x[4][c], 64.f * x[5][c], 64.f * x[6][c], 64.f * x[7][c]);
            o.z = pg8::pk4_fp8(64.f * x[8][c], 64.f * x[9][c], 64.f * x[10][c], 64.f * x[11][c]); o.w = pg8::pk4_fp8(64.f * x[12][c], 64.f * x[13][c], 64.f * x[14][c], 64.f * x[15][c]);
            *(u32x4*)(d.dst + (size_t)c * d.K) = o; }
    } else {
#pragma unroll
        for (int c = 0; c < 4; ++c) { u32x4 o0, o1;
            o0.x = pk2(x[0][c], x[1][c]); o0.y = pk2(x[2][c], x[3][c]); o0.z = pk2(x[4][c], x[5][c]); o0.w = pk2(x[6][c], x[7][c]);
            o1.x = pk2(x[8][c], x[9][c]); o1.y = pk2(x[10][c], x[11][c]); o1.z = pk2(x[12][c], x[13][c]); o1.w = pk2(x[14][c], x[15][c]);
            u32x4* dst = (u32x4*)(d.dst + (size_t)c * d.K * 2); dst[0] = o0; dst[1] = o1; }
    }
}
__device__ __forceinline__ void convert_items(const Ctx& F, const float* const* in, int lo, int hi, int w0, int nw) {
    int it = lo + w0; if (it >= hi) return;
    CvDesc cur = cv_desc(F, in, it); f32x4 x[16]; cv_load(cur, x);
    for (;;) {
        const int nx = it + nw; const bool more = nx < hi;
        CvDesc nxt = cur; f32x4 y[16];
        if (more) { nxt = cv_desc(F, in, nx); cv_load(nxt, y); }
        cv_store(cur, x);
        if (!more) break;
#pragma unroll
        for (int j = 0; j < 16; ++j) x[j] = y[j];
        cur = nxt; it = nx;
    }
}
__device__ __forceinline__ void w_quant_item(const Ctx& F, const float* W, int N, int nb, float* SW, unsigned char* WT, int gu) {
    const int n4 = F.lane & 7, nn = 32 * nb + 4 * n4, k0 = 256 * F.wave + 32 * (F.lane >> 3);
    const f32x4* src = (const f32x4*)(W + (size_t)k0 * N + nn);
    f32x4 x[32];
#pragma unroll
    for (int j = 0; j < 32; ++j) x[j] = src[(size_t)j * (N / 4)];
    f32x4 mx = (f32x4){0.f, 0.f, 0.f, 0.f};
#pragma unroll
    for (int j = 0; j < 32; ++j) mx = __builtin_elementwise_max(mx, __builtin_elementwise_abs(x[j]));
#pragma unroll
    for (int c = 0; c < 4; ++c) { float v = mx[c]; v = fmaxf(v, shfl_idx(v, F.lane ^ 8)); v = fmaxf(v, shfl_idx(v, F.lane ^ 16)); v = fmaxf(v, shfl_idx(v, F.lane ^ 32)); mx[c] = v; }
    LAS f32x4* cmx = (LAS f32x4*)F.lds;
    if ((F.lane >> 3) == 0) cmx[F.wave * 8 + n4] = mx;
    __syncthreads();
    f32x4 m = cmx[n4];
#pragma unroll
    for (int w = 1; w < 8; ++w) m = __builtin_elementwise_max(m, cmx[w * 8 + n4]);
    __syncthreads();
    const int drow = gu ? ((nn >> 7) * 256 + (nn & 127) + (gu - 1) * 128) : nn;
#pragma unroll
    for (int c = 0; c < 4; ++c) { const float cm = fmaxf(m[c], 1e-30f), inv = 127.0f / cm; unsigned w[8];
#pragma unroll
        for (int q = 0; q < 8; ++q) { unsigned pk = 0;
#pragma unroll
            for (int b = 0; b < 4; ++b) { const int v = (int)rintf(x[4 * q + b][c] * inv); pk |= ((unsigned)v & 0xffu) << (8 * b); }
            w[q] = pk; }
        u32x4* dst = (u32x4*)(WT + (size_t)(drow + c) * D + k0);
        dst[0] = (u32x4){w[0], w[1], w[2], w[3]}; dst[1] = (u32x4){w[4], w[5], w[6], w[7]};
        if (F.wave == 0 && (F.lane >> 3) == 0) SW[nn + c] = cm * (1.0f / 127.0f); }
}
constexpr int QI_GU = D_FF / 32, QI_IN = D_IN / 32, QI_ALL = 2 * QI_GU + 2 * QI_IN;
__device__ __forceinline__ void i8_quantize_items(const Ctx& F, int first, int count, int c, int G) {
    float* SW = (float*)(F.ws + WS_SW);
    for (int it = first + c; it < first + count; it += G) {
        if (it < 2 * QI_GU) { const int up = it >= QI_GU, nb = it - up * QI_GU; w_quant_item(F, up ? inp(15) : inp(14), D_FF, nb, SW + up * D_FF, F.ws + WS_WGU_D, 1 + up); }
        else { const int q = it - 2 * QI_GU, l = q >= QI_IN, nb = q - l * QI_IN; w_quant_item(F, inp(2) + (size_t)l * D * D_IN, D_IN, nb, SW + 2 * D_FF + l * D_IN, F.ws + WS_WIN + (size_t)l * D_IN * D, 0); }
    }
}
__device__ __forceinline__ void p0_convert(const Ctx& F, const float* const* in, int c, int G) {
    i8_quantize_items(F, 0, 2 * QI_GU, c, G); i8_quantize_items(F, 2 * QI_GU + QI_IN, QI_IN, c, G);
    const int gw = c * 8 + F.wave, NGW = G * 8;
    convert_items(F, in, E0, E1, gw, NGW); convert_items(F, in, E3, E8, gw, NGW);
}
__device__ __forceinline__ void p0_prologue(const Ctx& F) {
    i8_quantize_items(F, 2 * QI_GU, QI_IN, F.vcu, F.G);
    f32x2* ROPE = (f32x2*)(F.ws + WS_ROPE);
    for (int i = (F.vcu * 512 + F.tid); i < SEQ * 32; i += F.G * 512) {
        const int s = i >> 5, j = i & 31;
        const float invf = exp2f(-(float)j * (13.287712379549449f / 32.0f));
        const float ang = (float)s * invf;
        const float nrev = rintf(ang * 0.15915494309189535f);
        float r = fmaf(-nrev, 6.28125f, ang); r = fmaf(-nrev, 0.0019353071795864769f, r);
        ROPE[i] = (f32x2){cosf(r), sinf(r)};
    }
}

template <bool BF> struct XSel;
template <> struct XSel<false> { typedef f32x4 type;
    static __device__ __forceinline__ f32x4 load(const void* X, size_t row, int i) { return ((const f32x4*)((const float*)X + row * D))[i]; }
    static __device__ __forceinline__ f32x4 cvt(f32x4 v) { return v; } };
template <> struct XSel<true> { typedef u32x2 type;
    static __device__ __forceinline__ u32x2 load(const void* X, size_t row, int i) { return ((const u32x2*)((const bf16*)X + row * D))[i]; }
    static __device__ __forceinline__ f32x4 cvt(u32x2 w) { return (f32x4){bflo(w.x), bfhi(w.x), bflo(w.y), bfhi(w.y)}; } };
template <bool ROUTE, bool OUTI8 = false, bool XBF = false>
__device__ __forceinline__ void norm_phase(const Ctx& F, const void* Xv, const float* gain, bf16* H, const float* router) {
    const float* X = (const float*)Xv; const bf16* Xb = (const bf16*)Xv; (void)X; (void)Xb;
    const int gw = F.vcu * 8 + F.wave, NGW = F.G * 8;
    f32x4 gv[8];
#pragma unroll
    for (int j = 0; j < 8; ++j) gv[j] = ((const f32x4*)gain)[F.lane + 64 * j];
    LAS float* RT = (LAS float*)F.lds;
    LAS unsigned* lst = (LAS unsigned*)(F.lds + 65536);
    unsigned* TOPE = (unsigned*)(F.ws + WS_ROUTE + RT_TOPE); float* TOPG = (float*)(F.ws + WS_ROUTE + RT_TOPG);
    unsigned* TOPR = (unsigned*)(F.ws + WS_ROUTE + RT_TOPR); unsigned* CNTB = (unsigned*)(F.ws + WS_ROUTE + RT_CNTB);
    if (ROUTE) {
        for (int i = F.tid; i < D * NE; i += 512) { const int c = i >> 3, e = i & 7; RT[e * D + c] = router[i]; }
        __syncthreads();
    }
    int it = 0;
    typedef typename XSel<XBF>::type xrow_t;
    xrow_t vv[8];
    if (gw < T) {
#pragma unroll
        for (int j = 0; j < 8; ++j) vv[j] = XSel<XBF>::load(Xv, (size_t)gw, F.lane + 64 * j); }
    for (int m = gw; m < T; m += NGW, ++it) {
        xrow_t vn[8];
        if (m + NGW < T) {
#pragma unroll
            for (int j = 0; j < 8; ++j) vn[j] = XSel<XBF>::load(Xv, (size_t)(m + NGW), F.lane + 64 * j); }
        else {
#pragma unroll
            for (int j = 0; j < 8; ++j) vn[j] = vv[j]; }
        f32x4 v[8];
#pragma unroll
        for (int j = 0; j < 8; ++j) v[j] = XSel<XBF>::cvt(vv[j]);
        float ss = 0.f;
#pragma unroll
        for (int j = 0; j < 8; ++j) ss += (v[j].x * v[j].x + v[j].y * v[j].y) + (v[j].z * v[j].z + v[j].w * v[j].w);
        ss = wave_sum(ss, F.lane);
        const float rstd = 1.0f / sqrtf(ss * (1.0f / D) + EPS);
        if (OUTI8) {
            float mx = 0.f;
#pragma unroll
            for (int j = 0; j < 8; ++j) { v[j] = v[j] * rstd * gv[j]; mx = fmaxf(mx, fmaxf(fmaxf(fabsf(v[j].x), fabsf(v[j].y)), fmaxf(fabsf(v[j].z), fabsf(v[j].w)))); }
#pragma unroll
            for (int o = 1; o < 64; o <<= 1) mx = fmaxf(mx, shfl_x(mx, o, F.lane));
            mx = fmaxf(mx, 1e-30f); const float inv = 127.0f / mx;
            if (F.lane == 0) ((float*)(F.ws + WS_SA))[m] = mx * (1.0f / 127.0f);
            unsigned* o4 = (unsigned*)((unsigned char*)H + (size_t)m * D) + F.lane;
#pragma unroll
            for (int j = 0; j < 8; ++j) { const int a = (int)rintf(v[j].x * inv), b2 = (int)rintf(v[j].y * inv), c = (int)rintf(v[j].z * inv), d = (int)rintf(v[j].w * inv);
                o4[64 * j] = ((unsigned)a & 0xffu) | (((unsigned)b2 & 0xffu) << 8) | (((unsigned)c & 0xffu) << 16) | (((unsigned)d & 0xffu) << 24); }
        } else if (ROUTE) {
            unsigned* o4 = (unsigned*)((unsigned char*)H + (size_t)m * D) + F.lane;
#pragma unroll
            for (int j = 0; j < 8; ++j) { v[j] = v[j] * rstd * gv[j]; o4[64 * j] = pg8::pk4_fp8(v[j].x, v[j].y, v[j].z, v[j].w); }
        } else {
            u32x2* o8 = (u32x2*)(H + (size_t)m * D) + F.lane;
#pragma unroll
            for (int j = 0; j < 8; ++j) { v[j] = v[j] * rstd * gv[j]; o8[64 * j] = (u32x2){pk2(v[j].x, v[j].y), pk2(v[j].z, v[j].w)}; }
        }
        if (ROUTE) {
            float lg[8];
#pragma unroll
            for (int e = 0; e < 8; ++e) { float a = 0.f;
#pragma unroll
                for (int j = 0; j < 8; ++j) { const f32x4 r = ((const LAS f32x4*)(RT + e * D))[F.lane + 64 * j]; a += (v[j].x * r.x + v[j].y * r.y) + (v[j].z * r.z + v[j].w * r.w); }
                lg[e] = wave_sum(a, F.lane); }
            float v1 = -3.0e38f, v2 = -3.0e38f; int e1 = 0, e2 = 0;
#pragma unroll
            for (int e = 0; e < 8; ++e) { const float x = lg[e]; if (x > v1) { v2 = v1; e2 = e1; v1 = x; e1 = e; } else if (x > v2) { v2 = x; e2 = e; } }
            const float g2 = 1.0f / (1.0f + expf(v1 - v2)), g1 = 1.0f - g2;
            if (F.lane == 0) { TOPE[m] = (unsigned)e1 | ((unsigned)e2 << 8); TOPG[2 * m] = g1; TOPG[2 * m + 1] = g2; lst[it * 8 + F.wave] = (unsigned)e1 | ((unsigned)e2 << 8); }
        }
#pragma unroll
        for (int j = 0; j < 8; ++j) vv[j] = vn[j];
    }
    if (ROUTE) {
        __syncthreads();
        if (F.tid < NE) {
            const unsigned e = F.tid; unsigned cnt = 0;
            const int niter = (T + NGW - 1) / NGW;
            for (int i = 0; i < niter; ++i)
                for (int w = 0; w < 8; ++w) { const int m = F.vcu * 8 + w + i * NGW; if (m < T) { const unsigned ent = lst[i * 8 + w];
                    if ((ent & 0xffu) == e) TOPR[2 * m] = cnt++;
                    if (((ent >> 8) & 0xffu) == e) TOPR[2 * m + 1] = cnt++; } }
            CNTB[F.vcu * 8 + e] = cnt;
        }
    }
}

__device__ __forceinline__ void moe_tables(const Ctx& F) {
    const unsigned* CNTB = (const unsigned*)(F.ws + WS_ROUTE + RT_CNTB);
    {
        const int e = F.wave; unsigned tot = 0, pre = 0;
        for (int b = F.lane; b < F.G; b += 64) { const unsigned c = CNTB[b * 8 + e]; tot += c; pre += (b < F.vcu) ? c : 0u; }
#pragma unroll
        for (int o = 1; o < 64; o <<= 1) { tot += shfl_u(tot, F.lane ^ o); pre += shfl_u(pre, F.lane ^ o); }
        if (F.lane == 0) { F.lctl[LC_PRE + e] = pre; F.lctl[LC_TOT + e] = tot; }
    }
    __syncthreads();
    if (F.tid == 0) { unsigned tb = 0; for (int e = 0; e < NE; ++e) { F.lctl[LC_TB + e] = tb; tb += (F.lctl[LC_TOT + e] + 255u) >> 8; }
        F.lctl[LC_TB + 8] = tb; F.lctl[LC_NMT] = tb; }
    __syncthreads();
    if (F.tid < MAXMT) { unsigned e = 0;
#pragma unroll
        for (int k = 1; k < NE; ++k) e += ((unsigned)F.tid >= F.lctl[LC_TB + k]) ? 1u : 0u;
        F.lctl[LC_TEXP + F.tid] = e; }
    __syncthreads();
}

__device__ __forceinline__ void slot_tables(const Ctx& F) {
    const int gw = F.vcu * 8 + F.wave, NGW = F.G * 8;
    const unsigned* TOPE = (const unsigned*)(F.ws + WS_ROUTE + RT_TOPE); const unsigned* TOPR = (const unsigned*)(F.ws + WS_ROUTE + RT_TOPR); unsigned* SLOT = (unsigned*)(F.ws + WS_ROUTE + RT_SLOT);
    unsigned* ROWOF = (unsigned*)(F.ws + WS_ROUTE + RT_ROWOF);
    for (int m0 = gw; m0 < T; m0 += 32 * NGW) {
        const int m = m0 + (F.lane >> 1) * NGW, k = F.lane & 1;
        if (m < T) { const unsigned e = (TOPE[m] >> (8 * k)) & 0xffu; const unsigned slot = F.lctl[LC_TB + e] * 256u + F.lctl[LC_PRE + e] + TOPR[2 * m + k];
            SLOT[2 * m + k] = slot; ROWOF[slot] = (unsigned)m; }
    }
    if (F.vcu == 0) {
        for (int e = 0; e < NE; ++e) { const unsigned lo = F.lctl[LC_TB + e] * 256u + F.lctl[LC_TOT + e], hi = F.lctl[LC_TB + e + 1] * 256u;
            for (unsigned i = lo + F.tid; i < hi; i += 512) ROWOF[i] = 0u; }
    }
}

__device__ __forceinline__ void final_phase(const Ctx& F, const float* gain) {
    const int gw = F.vcu * 8 + F.wave, NGW = F.G * 8;
    const float* TOPG = (const float*)(F.ws + WS_ROUTE + RT_TOPG); const unsigned* SLOT = (const unsigned*)(F.ws + WS_ROUTE + RT_SLOT);
    const bf16* OS = (const bf16*)(F.ws + WS_PROJ); const bf16* OS2 = (const bf16*)(F.ws + WS_H);
    LAS unsigned char* SPL = (LAS unsigned char*)(F.lctl + LC_SPLIT);
    { pg8::SplitOrder S; S.init((int)F.lctl[LC_NMT], D / 256, F.G, 0, nullptr); S.init2();
      for (int i = F.tid; i < MAXMT * 8; i += 512) SPL[i] = 0xffu;
      __syncthreads();
      if (F.tid < S.rem) { pg8::Unit u; if (S.unit_at((long)S.R * S.G + F.tid, u)) SPL[u.pm * 8 + u.pn] = (unsigned char)F.tid; }
      __syncthreads(); }
    f32x4 gv[8];
#pragma unroll
    for (int j = 0; j < 8; ++j) gv[j] = ((const f32x4*)gain)[F.lane + 64 * j];
    float g1 = 0.f, g2 = 0.f, ng1 = 0.f, ng2 = 0.f; unsigned s1 = 0, s2 = 0, ns1 = 0, ns2 = 0;
    const bf16* XR = (const bf16*)(F.ws + WS_XR);
    u32x2 xv[8]; u32x2 av[8], bv[8];
    if (gw < T) { g1 = TOPG[2 * gw]; g2 = TOPG[2 * gw + 1]; s1 = SLOT[2 * gw]; s2 = SLOT[2 * gw + 1];
        const u32x2* xr0 = (const u32x2*)(XR + (size_t)gw * D) + F.lane; const u32x2* o1 = (const u32x2*)(OS + (size_t)s1 * D) + F.lane; const u32x2* o2 = (const u32x2*)(OS + (size_t)s2 * D) + F.lane;
#pragma unroll
        for (int j = 0; j < 8; ++j) { xv[j] = xr0[64 * j]; av[j] = o1[64 * j]; bv[j] = o2[64 * j]; } }
    if (gw + NGW < T) { const int mn = gw + NGW; ng1 = TOPG[2 * mn]; ng2 = TOPG[2 * mn + 1]; ns1 = SLOT[2 * mn]; ns2 = SLOT[2 * mn + 1]; }
    for (int m = gw; m < T; m += NGW) {
        f32x4* xr = (f32x4*)(F.out + (size_t)m * D) + F.lane;
        u32x2 xn[8]; u32x2 an[8], bn[8]; float fg1 = 0.f, fg2 = 0.f; unsigned fs1 = 0, fs2 = 0;
        if (m + NGW < T) { const u32x2* xrn = (const u32x2*)(XR + (size_t)(m + NGW) * D) + F.lane; const u32x2* o1 = (const u32x2*)(OS + (size_t)ns1 * D) + F.lane; const u32x2* o2 = (const u32x2*)(OS + (size_t)ns2 * D) + F.lane;
#pragma unroll
            for (int j = 0; j < 8; ++j) { xn[j] = xrn[64 * j]; an[j] = o1[64 * j]; bn[j] = o2[64 * j]; } }
        else {
#pragma unroll
            for (int j = 0; j < 8; ++j) { xn[j] = xv[j]; an[j] = av[j]; bn[j] = bv[j]; } }
        if (m + 2 * NGW < T) { const int mf = m + 2 * NGW; fg1 = TOPG[2 * mf]; fg2 = TOPG[2 * mf + 1]; fs1 = SLOT[2 * mf]; fs2 = SLOT[2 * mf + 1]; }
        f32x4 v[8]; float ss = 0.f;
#pragma unroll
        for (int j = 0; j < 8; ++j) { const u32x2 a = av[j], b = bv[j]; v[j] = (f32x4){bflo(xv[j].x), bfhi(xv[j].x), bflo(xv[j].y), bfhi(xv[j].y)};
            float va[4] = {bflo(a.x), bfhi(a.x), bflo(a.y), bfhi(a.y)}, vb[4] = {bflo(b.x), bfhi(b.x), bflo(b.y), bfhi(b.y)};
            const unsigned q1 = SPL[(s1 >> 8) * 8 + j], q2 = SPL[(s2 >> 8) * 8 + j];
            if (q1 != 0xffu) { const u32x2 c = ((const u32x2*)(OS2 + ((size_t)q1 * 256 + (s1 & 255u)) * 256))[F.lane]; va[0] += bflo(c.x); va[1] += bfhi(c.x); va[2] += bflo(c.y); va[3] += bfhi(c.y); }
            if (q2 != 0xffu) { const u32x2 c = ((const u32x2*)(OS2 + ((size_t)q2 * 256 + (s2 & 255u)) * 256))[F.lane]; vb[0] += bflo(c.x); vb[1] += bfhi(c.x); vb[2] += bflo(c.y); vb[3] += bfhi(c.y); }
            v[j].x += g1 * va[0] + g2 * vb[0]; v[j].y += g1 * va[1] + g2 * vb[1]; v[j].z += g1 * va[2] + g2 * vb[2]; v[j].w += g1 * va[3] + g2 * vb[3];
            ss += (v[j].x * v[j].x + v[j].y * v[j].y) + (v[j].z * v[j].z + v[j].w * v[j].w); }
        ss = wave_sum(ss, F.lane);
        const float rstd = 1.0f / sqrtf(ss * (1.0f / D) + EPS);
#pragma unroll
        for (int j = 0; j < 8; ++j) xr[64 * j] = v[j] * rstd * gv[j];
#pragma unroll
        for (int j = 0; j < 8; ++j) { xv[j] = xn[j]; av[j] = an[j]; bv[j] = bn[j]; }
        g1 = ng1; g2 = ng2; s1 = ns1; s2 = ns2; ng1 = fg1; ng2 = fg2; ns1 = fs1; ns2 = fs2;
    }
}

__device__ __forceinline__ void lru_unit(const Ctx& F, int l, int b, int n, int hf, const float* const* in) {
    asm volatile("" : "+s"(l), "+s"(b), "+s"(n), "+s"(hf));
    const int tid = F.tid, wave = F.wave, lane = F.lane, fr = lane & 15, fq = lane >> 4, nt = wave & 3, mh = wave >> 2;
    LAS unsigned char* XC = F.lds; LAS float* EX = (LAS float*)(F.lds + 32768);
    LAS float* HS = EX + 256;
    static_assert(32768 + (256 + 128 * 68) * 4 <= LDSCTL_OFF, "RG-LRU LDS map");
    const bf16* PROJ = (const bf16*)(F.ws + WS_PROJ); bf16* Y = (bf16*)(F.ws + WS_H); float* SSP = (float*)(F.ws + WS_SSP);
    const bf16* WL = (const bf16*)(F.ws + WS_WLRU) + (size_t)l * 2 * 8 * 16384;
    const int os_g = tid & 7, os_tok = tid >> 3;
    float gn[8]; { const f32x4 a = *(const f32x4*)(inp(10) + (size_t)l * D_RNN + n * 128 + hf * 64 + 8 * os_g), c = *(const f32x4*)(inp(10) + (size_t)l * D_RNN + n * 128 + hf * 64 + 8 * os_g + 4);
        gn[0] = a.x; gn[1] = a.y; gn[2] = a.z; gn[3] = a.w; gn[4] = c.x; gn[5] = c.y; gn[6] = c.z; gn[7] = c.w; }
    const int cg = tid & 15, tl = tid >> 4, cch = n * 128 + cg * 8;
    const int prow0 = ((tl >> 4) << 6) | ((tl & 3) << 4) | (((tl >> 2) & 3) << 2);
    float cw[4][8], cb[8];
#pragma unroll
    for (int tap = 0; tap < 4; ++tap) { const f32x4 a = *(const f32x4*)(inp(3) + (size_t)(l * 4 + tap) * D_RNN + cch), c = *(const f32x4*)(inp(3) + (size_t)(l * 4 + tap) * D_RNN + cch + 4);
        cw[tap][0] = a.x; cw[tap][1] = a.y; cw[tap][2] = a.z; cw[tap][3] = a.w; cw[tap][4] = c.x; cw[tap][5] = c.y; cw[tap][6] = c.z; cw[tap][7] = c.w; }
    { const f32x4 a = *(const f32x4*)(inp(4) + (size_t)l * D_RNN + cch), c = *(const f32x4*)(inp(4) + (size_t)l * D_RNN + cch + 4);
        cb[0] = a.x; cb[1] = a.y; cb[2] = a.z; cb[3] = a.w; cb[4] = c.x; cb[5] = c.y; cb[6] = c.z; cb[7] = c.w; }
    const int lc = hf * 64 + nt * 16 + fr, gc = n * 128 + lc;
    const float ba_c = inp(6)[l * D_RNN + gc], bx_c = inp(8)[l * D_RNN + gc];
    const float sp8 = 8.0f * log1pf(expf(-inp(9)[l * D_RNN + gc]));
    bf16x8 Wa[4], Wx[4];
#pragma unroll
    for (int ks = 0; ks < 4; ++ks) { Wa[ks] = *(const bf16x8*)(WL + (size_t)((0 * 8 + n) * 128 + lc) * 128 + 32 * ks + 8 * fq);
                                     Wx[ks] = *(const bf16x8*)(WL + (size_t)((1 * 8 + n) * 128 + lc) * 128 + 32 * ks + 8 * fq); }
    float Hc = 0.f;
    u32x4 xr[7];
#pragma unroll
    for (int r = 0; r < 7; ++r) { const int t = 4 * tl - 3 + r; xr[r] = (u32x4){0u, 0u, 0u, 0u}; if (t >= 0) xr[r] = *(const u32x4*)(PROJ + (size_t)(b * SEQ + t) * D_IN + cch); }
    for (int ck = 0; ck < SEQ / 128; ++ck) {
        const int t0 = ck * 128;
        {
            float xv[7][8];
#pragma unroll
            for (int r = 0; r < 7; ++r) { const u32x4 w = xr[r];
                xv[r][0] = bflo(w.x); xv[r][1] = bfhi(w.x); xv[r][2] = bflo(w.y); xv[r][3] = bfhi(w.y); xv[r][4] = bflo(w.z); xv[r][5] = bfhi(w.z); xv[r][6] = bflo(w.w); xv[r][7] = bfhi(w.w); }
#pragma unroll
            for (int q = 0; q < 4; ++q) { float y[8];
#pragma unroll
                for (int c = 0; c < 8; ++c) { float a = cb[c];
#pragma unroll
                    for (int tap = 0; tap < 4; ++tap) a += cw[tap][c] * xv[q + tap][c];
                    y[c] = a; }
                *(LAS u32x4*)(XC + tile_off(prow0 + q, 8 * cg, 4)) = (u32x4){pk2(y[0], y[1]), pk2(y[2], y[3]), pk2(y[4], y[5]), pk2(y[6], y[7])}; }
        }
        __syncthreads();
        if (ck + 1 < SEQ / 128) {
#pragma unroll
            for (int r = 0; r < 7; ++r) xr[r] = *(const u32x4*)(PROJ + (size_t)(b * SEQ + t0 + 128 + 4 * tl - 3 + r) * D_IN + cch);
        }
        u32x4 gpre[2];
#pragma unroll
        for (int j = 0; j < 2; ++j) gpre[j] = *(const u32x4*)(PROJ + (size_t)(b * SEQ + t0 + os_tok + 64 * j) * D_IN + OFF_GATE + n * 128 + hf * 64 + 8 * os_g);
        float av[16], bv[16];
#pragma unroll
        for (int mi = 0; mi < 4; ++mi) {
            const int mt = 4 * mh + mi;
            f32x4 aa = (f32x4){0.f, 0.f, 0.f, 0.f}, ax = (f32x4){0.f, 0.f, 0.f, 0.f};
#pragma unroll
            for (int ks = 0; ks < 4; ++ks) { const bf16x8 xf = lds_frag(XC, tile_off(16 * mt + fr, 32 * ks + 8 * fq, 4)); aa = MFMA16(xf, Wa[ks], aa); ax = MFMA16(xf, Wx[ks], ax); }
#pragma unroll
            for (int i = 0; i < 4; ++i) { const int tok = 64 * mh + 16 * fq + 4 * mi + i;
                const float r = sigmoidf_(aa[i] + ba_c), ig = sigmoidf_(ax[i] + bx_c);
                const float a = __expf(-sp8 * r); float mult = sqrtf(fmaxf(1.0f - a * a, 0.f));
                if (ck == 0 && tok == 0) mult = 1.0f;
                const float xcv = __builtin_bit_cast(float, (unsigned)(*(const LAS unsigned short*)(XC + tile_off(16 * mt + 4 * fq + i, lc, 4))) << 16);
                av[4 * mi + i] = a; bv[4 * mi + i] = mult * ig * xcv; }
        }
        float P = av[0], Q = bv[0];
#pragma unroll
        for (int k = 1; k < 16; ++k) { P *= av[k]; Q = Q * av[k] + bv[k]; }
        { const float P1 = shfl_idx(P, lane - 16), Q1 = shfl_idx(Q, lane - 16); if (fq >= 1) { Q = P * Q1 + Q; P = P * P1; } }
        { const float P2 = shfl_idx(P, lane - 32), Q2 = shfl_idx(Q, lane - 32); if (fq >= 2) { Q = P * Q2 + Q; P = P * P2; } }
        float Pex = shfl_idx(P, lane - 16), Qex = shfl_idx(Q, lane - 16); if (fq == 0) { Pex = 1.0f; Qex = 0.f; }
        const float Pc = shfl_idx(P, fr + 48), Qc = shfl_idx(Q, fr + 48);
        if (fq == 0) { EX[((mh * 4 + nt) * 16 + fr) * 2] = Pc; EX[((mh * 4 + nt) * 16 + fr) * 2 + 1] = Qc; }
        __syncthreads();
        const float P0 = EX[((0 * 4 + nt) * 16 + fr) * 2], Q0 = EX[((0 * 4 + nt) * 16 + fr) * 2 + 1], P1h = EX[((1 * 4 + nt) * 16 + fr) * 2], Q1h = EX[((1 * 4 + nt) * 16 + fr) * 2 + 1];
        const float Hmid = P0 * Hc + Q0;
        const float Hw = (mh == 0) ? Hc : Hmid;
        Hc = P1h * Hmid + Q1h;
        {
            float h = Pex * Hw + Qex;
#pragma unroll
            for (int k = 0; k < 16; ++k) { h = av[k] * h + bv[k]; HS[(64 * mh + 16 * fq + k) * 68 + nt * 16 + fr] = h; }
        }
        __syncthreads();
#pragma unroll
        for (int j = 0; j < 2; ++j) { const int tk = os_tok + 64 * j; const size_t row = (size_t)(b * SEQ + t0 + tk);
            const u32x4 gw = gpre[j];
            const f32x4 h0 = *(const LAS f32x4*)(HS + tk * 68 + 8 * os_g), h1 = *(const LAS f32x4*)(HS + tk * 68 + 8 * os_g + 4);
            const float hh[8] = {h0.x, h0.y, h0.z, h0.w, h1.x, h1.y, h1.z, h1.w};
            {
                float ss = ((hh[0] * hh[0] + hh[1] * hh[1]) + (hh[2] * hh[2] + hh[3] * hh[3])) + ((hh[4] * hh[4] + hh[5] * hh[5]) + (hh[6] * hh[6] + hh[7] * hh[7]));
                ss += shfl_x(ss, 1, lane); ss += shfl_x(ss, 2, lane); ss += shfl_x(ss, 4, lane);
                if (os_g == 0) SSP[row * 16 + (n * 2 + hf)] = ss; }
            const float g[8] = {bflo(gw.x), bfhi(gw.x), bflo(gw.y), bfhi(gw.y), bflo(gw.z), bfhi(gw.z), bflo(gw.w), bfhi(gw.w)}; float y[8];
#pragma unroll
            for (int r = 0; r < 8; ++r) { const float x = g[r]; y[r] = hh[r] * gn[r] * (x * sigmoidf_(1.5957691216f * (x + 0.044715f * x * x * x))); }
            *(u32x4*)(Y + row * D + n * 128 + hf * 64 + 8 * os_g) = (u32x4){pk2(y[0], y[1]), pk2(y[2], y[3]), pk2(y[4], y[5]), pk2(y[6], y[7])}; }
    }
    __syncthreads();
}

typedef short s16x4 __attribute__((ext_vector_type(4)));
__device__ __forceinline__ bf16x8 tr_frag(LAS unsigned char* base, int stride, int krow0, int col0, int lane) {
    const int g = lane >> 4, i = lane & 15, q = i >> 2, p = i & 3;
    const s16x4 lo = __builtin_amdgcn_ds_read_tr16_b64_v4i16((LAS s16x4*)(base + (krow0 + 8 * g + q) * stride + (col0 + 4 * p) * 2));
    const s16x4 hi = __builtin_amdgcn_ds_read_tr16_b64_v4i16((LAS s16x4*)(base + (krow0 + 8 * g + 4 + q) * stride + (col0 + 4 * p) * 2));
    return __builtin_shufflevector(lo, hi, 0, 1, 2, 3, 4, 5, 6, 7);
}
constexpr int SKZ = 144, SVS = 288;
__device__ __forceinline__ void ret_unit(const Ctx& F, int l, int b, int h, int c0, int c1, const float* const* in) {
    asm volatile("" : "+s"(l), "+s"(b), "+s"(h), "+s"(c0), "+s"(c1));
    const int tid = F.tid, wave = F.wave, lane = F.lane, fr = lane & 15, fq = lane >> 4;
    LAS unsigned char* Qs = F.lds; LAS unsigned char* Ks = F.lds + 16384; LAS unsigned char* Kz = F.lds + 32768; LAS unsigned char* Vs = Kz + 128 * SKZ;
    LAS unsigned char* Ps = Vs + 128 * SVS; LAS unsigned char* STs = Ps + 32768;
    static_assert(32768 + 128 * SKZ + 128 * SVS + 32768 + 16384 <= LDSCTL_OFF, "retention LDS map");
    const bf16* PROJ = (const bf16*)(F.ws + WS_PROJ); bf16* Y = (bf16*)(F.ws + WS_H); const f32x2* ROPE = (const f32x2*)(F.ws + WS_ROPE);
    const float* rg = inp(11) + (size_t)l * 1024 + h * 128;
    const float lgm = log2f(1.0f - exp2f(-5.0f - (float)h));
    const float cdec = exp2f(128.0f * lgm);
    const int tok = tid >> 2, seg = tid & 3;
    const float zeta = exp2f((float)(127 - tok) * lgm);
    f32x4 accS[4];
#pragma unroll
    for (int dt = 0; dt < 4; ++dt) accS[dt] = (f32x4){0.f, 0.f, 0.f, 0.f};
    f32x4 pr_cs[4]; u32x4 pr_k[2], pr_v[4], pr_q[2];
#define RET_LOAD(ckk, want_q) do { const size_t ro_ = (size_t)(b * SEQ + (ckk) * 128 + tok) * D_IN; const f32x4* cs_ = (const f32x4*)(ROPE + (size_t)((ckk) * 128 + tok) * 32 + 8 * seg); \
        _Pragma("unroll") for (int i_ = 0; i_ < 4; ++i_) pr_cs[i_] = cs_[i_]; \
        pr_k[0] = *(const u32x4*)(PROJ + ro_ + OFF_K + h * 64 + 8 * seg); pr_k[1] = *(const u32x4*)(PROJ + ro_ + OFF_K + h * 64 + 32 + 8 * seg); \
        _Pragma("unroll") for (int q_ = 0; q_ < 4; ++q_) pr_v[q_] = *(const u32x4*)(PROJ + ro_ + OFF_V + h * 128 + 32 * seg + 8 * q_); \
        if (want_q) { pr_q[0] = *(const u32x4*)(PROJ + ro_ + OFF_Q + h * 64 + 8 * seg); pr_q[1] = *(const u32x4*)(PROJ + ro_ + OFF_Q + h * 64 + 32 + 8 * seg); } } while (0)
    pr_q[0] = pr_q[1] = (u32x4){0u, 0u, 0u, 0u};
    RET_LOAD(0, c0 == 0);
    for (int ck = 0; ck < c1; ++ck) {
        const int t0 = ck * 128; const bool full = ck >= c0;
        if (full) {
#pragma unroll
            for (int dt = 0; dt < 4; ++dt) *(LAS u32x2*)(STs + tile_off(16 * wave + fr, 16 * dt + 4 * fq, 2)) = (u32x2){pk2(accS[dt][0], accS[dt][1]), pk2(accS[dt][2], accS[dt][3])};
        }
        {
            float c[8], s[8];
#pragma unroll
            for (int i = 0; i < 4; ++i) { const f32x4 v = pr_cs[i]; c[2 * i] = v.x; s[2 * i] = v.y; c[2 * i + 1] = v.z; s[2 * i + 1] = v.w; }
            if (full) {
                const u32x4 w1 = pr_q[0], w2 = pr_q[1];
                const float x1[8] = {bflo(w1.x), bfhi(w1.x), bflo(w1.y), bfhi(w1.y), bflo(w1.z), bfhi(w1.z), bflo(w1.w), bfhi(w1.w)};
                const float x2[8] = {bflo(w2.x), bfhi(w2.x), bflo(w2.y), bfhi(w2.y), bflo(w2.z), bfhi(w2.z), bflo(w2.w), bfhi(w2.w)};
                float r1[8], r2[8];
#pragma unroll
                for (int i = 0; i < 8; ++i) { r1[i] = x1[i] * c[i] - x2[i] * s[i]; r2[i] = x1[i] * s[i] + x2[i] * c[i]; }
                *(LAS u32x4*)(Qs + tile_off(tok, 8 * seg, 2)) = (u32x4){pk2(r1[0], r1[1]), pk2(r1[2], r1[3]), pk2(r1[4], r1[5]), pk2(r1[6], r1[7])};
                *(LAS u32x4*)(Qs + tile_off(tok, 32 + 8 * seg, 2)) = (u32x4){pk2(r2[0], r2[1]), pk2(r2[2], r2[3]), pk2(r2[4], r2[5]), pk2(r2[6], r2[7])};
            }
            {
                const u32x4 w1 = pr_k[0], w2 = pr_k[1];
                const float x1[8] = {bflo(w1.x), bfhi(w1.x), bflo(w1.y), bfhi(w1.y), bflo(w1.z), bfhi(w1.z), bflo(w1.w), bfhi(w1.w)};
                const float x2[8] = {bflo(w2.x), bfhi(w2.x), bflo(w2.y), bfhi(w2.y), bflo(w2.z), bfhi(w2.z), bflo(w2.w), bfhi(w2.w)};
                float r1[8], r2[8];
#pragma unroll
                for (int i = 0; i < 8; ++i) { r1[i] = (x1[i] * c[i] - x2[i] * s[i]) * 0.125f; r2[i] = (x1[i] * s[i] + x2[i] * c[i]) * 0.125f; }
                if (full) {
                    *(LAS u32x4*)(Ks + tile_off(tok, 8 * seg, 2)) = (u32x4){pk2(r1[0], r1[1]), pk2(r1[2], r1[3]), pk2(r1[4], r1[5]), pk2(r1[6], r1[7])};
                    *(LAS u32x4*)(Ks + tile_off(tok, 32 + 8 * seg, 2)) = (u32x4){pk2(r2[0], r2[1]), pk2(r2[2], r2[3]), pk2(r2[4], r2[5]), pk2(r2[6], r2[7])};
                }
#pragma unroll
                for (int i = 0; i < 8; ++i) { r1[i] *= zeta; r2[i] *= zeta; }
                *(LAS u32x4*)(Kz + tok * SKZ + 16 * seg) = (u32x4){pk2(r1[0], r1[1]), pk2(r1[2], r1[3]), pk2(r1[4], r1[5]), pk2(r1[6], r1[7])};
                *(LAS u32x4*)(Kz + tok * SKZ + 64 + 16 * seg) = (u32x4){pk2(r2[0], r2[1]), pk2(r2[2], r2[3]), pk2(r2[4], r2[5]), pk2(r2[6], r2[7])};
            }
#pragma unroll
            for (int q = 0; q < 4; ++q) *(LAS u32x4*)(Vs + tok * SVS + 64 * seg + 16 * q) = pr_v[q];
        }
        __syncthreads();
        if (ck + 1 < c1) RET_LOAD(ck + 1, ck + 1 >= c0);
        if (full) {
            bf16x8 qf[2];
#pragma unroll
            for (int ks = 0; ks < 2; ++ks) qf[ks] = lds_frag(Qs, tile_off(16 * wave + fr, 32 * ks + 8 * fq, 2));
            int irow = 16 * wave + fr; float lgv = lgm; asm volatile("" : "+v"(irow), "+v"(lgv));
#pragma unroll
            for (int jt = 0; jt < 8; ++jt) {
                u32x2 pw = (u32x2){0u, 0u};
                if (jt <= wave) {
                    f32x4 sc = (f32x4){0.f, 0.f, 0.f, 0.f};
#pragma unroll
                    for (int ks = 0; ks < 2; ++ks) sc = MFMA16(lds_frag(Ks, tile_off(16 * jt + fr, 32 * ks + 8 * fq, 2)), qf[ks], sc);
                    float p[4];
#pragma unroll
                    for (int r = 0; r < 4; ++r) { const int dij = irow - (16 * jt + 4 * fq + r); p[r] = (dij >= 0) ? sc[r] * __builtin_amdgcn_exp2f((float)dij * lgv) : 0.f; }
                    pw = (u32x2){pk2(p[0], p[1]), pk2(p[2], p[3])};
                }
                *(LAS u32x2*)(Ps + tile_off(irow, 16 * jt + 4 * fq, 4)) = pw;
            }
            __syncthreads();
            bf16x8 pf[4];
#pragma unroll
            for (int ks = 0; ks < 4; ++ks) pf[ks] = lds_frag(Ps, tile_off(16 * wave + fr, 32 * ks + 8 * fq, 4));
            const float xi = __builtin_amdgcn_exp2f((float)(irow + 1) * lgv);
            float o[8][4]; float sum = 0.f;
#pragma unroll
            for (int et = 0; et < 8; ++et) {
                f32x4 ao = (f32x4){0.f, 0.f, 0.f, 0.f}, ac = (f32x4){0.f, 0.f, 0.f, 0.f};
#pragma unroll
                for (int ks = 0; ks < 4; ++ks) if (32 * ks <= 16 * wave + 15) ao = MFMA16(tr_frag(Vs, SVS, 32 * ks, 16 * et, lane), pf[ks], ao);
#pragma unroll
                for (int ks = 0; ks < 2; ++ks) ac = MFMA16(lds_frag(STs, tile_off(16 * et + fr, 32 * ks + 8 * fq, 2)), qf[ks], ac);
#pragma unroll
                for (int r = 0; r < 4; ++r) { o[et][r] = ao[r] + xi * ac[r]; sum += o[et][r]; }
            }
            sum += shfl_x(sum, 16, lane); sum += shfl_x(sum, 32, lane);
            const float mean = sum * (1.0f / 128.0f); float var = 0.f;
#pragma unroll
            for (int et = 0; et < 8; ++et)
#pragma unroll
                for (int r = 0; r < 4; ++r) { const float d = o[et][r] - mean; var += d * d; }
            var += shfl_x(var, 16, lane); var += shfl_x(var, 32, lane);
            const float rstd = 1.0f / sqrtf(var * (1.0f / 128.0f) + EPS);
            {
                const size_t rowo = (size_t)(b * SEQ + t0 + irow);
#pragma unroll
                for (int et = 0; et < 8; ++et) {
                    const u32x2 gw = *(const u32x2*)(PROJ + rowo * D_IN + OFF_G + h * 128 + 16 * et + 4 * fq);
                    const f32x4 gn = *(const f32x4*)(rg + 16 * et + 4 * fq);
                    const float g[4] = {bflo(gw.x), bfhi(gw.x), bflo(gw.y), bfhi(gw.y)};
                    float y[4];
#pragma unroll
                    for (int r = 0; r < 4; ++r) y[r] = (o[et][r] - mean) * rstd * gn[r] * (g[r] * sigmoidf_(g[r]));
                    *(u32x2*)(Y + rowo * D + 1024 + h * 128 + 16 * et + 4 * fq) = (u32x2){pk2(y[0], y[1]), pk2(y[2], y[3])};
                }
            }
        }
        {
            bf16x8 vf[4];
#pragma unroll
            for (int ks = 0; ks < 4; ++ks) vf[ks] = tr_frag(Vs, SVS, 32 * ks, 16 * wave, lane);
#pragma unroll
            for (int dt = 0; dt < 4; ++dt) { accS[dt] = accS[dt] * cdec;
#pragma unroll
                for (int ks = 0; ks < 4; ++ks) accS[dt] = MFMA16(tr_frag(Kz, SKZ, 32 * ks, 16 * dt, lane), vf[ks], accS[dt]); }
        }
        __syncthreads();
    }
#undef RET_LOAD
}

__device__ __forceinline__ void ylru_phase(const Ctx& F, int l, const float* gain) {
    const int gw = F.vcu * 8 + F.wave, NGW = F.G * 8;
    const float* HLRU = (const float*)(F.ws + WS_HID); const float* SSP = (const float*)(F.ws + WS_SSP); const bf16* PROJ = (const bf16*)(F.ws + WS_PROJ); bf16* Y = (bf16*)(F.ws + WS_H);
    f32x4 gv[4];
#pragma unroll
    for (int j = 0; j < 4; ++j) gv[j] = ((const f32x4*)(gain + (size_t)l * D_RNN))[F.lane + 64 * j];
    for (int m = gw; m < T; m += NGW) {
        float ss = 0.f;
#pragma unroll
        for (int n = 0; n < 16; ++n) ss += SSP[(size_t)n * T + m];
        const float rstd = 1.0f / sqrtf(ss * (1.0f / D_RNN) + EPS);
#pragma unroll
        for (int j = 0; j < 4; ++j) { const f32x4 hh = ((const f32x4*)(HLRU + (size_t)m * D_RNN))[F.lane + 64 * j];
            const u32x2 gw2 = ((const u32x2*)(PROJ + (size_t)m * D_IN + OFF_GATE))[F.lane + 64 * j];
            const float g[4] = {bflo(gw2.x), bfhi(gw2.x), bflo(gw2.y), bfhi(gw2.y)}; float y[4];
#pragma unroll
            for (int r = 0; r < 4; ++r) { const float x = g[r]; const float ge = x * sigmoidf_(1.5957691216f * (x + 0.044715f * x * x * x)); y[r] = hh[r] * rstd * gv[j][r] * ge; }
            ((u32x2*)(Y + (size_t)m * D))[F.lane + 64 * j] = (u32x2){pk2(y[0], y[1]), pk2(y[2], y[3])}; }
    }
}

constexpr int NPHASE = 20;
struct Args { const float* in[22]; float* out; unsigned char* ws; int ph_lo, ph_hi, li, pad; };
__global__ void __launch_bounds__(512, 2) fwd(Args args) {
    extern __shared__ __attribute__((aligned(16))) unsigned char lds_raw[];
    Ctx F;
    F.lds = (LAS unsigned char*)lds_raw; F.lctl = (LAS unsigned*)(F.lds + LDSCTL_OFF);
    F.tid = threadIdx.x; F.lane = F.tid & 63; F.wave = __builtin_amdgcn_readfirstlane(F.tid >> 6);
    F.G = gridDim.x; { const int bx = blockIdx.x; F.vcu = (F.G % 8 == 0) ? (bx % 8) * (F.G / 8) + bx / 8 : bx; }
    F.out = args.out; F.ws = args.ws;
    for (int u = F.tid; u < (LDS_BYTES - LDSCTL_OFF) / 4; u += 512) F.lctl[u] = 0u;
    __syncthreads();
    unsigned* ctl = (unsigned*)(args.ws + WS_CTL);
    XcdBarrier bar = xcd_barrier_post(ctl + CW_BAR + args.li * XCD_BAR_WORDS, (volatile LAS unsigned*)(F.lctl + LC_BAR));
    const int lo = args.ph_lo, hi = args.ph_hi;
#define IN(k) (lo <= (k) && (k) < hi)
#define SEAM(k) do { if ((k) + 1 < hi) xcd_barrier(bar); } while (0)
    bf16* Hb = (bf16*)(args.ws + WS_H); bf16* PROJ = (bf16*)(args.ws + WS_PROJ); bf16* HID = (bf16*)(args.ws + WS_HID);

    if (IN(0)) REPEAT(REP_P0) { const Ctx P = fresh(F); p0_prologue(P); norm_phase<false, true>(P, inp(0), inp(1), Hb, nullptr); SEAM(0); }

    for (int l = 0; l < 2; ++l) {
        const int pb = 1 + 9 * l;
        bf16* XR = (bf16*)(args.ws + WS_XR);
        if (IN(pb + 0) && l == 1) REPEAT(REP_NORM) { const Ctx P = fresh(F); norm_phase<false, true, true>(P, XR, inp(1) + (size_t)l * D, Hb, nullptr); SEAM(pb + 0); }
        if (IN(pb + 1)) REPEAT(REP_GIN) {
            const Ctx P = fresh(F);
            int Gv = F.G, cv = (int)blockIdx.x; bool gemm = true;
            if (l == 0) {
                const int xcd = (int)blockIdx.x % 8, idx = (int)blockIdx.x / 8, per = F.G / 8, nc = (F.G % 8 == 0 && per > GIN0_NC) ? GIN0_NC : 0;
                int cc = F.vcu, cg = F.G; bool conv = true;
                if (nc != 0) { if (idx >= per - nc) { cc = (idx - (per - nc)) * 8 + xcd; cg = nc * 8; gemm = false; } else { conv = false; Gv = (per - nc) * 8; cv = idx * 8 + xcd; } }
                if (conv) p0_convert(P, args.in, cc, cg);
            }
            if (gemm) {
                pg8::Gemm g{Hb, args.ws + WS_WIN + (size_t)l * D_IN * D, D}; pg8::ScaleOrder S; S.init(T / 256, D_IN / 256, Gv, cv, nullptr);
                S.SA = (const float*)(args.ws + WS_SA); S.SW = (const float*)(args.ws + WS_SW) + 2 * D_FF + (size_t)l * D_IN; S.cols = 0; S.st = (LAS float*)(P.lds + pg8::RS_OFF); S.tid = P.tid;
                pg8::EpiOut<true> E{nullptr, nullptr, PROJ, D_IN, 1, S.SA, S.SW, nullptr, S.st};
                pg8::gemm_phase<pg8::EpiOut<true>, pg8::ScaleOrder, true, true, 2>(P.lds, P.tid, g, S, E);
            }
            SEAM(pb + 1);
        }
        if (IN(pb + 2)) REPEAT(REP_MIX) {
            const Ctx P = fresh(F);
            for (int u = blockIdx.x; u < 128; u += F.G) REPEAT(REP_RET) { const int bh = u & 63, th = u >> 6; ret_unit(P, l, bh >> 3, bh & 7, th ? 9 : 0, th ? 16 : 9, args.in); }
            { int u0 = (int)blockIdx.x - 128; if (u0 < 0) u0 += F.G; for (int u = u0; u < 128; u += F.G) REPEAT(REP_LRU) { const int bn = u & 63; lru_unit(P, l, bn >> 3, bn & 7, u >> 6, args.in); } }
            SEAM(pb + 2);
        }
        if (IN(pb + 4)) {
            const Ctx P = fresh(F);
            pg8::Gemm g{Hb, (const bf16*)(args.ws + WS_WOUT) + (size_t)l * D * D, 2 * D}; pg8::RowScaleOrder S; S.init(T / 256, D / 256, F.G, (int)blockIdx.x, nullptr);
            S.ssp = (const float*)(args.ws + WS_SSP); S.rs = (LAS float*)(P.lds + pg8::RS_OFF); S.tid = P.tid;
            pg8::EpiOut<false> E{l == 0 ? (const void*)inp(0) : (const void*)XR, XR, nullptr, D, l == 0 ? 0 : 2, nullptr, nullptr};
            pg8::gemm_phase<pg8::EpiOut<false>, pg8::RowScaleOrder, true, true, 0, true>(P.lds, P.tid, g, S, E);
            SEAM(pb + 4);
        }
        if (IN(pb + 5)) REPEAT(REP_NORM) {
            const Ctx P = fresh(F);
            if (l == 0) { norm_phase<false, true, true>(P, XR, inp(13) + (size_t)l * D, Hb, nullptr); }
            else norm_phase<true, false, true>(P, XR, inp(13) + (size_t)l * D, Hb, inp(17));
            SEAM(pb + 5);
        }
        if (IN(pb + 6) && l == 1) REPEAT(REP_GATHER) { const Ctx P = fresh(F); moe_tables(P); slot_tables(P); SEAM(pb + 6); }
        if (IN(pb + 7)) REPEAT(REP_GGU) {
            const Ctx P = fresh(F);
            if (l == 0) {
                pg8::Gemm g{Hb, args.ws + WS_WGU_D, D}; pg8::ScaleOrder S; S.init(T / 256, 2 * D_FF / 256, F.G, (int)blockIdx.x, nullptr);
                S.SA = (const float*)(args.ws + WS_SA); S.SW = (const float*)(args.ws + WS_SW); S.cols = D_FF; S.st = (LAS float*)(P.lds + pg8::RS_OFF); S.tid = P.tid;
                pg8::EpiSwiglu<true, true> E{HID, D_FF, S.SA, S.SW, S.st};
                pg8::gemm_phase<pg8::EpiSwiglu<true, true>, pg8::ScaleOrder, true, true, 2>(P.lds, P.tid, g, S, E);
            } else {
                if (!MK_ONE_LAUNCH || lo > pb + 6) moe_tables(P);
                pg8::Gemm g{Hb, args.ws + WS_WGU_M, D, (const unsigned*)(args.ws + WS_ROUTE + RT_ROWOF)};
                pg8::GroupOrder S; S.init((int)P.lctl[LC_NMT], 2 * D_FF / 256, F.G, (int)blockIdx.x, (const LAS int*)(P.lctl + LC_TEXP));
                pg8::EpiSwiglu<true> E{HID, D_FF, nullptr, nullptr};
                pg8::gemm_phase<pg8::EpiSwiglu<true>, pg8::GroupOrder, true, true, 1, false, false, true>(P.lds, P.tid, g, S, E);
            }
            SEAM(pb + 7);
        }
        if (IN(pb + 8)) {
            const Ctx P = fresh(F);
            if (l == 0) {
                pg8::Gemm g{HID, args.ws + WS_WDN_D, D_FF}; pg8::GroupOrder S; S.init(T / 256, D / 256, F.G, (int)blockIdx.x, nullptr);
                pg8::EpiOut<false> E{XR, XR, nullptr, D, 2, nullptr, nullptr};
                pg8::gemm_phase<pg8::EpiOut<false>, pg8::GroupOrder, true, true, 1>(P.lds, P.tid, g, S, E);
            } else {
                if (!MK_ONE_LAUNCH || lo > pb + 6) moe_tables(P);
                static_assert((D_FF / 128 / 2) % 2 == 0, "half of K is a whole number of K-tile pairs");
                pg8::Gemm g{HID, args.ws + WS_WDN_M, D_FF}; pg8::SplitOrder S; S.init((int)P.lctl[LC_NMT], D / 256, F.G, (int)blockIdx.x, (const LAS int*)(P.lctl + LC_TEXP)); S.init2();
                pg8::EpiOut<false, true> E{nullptr, nullptr, PROJ, D, 1, nullptr, nullptr, (bf16*)(args.ws + WS_H)};
                pg8::gemm_phase<pg8::EpiOut<false, true>, pg8::SplitOrder, true, true, 1, false, true>(P.lds, P.tid, g, S, E);
            }
            SEAM(pb + 8);
        }
    }
    if (IN(19)) { const Ctx P = fresh(F); if (!MK_ONE_LAUNCH || lo > 16) moe_tables(P); final_phase(P, inp(21)); }
#undef IN
#undef SEAM
}

extern "C" void kernel_launch(void* const* d_in, const int* in_sizes, int n_in, void* d_out, int out_size, void* d_ws, size_t ws_size, hipStream_t stream) {
    static int grid = 0;
    if (grid == 0) {
        if (n_in != 22 || in_sizes[0] != T * D || out_size != T * D || ws_size < WS_END) { fprintf(stderr, "kernel_launch: unexpected shapes (n_in %d, in0 %d, out %d, ws %zu < %zu); nothing launched\n", n_in, n_in > 0 ? in_sizes[0] : -1, out_size, ws_size, (size_t)WS_END); grid = -1; return; }
        int dev = 0, cus = 0, per_cu = 0;
        if (hipGetDevice(&dev) != hipSuccess || hipDeviceGetAttribute(&cus, hipDeviceAttributeMultiprocessorCount, dev) != hipSuccess) { grid = -1; return; }
        if (hipFuncSetAttribute((const void*)fwd, hipFuncAttributeMaxDynamicSharedMemorySize, LDS_BYTES) != hipSuccess) { fprintf(stderr, "kernel_launch: hipFuncSetAttribute failed\n"); grid = -1; return; }
        if (hipOccupancyMaxActiveBlocksPerMultiprocessor(&per_cu, (const void*)fwd, 512, LDS_BYTES) != hipSuccess || per_cu < 1) fprintf(stderr, "kernel_launch: occupancy query reports %d\n", per_cu);
        (void)hipGetLastError();
        grid = cus < 256 ? cus : 256;
    }
    if (grid < 0) return;
    if (hipMemsetAsync((char*)d_ws + WS_CTL, 0, CTL_ZERO_BYTES, stream) != hipSuccess) return;
    Args a{};
    for (int i = 0; i < 22; ++i) a.in[i] = (const float*)d_in[i];
    a.out = (float*)d_out; a.ws = (unsigned char*)d_ws; a.pad = 0;
#if MK_ONE_LAUNCH
    a.ph_lo = 0; a.ph_hi = NPHASE; a.li = 0;
    hipLaunchKernelGGL(fwd, dim3(grid), dim3(512), LDS_BYTES, stream, a);
#else
    int li = 0;
    for (int p = 0; p < NPHASE; ++p) {
        if (p == 1 || p == 1 + 6 || p == 4 || p == 13) continue;
        a.ph_lo = p; a.ph_hi = p + 1; a.li = li++;
        hipLaunchKernelGGL(fwd, dim3(grid), dim3(512), LDS_BYTES, stream, a);
    }
#endif
}
```

```cpp
#include <hip/hip_runtime.h>
#include <cstdio>
#include <cstdint>

#ifndef MK_ONE_LAUNCH
#define MK_ONE_LAUNCH 1
#endif

#ifndef REP_P0
#define REP_P0 1
#endif
#ifndef REP_NORM
#define REP_NORM 1
#endif
#ifndef REP_GIN
#define REP_GIN 1
#endif
#ifndef REP_MIX
#define REP_MIX 1
#endif
#ifndef REP_YLRU
#define REP_YLRU 1
#endif
#ifndef REP_GATHER
#define REP_GATHER 1
#endif
#ifndef REP_GGU
#define REP_GGU 1
#endif
#ifndef REP_RET
#define REP_RET 1
#endif
#ifndef REP_LRU
#define REP_LRU 1
#endif
#define REPEAT(n) for (int rep_ = 0; rep_ < (n); ++rep_)
#ifndef GIN0_NC
#define GIN0_NC 20
#endif
#define LAS __attribute__((address_space(3)))
#define GAS __attribute__((address_space(1)))
typedef unsigned short bf16;
typedef short bf16x8 __attribute__((ext_vector_type(8)));
typedef float f32x4 __attribute__((ext_vector_type(4)));
typedef float f32x2 __attribute__((ext_vector_type(2)));
typedef unsigned u32x4 __attribute__((ext_vector_type(4)));
typedef unsigned u32x2 __attribute__((ext_vector_type(2)));

constexpr int BATCH = 8, SEQ = 2048, T = BATCH * SEQ, D = 2048, D_IN = 5120, D_RNN = 1024, NH = 8, DK = 64, DV = 128, D_FF = 5632, NE = 8;
constexpr int OFF_GATE = 1024, OFF_Q = 2048, OFF_K = 2560, OFF_V = 3072, OFF_G = 4096;
constexpr float EPS = 1e-6f;
constexpr int MAXMT = 136;
constexpr int MPAD = MAXMT * 256;

constexpr size_t MiB = 1u << 20;
constexpr size_t WS_CTL = 0, CTL_ZERO_BYTES = 1 * MiB;
constexpr size_t WS_ROPE = 1 * MiB;
constexpr size_t WS_WLRU = 2 * MiB;
constexpr size_t WS_SSP = 3 * MiB;
constexpr size_t WS_ROUTE = 4 * MiB;
constexpr size_t RT_TOPE = 0, RT_TOPG = 65536, RT_TOPR = 65536 * 3, RT_SLOT = 65536 * 5, RT_CNTB = 65536 * 7, RT_ROWOF = 65536 * 8;
constexpr size_t WS_SA = 5 * MiB;
constexpr size_t WS_SW = 6 * MiB;
constexpr size_t WS_WIN = 8 * MiB;
constexpr size_t WS_WOUT = 48 * MiB;
constexpr size_t WS_WGU_D = 64 * MiB;
constexpr size_t WS_WDN_D = 108 * MiB;
constexpr size_t WS_WGU_M = 130 * MiB;
constexpr size_t WS_WDN_M = 482 * MiB;
constexpr size_t WS_XR = 400 * MiB;
constexpr size_t WS_H = 658 * MiB;
constexpr size_t WS_PROJ = 722 * MiB;
constexpr size_t WS_HID = 882 * MiB;
constexpr size_t WS_END = 1256 * MiB;
static_assert(WS_WIN + (size_t)2 * D_IN * D * 2 <= WS_WOUT && WS_WOUT + (size_t)2 * D * D * 2 <= WS_WGU_D && WS_WGU_D + (size_t)2 * D_FF * D * 2 <= WS_WDN_D &&
              WS_WDN_D + (size_t)D * D_FF * 2 <= WS_WGU_M && WS_WGU_M + (size_t)NE * 2 * D_FF * D * 2 <= WS_WDN_M && WS_WDN_M + (size_t)NE * D * D_FF * 2 <= WS_H &&
              WS_H + (size_t)T * D * 2 <= WS_PROJ && WS_PROJ + (size_t)T * D_IN * 2 <= WS_HID && WS_PROJ + (size_t)MPAD * D * 2 <= WS_HID && WS_HID + (size_t)MPAD * D_FF * 2 <= WS_END, "d_ws map");
static_assert(WS_WGU_M + (size_t)NE * 2 * D_FF * D <= WS_XR && WS_XR + (size_t)T * D * 2 <= WS_WDN_M, "residual stream inside the free half of the expert gate/up region");
constexpr int CW_TMO = 0;
constexpr int CW_BAR = 4096;

constexpr int RING_BYTES = 131072;
constexpr int LDSCTL_OFF = 140 * 1024;
constexpr int LDS_BYTES = 147456;
constexpr int LC_BAR = 0, LC_TB = 16, LC_PRE = 32, LC_TOT = 40, LC_NMT = 48, LC_TEXP = 64, LC_SPLIT = 256;

#define RLX_AGENT __ATOMIC_RELAXED, __HIP_MEMORY_SCOPE_AGENT
__device__ __forceinline__ unsigned f2bf(float f) { unsigned u = __builtin_bit_cast(unsigned, f); return (u + 0x7fffu + ((u >> 16) & 1u)) >> 16; }
__device__ __forceinline__ unsigned pk2(float lo, float hi) { return f2bf(lo) | (f2bf(hi) << 16); }
__device__ __forceinline__ float bflo(unsigned w) { return __builtin_bit_cast(float, w << 16); }
__device__ __forceinline__ float bfhi(unsigned w) { return __builtin_bit_cast(float, w & 0xffff0000u); }
__device__ __forceinline__ float shfl_idx(float v, int src) { return __builtin_bit_cast(float, __builtin_amdgcn_ds_bpermute(src << 2, __builtin_bit_cast(int, v))); }
__device__ __forceinline__ float shfl_x(float v, int o, int lane) { return shfl_idx(v, lane ^ o); }
__device__ __forceinline__ unsigned shfl_u(unsigned v, int src) { return (unsigned)__builtin_amdgcn_ds_bpermute(src << 2, (int)v); }
__device__ __forceinline__ float wave_sum(float v, int lane) {
#pragma unroll
    for (int o = 1; o < 64; o <<= 1) v += shfl_x(v, o, lane);
    return v;
}
__device__ __forceinline__ float sigmoidf_(float x) { return __builtin_amdgcn_rcpf(1.0f + __expf(-x)); }
__device__ __forceinline__ int tile_off(int r, int c, int kc32) { const int ob = (r & 15) * 64 + (c & 31) * 2; return ((r >> 4) * kc32 + (c >> 5)) * 1024 + (ob ^ (((ob >> 9) & 1) << 5)); }
__device__ __forceinline__ bf16x8 lds_frag(LAS unsigned char* base, int off) { return *(const LAS bf16x8*)(base + off); }
#define MFMA16(a, b, c) __builtin_amdgcn_mfma_f32_16x16x32_bf16((a), (b), (c), 0, 0, 0)

namespace pg8 {
constexpr int BM = 256, BK = 64, HALF = 128, HTB = HALF * BK * 2, STAGE_BYTES = 8 * HTB, NXCD = 8, WGM = 8;
__host__ __device__ __forceinline__ int lds_byte(int r, int c) { const int st = (r >> 4) * 2 + (c >> 5), rr = r & 15, cc = c & 31, ob = rr * 64 + cc * 2; return st * 1024 + (ob ^ (((ob >> 9) & 1) << 5)); }
__host__ __device__ __forceinline__ void stage_rc(int b, int& R, int& C) { const int st = b / 1024, sb = b % 1024, swz = sb ^ (((sb >> 9) & 1) << 5); R = (st >> 1) * 16 + swz / 64; C = (st & 1) * 32 + (swz % 64) / 2; }
__host__ __device__ __forceinline__ int perm32(int rho) { const int n = rho >> 4, i = rho & 15; return 8 * (i >> 2) + 4 * n + (i & 3); }

struct Unit { int pm, pn, pb, kh; };
struct Gemm { const void* A; const void* Bt; int Kb; const unsigned* arow; };

struct GroupOrder {
    int nM, nN, nwg, G, c; const LAS int* texp;
    __device__ void init(int nM_, int nN_, int G_, int c_, const LAS int* texp_) { nM = nM_; nN = nN_; nwg = nM * nN; G = G_; c = c_; texp = texp_; }
    __device__ bool next(int i, Unit& u) const { return unit_at((long)i * G + c, u); }
    __device__ bool unit_at(long L, Unit& u) const {
        if (L >= nwg) return false;
        int wgid = (int)L; { const int q = nwg / NXCD, r = nwg % NXCD, xcd = wgid % NXCD, off = wgid / NXCD; wgid = (xcd < r ? xcd * (q + 1) : r * (q + 1) + (xcd - r) * q) + off; }
        const int nig = WGM * nN, gid = wgid / nig, fm = gid * WGM, gsz = (nM - fm) < WGM ? (nM - fm) : WGM;
        u.pm = fm + ((wgid % nig) % gsz); u.pn = (wgid % nig) / gsz;
        u.pb = (texp ? __builtin_amdgcn_readfirstlane(texp[u.pm]) : 0) * nN + u.pn; return true;
    }
    struct Pre {};
    __device__ __forceinline__ void a_issue(const Unit&, Pre&) const {}
    __device__ __forceinline__ void a_finish(const Unit&, int, const Pre&) const {}
    __device__ __forceinline__ void done(const Unit&) const {}
};
struct SplitOrder : GroupOrder {
    int R, rem;
    __device__ void init2() { R = nwg / G; rem = nwg - R * G; if (2 * rem > G) rem = 0; }
    __device__ bool next(int i, Unit& u) const {
        if (rem == 0 || i < R) { const bool ok = GroupOrder::next(i, u); u.kh = 0; return ok; }
        if (i > R || c >= 2 * rem) return false;
        const bool ok = unit_at((long)R * G + (c >> 1), u); u.kh = ((c >> 1) << 2) | (1 + (c & 1)); return ok;
    }
};
constexpr int RS_OFF = 131072;
struct RowScaleOrder : GroupOrder {
    const float* ssp; LAS float* rs; int tid;
    struct Pre { f32x4 a, b; };
    __device__ __forceinline__ void a_issue(const Unit& u, Pre& p) const {
        const int r = tid & 255, h = tid >> 8; const f32x4* q = (const f32x4*)(ssp + (size_t)(u.pm * BM + r) * 16 + h * 8);
        p.a = q[0]; p.b = q[1];
    }
    __device__ __forceinline__ void a_finish(const Unit&, int par, const Pre& p) const {
        const int r = tid & 255, h = tid >> 8; const f32x4 t4 = p.a + p.b;
        rs[(par * 2 + h) * 256 + r] = (t4[0] + t4[1]) + (t4[2] + t4[3]);
    }
};
struct ScaleOrder : GroupOrder {
    const float* SA; const float* SW; int cols; LAS float* st; int tid;
    struct Pre { float v; };
    __device__ bool next(int i, Unit& u) const { const bool ok = GroupOrder::next(i, u); u.kh = i & 1; return ok; }
    __device__ __forceinline__ void a_issue(const Unit& u, Pre& p) const {
        const int t = tid;
        p.v = t < 256 ? SA[u.pm * BM + t] : (cols == 0 ? SW[u.pn * BM + t - 256] : (t < 384 ? SW[u.pn * HALF + t - 256] : SW[cols + u.pn * HALF + t - 384]));
    }
    __device__ __forceinline__ void a_finish(const Unit&, int par, const Pre& p) const { st[par * 512 + tid] = p.v; }
};
__device__ __forceinline__ float rs_scale(const LAS float* rs, int par, int r, float inv) { return 1.0f / sqrtf((rs[(par * 2) * 256 + r] + rs[(par * 2 + 1) * 256 + r]) * inv + EPS); }

__device__ __forceinline__ unsigned cvt_pk_bf16(float lo, float hi) { unsigned r; asm volatile("v_cvt_pk_bf16_f32 %0, %1, %2" : "=v"(r) : "v"(lo), "v"(hi)); return r; }

__device__ __forceinline__ float clamp448(float x) { return __builtin_amdgcn_fmed3f(x, -448.0f, 448.0f); }
__device__ __forceinline__ unsigned pk4_fp8(float a, float b, float c, float d) { unsigned w = 0; w = __builtin_amdgcn_cvt_pk_fp8_f32(clamp448(a), clamp448(b), w, false); w = __builtin_amdgcn_cvt_pk_fp8_f32(clamp448(c), clamp448(d), w, true); return w; }
template <bool INI8 = false, bool KS = false> struct EpiOut {
    static constexpr bool PERM = true;
    const void* base; bf16* C; bf16* O; int ldc; int mode; const float* SA; const float* SW;
    bf16* O2;
    const LAS float* st;
    __device__ __forceinline__ void operator()(const f32x4 (&acc)[2][2][4][2], const Unit& u, int wr, int wc, int fr, int fq) const {
        int row0 = u.pm * BM + wr * 64 + fr, col0 = u.pn * BM + wc * 32 + 8 * fq;
        if (mode == 1) {
            bf16* O = this->O; int ldc = this->ldc;
            if constexpr (KS) { if ((u.kh & 3) == 2) { O = (bf16*)((unsigned char*)O2 + (size_t)(u.kh >> 2) * (BM * BM)); ldc = BM; row0 = wr * 64 + fr; col0 = wc * 32 + 8 * fq; } }
            float sw[2][8];
            if constexpr (INI8) {
#pragma unroll
                for (int bj = 0; bj < 2; ++bj)
#pragma unroll
                    for (int j = 0; j < 8; ++j) sw[bj][j] = st ? st[512 * u.kh + 256 + wc * 32 + 8 * fq + bj * HALF + j] : SW[col0 + bj * HALF + j]; }
#pragma unroll
            for (int ai = 0; ai < 2; ++ai)
#pragma unroll
                for (int m = 0; m < 4; ++m) {
                    const size_t off = (size_t)(row0 + ai * HALF + m * 16) * ldc + col0;
                    float sa = 1.0f; if constexpr (INI8) sa = st ? st[512 * u.kh + wr * 64 + fr + ai * HALF + m * 16] : SA[row0 + ai * HALF + m * 16];
#pragma unroll
                    for (int bj = 0; bj < 2; ++bj) { float f[8];
#pragma unroll
                        for (int j = 0; j < 4; ++j) { const float a0 = acc[ai][bj][m][0][j], a1 = acc[ai][bj][m][1][j];
                            if constexpr (INI8) { f[j] = (float)__builtin_bit_cast(int, a0) * (sa * sw[bj][j]); f[4 + j] = (float)__builtin_bit_cast(int, a1) * (sa * sw[bj][4 + j]); }
                            else { f[j] = a0; f[4 + j] = a1; } }
                        if constexpr (KS) {
                            *(u32x2*)((unsigned char*)O + off + bj * HALF) = (u32x2){pk4_fp8(16.f * f[0], 16.f * f[1], 16.f * f[2], 16.f * f[3]), pk4_fp8(16.f * f[4], 16.f * f[5], 16.f * f[6], 16.f * f[7])}; }
                        else { u32x4 w; w.x = cvt_pk_bf16(f[0], f[1]); w.y = cvt_pk_bf16(f[2], f[3]); w.z = cvt_pk_bf16(f[4], f[5]); w.w = cvt_pk_bf16(f[6], f[7]);
                            *(u32x4*)(O + off + bj * HALF) = w; } }
                }
        } else if (mode == 0) {
            const float* bf = (const float*)base;
#pragma unroll
            for (int ai = 0; ai < 2; ++ai) {
                f32x4 bb[4][2][2];
#pragma unroll
                for (int m = 0; m < 4; ++m) { const size_t off = (size_t)(row0 + ai * HALF + m * 16) * ldc + col0;
#pragma unroll
                    for (int bj = 0; bj < 2; ++bj) { bb[m][bj][0] = *(const f32x4*)(bf + off + bj * HALF); bb[m][bj][1] = *(const f32x4*)(bf + off + bj * HALF + 4); } }
#pragma unroll
                for (int m = 0; m < 4; ++m) { const size_t off = (size_t)(row0 + ai * HALF + m * 16) * ldc + col0;
#pragma unroll
                    for (int bj = 0; bj < 2; ++bj) { const f32x4 lo = bb[m][bj][0] + acc[ai][bj][m][0], hi = bb[m][bj][1] + acc[ai][bj][m][1];
                        u32x4 w; w.x = cvt_pk_bf16(lo[0], lo[1]); w.y = cvt_pk_bf16(lo[2], lo[3]); w.z = cvt_pk_bf16(hi[0], hi[1]); w.w = cvt_pk_bf16(hi[2], hi[3]);
                        *(u32x4*)(C + off + bj * HALF) = w; } }
                asm volatile("" ::: "memory");
            }
        } else {
            const bf16* bb16 = (const bf16*)base;
#pragma unroll
            for (int ai = 0; ai < 2; ++ai) {
                u32x4 bw[4][2];
#pragma unroll
                for (int m = 0; m < 4; ++m) { const size_t off = (size_t)(row0 + ai * HALF + m * 16) * ldc + col0;
#pragma unroll
                    for (int bj = 0; bj < 2; ++bj) bw[m][bj] = *(const u32x4*)(bb16 + off + bj * HALF); }
#pragma unroll
                for (int m = 0; m < 4; ++m) { const size_t off = (size_t)(row0 + ai * HALF + m * 16) * ldc + col0;
#pragma unroll
                    for (int bj = 0; bj < 2; ++bj) { const u32x4 r = bw[m][bj]; const f32x4 a0 = acc[ai][bj][m][0], a1 = acc[ai][bj][m][1];
                        u32x4 w; w.x = cvt_pk_bf16(bflo(r.x) + a0[0], bfhi(r.x) + a0[1]); w.y = cvt_pk_bf16(bflo(r.y) + a0[2], bfhi(r.y) + a0[3]);
                        w.z = cvt_pk_bf16(bflo(r.z) + a1[0], bfhi(r.z) + a1[1]); w.w = cvt_pk_bf16(bflo(r.w) + a1[2], bfhi(r.w) + a1[3]);
                        *(u32x4*)(C + off + bj * HALF) = w; } }
                asm volatile("" ::: "memory");
            }
            {
                asm volatile("" ::: "memory");
            }
        }
    }
};
template <bool OUT8, bool INI8 = false> struct EpiSwiglu {
    static constexpr bool PERM = true;
    void* O; int ldc; const float* SA; const float* SW;
    const LAS float* st;
    __device__ __forceinline__ void operator()(const f32x4 (&acc)[2][2][4][2], const Unit& u, int wr, int wc, int fr, int fq) const {
        const int row0 = u.pm * BM + wr * 64 + fr, col0 = u.pn * HALF + wc * 32 + 8 * fq;
        float swg[8], swu[8];
        if constexpr (INI8) {
#pragma unroll
            for (int j = 0; j < 8; ++j) { swg[j] = st ? st[512 * u.kh + 256 + wc * 32 + 8 * fq + j] : SW[col0 + j]; swu[j] = st ? st[512 * u.kh + 384 + wc * 32 + 8 * fq + j] : SW[ldc + col0 + j]; } }
#pragma unroll
        for (int ai = 0; ai < 2; ++ai)
#pragma unroll
            for (int m = 0; m < 4; ++m) {
                float h[8]; float sa = 1.0f; if constexpr (INI8) sa = st ? st[512 * u.kh + wr * 64 + fr + ai * HALF + m * 16] : SA[row0 + ai * HALF + m * 16];
#pragma unroll
                for (int n = 0; n < 2; ++n)
#pragma unroll
                    for (int j = 0; j < 4; ++j) { float g = acc[ai][0][m][n][j], up = acc[ai][1][m][n][j];
                        if constexpr (INI8) { g = (float)__builtin_bit_cast(int, g) * (sa * swg[4 * n + j]); up = (float)__builtin_bit_cast(int, up) * (sa * swu[4 * n + j]); } h[n * 4 + j] = g * __builtin_amdgcn_rcpf(1.0f + __builtin_amdgcn_exp2f(-1.44269504f * g)) * up; }
                if constexpr (OUT8) { *(u32x2*)((unsigned char*)O + (size_t)(row0 + ai * HALF + m * 16) * ldc + col0) = (u32x2){pk4_fp8(h[0], h[1], h[2], h[3]), pk4_fp8(h[4], h[5], h[6], h[7])}; }
                else { u32x4 w; w.x = cvt_pk_bf16(h[0], h[1]); w.y = cvt_pk_bf16(h[2], h[3]); w.z = cvt_pk_bf16(h[4], h[5]); w.w = cvt_pk_bf16(h[6], h[7]);
                    *(u32x4*)((bf16*)O + (size_t)(row0 + ai * HALF + m * 16) * ldc + col0) = w; }
            }
    }
};

typedef int i32x4 __attribute__((ext_vector_type(4)));
typedef int i32x8 __attribute__((ext_vector_type(8)));
template <class Epi, class Sched, bool ALIGN_EPI, bool SP2, int KIND  , bool MIDK = false, bool KSPLIT = false, bool GA = false>
__device__ __forceinline__ void gemm_phase(LAS unsigned char* lds, const int tid, const Gemm g, const Sched& S, const Epi& E) {
    const int wid = __builtin_amdgcn_readfirstlane(tid >> 6), lane = tid & 63, wr = wid >> 2, wc = wid & 3, fr = lane & 15, fq = lane >> 4;
    const int K = g.Kb, nt = K / 128;
    unsigned voffA[2], voffB[2];
#pragma unroll
    for (int i = 0; i < 2; ++i) { int R, C; stage_rc(tid * 16 + i * 8192, R, C); const int Rb = Epi::PERM ? ((R & ~31) + perm32(R & 31)) : R;
        voffA[i] = (unsigned)(R * K + C * 2); voffB[i] = (unsigned)(Rb * K + C * 2); }
    int rA0 = 0; unsigned colA = 0; { int R, C; stage_rc(tid * 16, R, C); rA0 = R; colA = (unsigned)(C * 2); }
    unsigned gofC[2][2], gofN[2][2], gofX[2][2]; (void)gofC; (void)gofN; (void)gofX; (void)rA0; (void)colA;
    LAS unsigned* atab = (LAS unsigned*)(lds + RS_OFF);
    const size_t kstep = (size_t)(BK * 2);
    const size_t hstep = (size_t)HALF * K;
    const size_t tstep = 2 * hstep;
    const unsigned ldsw = (unsigned)wid * 1024u;
    const int aoff = lds_byte(wr * 64 + fr, fq * 8), boff = lds_byte(wc * 32 + fr, fq * 8);
#define PG8_SA(b, h) (((b) * 2 + (h)) * HTB)
#define PG8_SB(b, h) ((4 + (b) * 2 + (h)) * HTB)
#define PG8_STAGE(bufoff, gbase, voff) do { _Pragma("unroll") for (int _i = 0; _i < 2; ++_i) \
        __builtin_amdgcn_global_load_lds((const unsigned*)((const char*)(gbase) + (voff)[_i]), (LAS unsigned*)(lds + (bufoff) + ldsw + _i * 8192), 16, 0, 0); } while (0)
#define PG8_STAGE_A(b, h, base, offs) do { if constexpr (GA) { PG8_STAGE(PG8_SA(b, h), (base), (offs)[h]); } else { PG8_STAGE(PG8_SA(b, h), (base) + (h) * hstep, voffA); } } while (0)
#define PG8_LDA(dst, b, h) do { _Pragma("unroll") for (int m = 0; m < 4; ++m) _Pragma("unroll") for (int k = 0; k < 2; ++k) dst[m][k] = *(const LAS bf16x8*)(lds + PG8_SA(b, h) + aoff + m * 2048 + k * 1024); } while (0)
#define PG8_LDB(dst, b, h) do { _Pragma("unroll") for (int n = 0; n < 2; ++n) _Pragma("unroll") for (int k = 0; k < 2; ++k) dst[n][k] = *(const LAS bf16x8*)(lds + PG8_SB(b, h) + boff + n * 2048 + k * 1024); } while (0)
#define PG8_CAT(x) __builtin_shufflevector(__builtin_bit_cast(i32x4, (x)[0]), __builtin_bit_cast(i32x4, (x)[1]), 0, 1, 2, 3, 4, 5, 6, 7)
#define PG8_MMA(ai, bj, At, Bt) do { __builtin_amdgcn_s_setprio(1); _Pragma("unroll") for (int m = 0; m < 4; ++m) _Pragma("unroll") for (int n = 0; n < 2; ++n) { \
        if constexpr (KIND == 1) { const i32x8 bw_ = PG8_CAT(Bt[n]), aw_ = PG8_CAT(At[m]); \
            asm volatile("v_mfma_scale_f32_16x16x128_f8f6f4 %0, %1, %2, %0, %3, %4 op_sel_hi:[0,0,0]" : "+v"(acc[ai][bj][m][n]) : "v"(bw_), "v"(aw_), "v"(sc_w), "v"(sc_a)); } \
        else if constexpr (KIND == 2) { _Pragma("unroll") for (int k = 0; k < 2; ++k) acc[ai][bj][m][n] = __builtin_bit_cast(f32x4, __builtin_amdgcn_mfma_i32_16x16x64_i8( \
            __builtin_bit_cast(i32x4, Bt[n][k]), __builtin_bit_cast(i32x4, At[m][k]), __builtin_bit_cast(i32x4, acc[ai][bj][m][n]), 0, 0, 0)); } \
        else { _Pragma("unroll") for (int k = 0; k < 2; ++k) acc[ai][bj][m][n] = __builtin_amdgcn_mfma_f32_16x16x32_bf16(Bt[n][k], At[m][k], acc[ai][bj][m][n], 0, 0, 0); } } \
        __builtin_amdgcn_s_setprio(0); } while (0)
#define PG8_WAIT_V(n) asm volatile("s_waitcnt vmcnt(" #n ")" ::: "memory")
#define PG8_WAIT_L(n) asm volatile("s_waitcnt lgkmcnt(" #n ")" ::: "memory")
#define PG8_BAR __builtin_amdgcn_s_barrier()
#define PG8_SCHED __builtin_amdgcn_sched_barrier(0)
    Unit cur, nxt; int ui = 0;
    if (!S.next(0, cur)) return;
    const int sc_w = 0x79797979, sc_a = 0x7f7f7f7f; (void)sc_w; (void)sc_a;
    f32x4 acc[2][2][4][2];
#pragma unroll
    for (int a = 0; a < 2; ++a)
#pragma unroll
        for (int b = 0; b < 2; ++b)
#pragma unroll
            for (int m = 0; m < 4; ++m)
#pragma unroll
                for (int n = 0; n < 2; ++n) acc[a][b][m][n] = (f32x4){0.f, 0.f, 0.f, 0.f};
    bf16x8 At[4][2], B0[2][2], B1[2][2];
    const char* cA = (const char*)g.A + (GA ? (size_t)0 : (size_t)cur.pm * tstep); const char* cB = (const char*)g.Bt + (size_t)cur.pb * tstep;
    if constexpr (GA) {
        static_assert(SP2 && !KSPLIT && !MIDK, "gathered A: SP2 schedule only");
#pragma unroll
        for (int h = 0; h < 2; ++h)
#pragma unroll
            for (int i = 0; i < 2; ++i) { gofC[h][i] = g.arow[cur.pm * BM + h * HALF + rA0 + 64 * i] * (unsigned)K + colA; gofN[h][i] = gofC[h][i]; }
    }
    if constexpr (KSPLIT) { if ((cur.kh & 3) == 2) { cA += (size_t)(nt / 2) * kstep; cB += (size_t)(nt / 2) * kstep; } }
    { typename Sched::Pre pre0; S.a_issue(cur, pre0); S.a_finish(cur, 0, pre0); }
    if constexpr (SP2) {
        PG8_STAGE(PG8_SB(0, 0), cB, voffB); PG8_STAGE(PG8_SB(0, 1), cB + hstep, voffB); PG8_STAGE_A(0, 0, cA, gofC); PG8_STAGE_A(0, 1, cA, gofC);
        if (wr == 1) PG8_BAR;
        PG8_WAIT_V(2); PG8_BAR;
        PG8_STAGE(PG8_SB(1, 0), cB + kstep, voffB); PG8_STAGE_A(1, 0, cA + kstep, gofC); PG8_STAGE(PG8_SB(1, 1), cB + hstep + kstep, voffB);
        PG8_WAIT_V(6); PG8_BAR;
    } else {
        PG8_STAGE(PG8_SB(0, 0), cB, voffB); PG8_STAGE(PG8_SA(0, 0), cA, voffA); PG8_STAGE(PG8_SB(0, 1), cB + hstep, voffB); PG8_STAGE(PG8_SA(0, 1), cA + hstep, voffA);
        if (wr == 1) PG8_BAR;
        PG8_WAIT_V(4); PG8_BAR;
        PG8_STAGE(PG8_SB(1, 0), cB + kstep, voffB); PG8_STAGE(PG8_SA(1, 0), cA + kstep, voffA); PG8_STAGE(PG8_SB(1, 1), cB + hstep + kstep, voffB);
        PG8_WAIT_V(6); PG8_BAR;
    }
    for (;;) {
        const bool has_next = S.next(ui + 1, nxt);
        const char* nA = (has_next && !GA) ? (const char*)g.A + (size_t)nxt.pm * tstep : cA; const char* nB = has_next ? (const char*)g.Bt + (size_t)nxt.pb * tstep : cB;
        if constexpr (GA) { if (has_next && wid == 0)
            __builtin_amdgcn_global_load_lds(g.arow + (size_t)nxt.pm * BM + lane * 4, atab + ((ui + 1) & 1) * BM, 16, 0, 0); }
        int unt = nt;
        if constexpr (KSPLIT) { if (has_next && (nxt.kh & 3) == 2) { nA += (size_t)(nt / 2) * kstep; nB += (size_t)(nt / 2) * kstep; } if (cur.kh & 3) unt = nt / 2; }
        for (int t = 0; t < unt; t += 2) {
            const bool last = (t == unt - 2);
            const char* a1 = cA + (size_t)(t + 1) * kstep;
            const char* a2 = last ? nA : cA + (size_t)(t + 2) * kstep; const char* b2 = last ? nB : cB + (size_t)(t + 2) * kstep;
            const char* a3 = a2 + kstep; const char* b3 = b2 + kstep;
            if constexpr (GA) {
                if (t == 2 && has_next) {
#pragma unroll
                    for (int h = 0; h < 2; ++h)
#pragma unroll
                        for (int i = 0; i < 2; ++i) gofN[h][i] = atab[((ui + 1) & 1) * BM + h * HALF + rA0 + 64 * i] * (unsigned)K + colA; }
#pragma unroll
                for (int h = 0; h < 2; ++h)
#pragma unroll
                    for (int i = 0; i < 2; ++i) gofX[h][i] = last ? gofN[h][i] : gofC[h][i];
            }
            if constexpr (MIDK) { if (t == nt / 2) {
                const LAS float* rs = (const LAS float*)(lds + RS_OFF);
#pragma unroll
                for (int ai = 0; ai < 2; ++ai)
#pragma unroll
                    for (int m = 0; m < 4; ++m) { const float sc = rs_scale(rs, ui & 1, ai * HALF + wr * 64 + m * 16 + fr, 1.0f / D_RNN);
#pragma unroll
                        for (int bj = 0; bj < 2; ++bj)
#pragma unroll
                            for (int n = 0; n < 2; ++n) acc[ai][bj][m][n] = acc[ai][bj][m][n] * sc; } } }
            if constexpr (SP2) {
            PG8_LDB(B0, 0, 0); PG8_LDB(B1, 0, 1); PG8_SCHED; PG8_LDA(At, 0, 0); PG8_STAGE_A(1, 1, a1, gofC);
            PG8_WAIT_V(8); PG8_WAIT_L(0); PG8_BAR; PG8_MMA(0, 0, At, B0); PG8_MMA(0, 1, At, B1); PG8_BAR; PG8_SCHED;
            PG8_LDA(At, 0, 1); PG8_STAGE(PG8_SB(0, 0), b2, voffB); PG8_STAGE(PG8_SB(0, 1), b2 + hstep, voffB); PG8_STAGE_A(0, 0, a2, gofX);
            PG8_WAIT_V(8); PG8_WAIT_L(0); PG8_BAR; PG8_MMA(1, 0, At, B0); PG8_MMA(1, 1, At, B1); PG8_BAR; PG8_SCHED;
            PG8_LDB(B0, 1, 0); PG8_LDB(B1, 1, 1); PG8_SCHED; PG8_LDA(At, 1, 0); PG8_STAGE_A(0, 1, a2, gofX);
            PG8_WAIT_V(8); PG8_WAIT_L(0); PG8_BAR; PG8_MMA(0, 0, At, B0); PG8_MMA(0, 1, At, B1); PG8_BAR; PG8_SCHED;
            PG8_LDA(At, 1, 1); PG8_STAGE(PG8_SB(1, 0), b3, voffB); PG8_STAGE(PG8_SB(1, 1), b3 + hstep, voffB); PG8_STAGE_A(1, 0, a3, gofX);
            PG8_WAIT_V(8); PG8_WAIT_L(0); PG8_BAR; PG8_MMA(1, 0, At, B0); PG8_MMA(1, 1, At, B1); PG8_BAR; PG8_SCHED;
            } else {
            PG8_LDB(B0, 0, 0); PG8_SCHED; PG8_LDA(At, 0, 0); PG8_STAGE(PG8_SA(1, 1), a1 + hstep, voffA);
            PG8_WAIT_L(8); PG8_BAR; PG8_WAIT_L(0); PG8_MMA(0, 0, At, B0); PG8_BAR; PG8_SCHED;
            PG8_LDB(B1, 0, 1); PG8_STAGE(PG8_SB(0, 0), b2, voffB);
            PG8_BAR; PG8_WAIT_L(0); PG8_MMA(0, 1, At, B1); PG8_BAR;
            PG8_LDA(At, 0, 1); PG8_STAGE(PG8_SA(0, 0), a2, voffA);
            PG8_BAR; PG8_WAIT_L(0); PG8_MMA(1, 0, At, B0); PG8_BAR; PG8_SCHED;
            PG8_STAGE(PG8_SB(0, 1), b2 + hstep, voffB);
            PG8_WAIT_V(6); PG8_BAR; PG8_MMA(1, 1, At, B1); PG8_BAR;
            PG8_LDB(B0, 1, 0); PG8_SCHED; PG8_LDA(At, 1, 0); PG8_STAGE(PG8_SA(0, 1), a2 + hstep, voffA);
            PG8_WAIT_L(8); PG8_BAR; PG8_WAIT_L(0); PG8_MMA(0, 0, At, B0); PG8_BAR; PG8_SCHED;
            PG8_LDB(B1, 1, 1); PG8_STAGE(PG8_SB(1, 0), b3, voffB);
            PG8_BAR; PG8_WAIT_L(0); PG8_MMA(0, 1, At, B1); PG8_BAR;
            PG8_LDA(At, 1, 1); PG8_STAGE(PG8_SA(1, 0), a3, voffA);
            PG8_BAR; PG8_WAIT_L(0); PG8_MMA(1, 0, At, B0); PG8_BAR; PG8_SCHED;
            PG8_STAGE(PG8_SB(1, 1), b3 + hstep, voffB);
            PG8_WAIT_V(6); PG8_BAR; PG8_MMA(1, 1, At, B1); PG8_BAR;
            }
        }
        if constexpr (ALIGN_EPI) { if (wr == 0) PG8_BAR; }
        if constexpr (KIND == 1) asm volatile("s_nop 15\n\ts_nop 15" ::: "memory");
        typename Sched::Pre pre; if (has_next) S.a_issue(nxt, pre);
        E(acc, cur, wr, wc, fr, fq); S.done(cur);
        if (has_next) S.a_finish(nxt, (ui + 1) & 1, pre);
        if (!has_next) break;
#pragma unroll
        for (int a = 0; a < 2; ++a)
#pragma unroll
            for (int b = 0; b < 2; ++b)
#pragma unroll
                for (int m = 0; m < 4; ++m)
#pragma unroll
                    for (int n = 0; n < 2; ++n) acc[a][b][m][n] = (f32x4){0.f, 0.f, 0.f, 0.f};
        cur = nxt; cA = nA; cB = nB; ++ui;
        if constexpr (GA) {
#pragma unroll
            for (int h = 0; h < 2; ++h)
#pragma unroll
                for (int i = 0; i < 2; ++i) gofC[h][i] = gofN[h][i]; }
        if constexpr (ALIGN_EPI) { if (wr == 1) PG8_BAR; }
    }
    PG8_WAIT_V(0);
    if constexpr (!ALIGN_EPI) { if (wr == 0) PG8_BAR; }
    PG8_BAR;
#undef PG8_SA
#undef PG8_SB
#undef PG8_STAGE
#undef PG8_LDA
#undef PG8_STAGE_A
#undef PG8_LDB
#undef PG8_MMA
#undef PG8_CAT
#undef PG8_WAIT_V
#undef PG8_WAIT_L
#undef PG8_BAR
#undef PG8_SCHED
}
}

#define XB_TMO      128
#define XB_XCNT(j)  (256  + 64 * (j))
#define XB_XSUB(j)  (1280 + 64 * (j))
#define XB_XGEN(j)  (2304 + 64 * (j))
#define XB_TOP      3328
#define XB_TOPGEN   3392
#define XCD_BAR_WORDS 3456
#define XB_SPIN_CAP (1u << 18)
__device__ __forceinline__ unsigned xb_ld(unsigned* p)              { return __hip_atomic_load(p, __ATOMIC_RELAXED, __HIP_MEMORY_SCOPE_AGENT); }
__device__ __forceinline__ unsigned xb_add(unsigned* p, unsigned v) { return __hip_atomic_fetch_add(p, v, __ATOMIC_RELAXED, __HIP_MEMORY_SCOPE_AGENT); }
__device__ __forceinline__ unsigned xb_xcc_id() { return (unsigned)__builtin_amdgcn_s_getreg((3 << 11) | 20) & 0xFu; }
#define XB_SPIN(cond, bar) do { unsigned _sp = 0; while (cond) { __builtin_amdgcn_s_sleep(1); \
    if ((++_sp & 255u) == 0u) { if (xb_ld(&(bar)[XB_TMO])) break; if (_sp > XB_SPIN_CAP) { atomicAdd(&(bar)[XB_TMO], 1u); break; } } } } while (0)
struct XcdBarrier { unsigned* bar; unsigned x; volatile LAS unsigned* st; };
__device__ __forceinline__ XcdBarrier xcd_barrier_post(unsigned* bar, volatile LAS unsigned* st) {
    XcdBarrier b; b.bar = bar; b.x = xb_xcc_id(); b.st = st;
    if (threadIdx.x == 0) (void)xb_add(&bar[XB_XCNT(b.x)], 1u);
    return b;
}
__device__ __forceinline__ void xcd_barrier_complete(unsigned* bar, unsigned x, unsigned& nloc, unsigned& nx) {
    const unsigned G = gridDim.x * gridDim.y * gridDim.z;
    unsigned sum, cnt, mine, sp = 0u;
    for (;;) {
        sum = 0u; cnt = 0u; mine = 0u;
#pragma unroll
        for (unsigned j = 0; j < 16; ++j) { const unsigned c = xb_ld(&bar[XB_XCNT(j)]); sum += c; cnt += (c > 0u) ? 1u : 0u; mine = (j == x) ? c : mine; }
        if (sum == G) break;
        __builtin_amdgcn_s_sleep(1);
        if ((++sp & 255u) == 0u) { if (xb_ld(&bar[XB_TMO])) break; if (sp > XB_SPIN_CAP) { atomicAdd(&bar[XB_TMO], 1u); break; } }
    }
    nloc = mine > 0u ? mine : 1u; nx = cnt > 0u ? cnt : 1u;
}
__device__ __forceinline__ void xcd_barrier(const XcdBarrier& b) {
    asm volatile("s_waitcnt vmcnt(0)" ::: "memory");
    __syncthreads();
    if (threadIdx.x == 0) {
        unsigned* bar = b.bar;
        __builtin_amdgcn_s_waitcnt(0);
        unsigned nloc = b.st[0], nx = b.st[1];
        if (nloc == 0u) { xcd_barrier_complete(bar, b.x, nloc, nx); b.st[0] = nloc; b.st[1] = nx; }
        const unsigned old = xb_add(&bar[XB_XSUB(b.x)], 1u);
        const unsigned gen = old / nloc;
        if (old + 1u == (gen + 1u) * nloc) {
            __builtin_amdgcn_fence(__ATOMIC_RELEASE, "agent");
            asm volatile("s_waitcnt vmcnt(0)" ::: "memory");
            const unsigned og = xb_add(&bar[XB_TOP], 1u);
            const unsigned tg = og / nx;
            if (og + 1u == (tg + 1u) * nx) xb_add(&bar[XB_TOPGEN], 1u);
            else XB_SPIN(xb_ld(&bar[XB_TOPGEN]) == tg, bar);
            __builtin_amdgcn_fence(__ATOMIC_ACQUIRE, "agent");
            xb_add(&bar[XB_XGEN(b.x)], 1u);
            asm volatile("s_waitcnt vmcnt(0)" ::: "memory");
        } else {
            XB_SPIN(xb_ld(&bar[XB_XGEN(b.x)]) == gen, bar);
            __builtin_amdgcn_fence(__ATOMIC_ACQUIRE, "agent");
            asm volatile("s_waitcnt vmcnt(0)" ::: "memory");
        }
    }
    __syncthreads();
}

__device__ __forceinline__ void p0_transpose_item(const float* W, int K, int N, bf16* WT, int kb, int nb, int drow0, LAS float* scr, int lane) {
    const int k0 = 64 * kb, n0 = 32 * nb;
#pragma unroll 8
    for (int i = 0; i < 32; ++i) { const int kk = 2 * i + (lane >> 5); scr[kk * 33 + (lane & 31)] = W[(size_t)(k0 + kk) * N + n0 + (lane & 31)]; }
    asm volatile("s_waitcnt lgkmcnt(0)" ::: "memory");
    const int c = lane & 7;
#pragma unroll
    for (int j = 0; j < 4; ++j) { const int n = (lane >> 3) + 8 * j; const LAS float* s = scr + (8 * c) * 33 + n;
        u32x4 o; o.x = pk2(s[0 * 33], s[1 * 33]); o.y = pk2(s[2 * 33], s[3 * 33]); o.z = pk2(s[4 * 33], s[5 * 33]); o.w = pk2(s[6 * 33], s[7 * 33]);
        *(u32x4*)(WT + (size_t)(drow0 + n) * K + k0 + 8 * c) = o; }
    asm volatile("s_waitcnt lgkmcnt(0)" ::: "memory");
}

__device__ __forceinline__ void p0_transpose_item_fp8(const float* W, int K, int N, unsigned char* WT, int kb, int nb, int drow0, LAS float* scr, int lane) {
    const int k0 = 64 * kb, n0 = 32 * nb;
#pragma unroll 8
    for (int i = 0; i < 32; ++i) { const int kk = 2 * i + (lane >> 5); scr[kk * 33 + (lane & 31)] = W[(size_t)(k0 + kk) * N + n0 + (lane & 31)]; }
    asm volatile("s_waitcnt lgkmcnt(0)" ::: "memory");
    const int c = lane & 3;
#pragma unroll
    for (int j = 0; j < 2; ++j) { const int n = (lane >> 2) + 16 * j; const LAS float* s = scr + (16 * c) * 33 + n;
        u32x4 o; o.x = pg8::pk4_fp8(64.f * s[0 * 33], 64.f * s[1 * 33], 64.f * s[2 * 33], 64.f * s[3 * 33]); o.y = pg8::pk4_fp8(64.f * s[4 * 33], 64.f * s[5 * 33], 64.f * s[6 * 33], 64.f * s[7 * 33]);
        o.z = pg8::pk4_fp8(64.f * s[8 * 33], 64.f * s[9 * 33], 64.f * s[10 * 33], 64.f * s[11 * 33]); o.w = pg8::pk4_fp8(64.f * s[12 * 33], 64.f * s[13 * 33], 64.f * s[14 * 33], 64.f * s[15 * 33]);
        *(u32x4*)(WT + (size_t)(drow0 + n) * K + k0 + 16 * c) = o; }
    asm volatile("s_waitcnt lgkmcnt(0)" ::: "memory");
}

__device__ __forceinline__ const float* inp(int i) {
    int off = i * 8; asm volatile("" : "+s"(off));
    const __attribute__((address_space(4))) char* ka = (const __attribute__((address_space(4))) char*)__builtin_amdgcn_kernarg_segment_ptr();
    return *(const float* const __attribute__((address_space(4)))*)(ka + off);
}

struct Ctx {
    LAS unsigned char* lds; LAS unsigned* lctl;
    int tid, lane, wave, vcu, G;
    float* out; unsigned char* ws;
};

__device__ __forceinline__ Ctx fresh(const Ctx& F) { Ctx R = F; int ln, wv = F.wave; asm volatile("v_mbcnt_lo_u32_b32 %0, -1, 0\n\tv_mbcnt_hi_u32_b32 %0, -1, %0" : "=v"(ln)); asm volatile("" : "+s"(wv));
    R.lane = ln; R.wave = wv; R.tid = wv * 64 + ln; return R; }

constexpr int I_IN = (D / 64) * (D_IN / 64), I_OUT = (D / 64) * (D / 64), I_GU = (D / 64) * (D_FF / 64), I_DN = (D_FF / 64) * (D / 64), I_LRU = 2 * 2;
constexpr int E0 = 2 * I_IN, E1 = E0 + 2 * I_OUT, E2 = E1 + I_GU, E3 = E2 + I_GU, E4 = E3 + I_DN, E5 = E4 + NE * I_GU, E6 = E5 + NE * I_GU, E7 = E6 + NE * I_DN, E8 = E7 + 32 * I_LRU;
struct CvDesc { const f32x4* src; unsigned char* dst; int N4, K, fp8; };
__device__ __forceinline__ CvDesc cv_desc(const Ctx& F, const float* const* in, int it) {
    const int n4 = F.lane & 15, kq = F.lane >> 4;
    const float* W; unsigned char* WT; int K, N, kb, nb, gu = 0, fp8 = 0;
    if (it < E0) { const int l = it / I_IN, r = it % I_IN, nblk = D_IN / 64; kb = r / nblk; nb = r % nblk; W = inp(2) + (size_t)l * D * D_IN; K = D; N = D_IN; WT = F.ws + WS_WIN + (size_t)l * D_IN * D * 2; }
    else if (it < E1) { const int q = it - E0, l = q / I_OUT, r = q % I_OUT, nblk = D / 64; kb = r / nblk; nb = r % nblk; W = inp(12) + (size_t)l * D * D; K = D; N = D; WT = F.ws + WS_WOUT + (size_t)l * D * D * 2; }
    else if (it < E3) { const int q = it - E1, up = q / I_GU, r = q % I_GU, nblk = D_FF / 64; kb = r / nblk; nb = r % nblk; W = up ? inp(15) : inp(14); K = D; N = D_FF; WT = F.ws + WS_WGU_D; gu = 1 + up; }
    else if (it < E4) { const int r = it - E3, nblk = D / 32; kb = r / nblk; nb = r % nblk; W = inp(16); K = D_FF; N = D; WT = F.ws + WS_WDN_D; fp8 = 1; }
    else if (it < E6) { const int q = it - E4, up = q / (NE * I_GU), q2 = q % (NE * I_GU), e = q2 / I_GU, r = q2 % I_GU, nblk = D_FF / 32; kb = r / nblk; nb = r % nblk;
        W = (up ? inp(19) : inp(18)) + (size_t)e * D * D_FF; K = D; N = D_FF; WT = F.ws + WS_WGU_M + (size_t)e * 2 * D_FF * D; gu = 1 + up; fp8 = 1; }
    else if (it < E7) { const int q = it - E6, e = q / I_DN, r = q % I_DN, nblk = D / 32; kb = r / nblk; nb = r % nblk; W = inp(20) + (size_t)e * D_FF * D; K = D_FF; N = D; WT = F.ws + WS_WDN_M + (size_t)e * D * D_FF; fp8 = 1; }
    else { const int q = it - E7, mi = q / I_LRU, r = q % I_LRU; kb = r / 2; nb = r % 2;
        const int mat = (mi / 8) & 1, n = mi & 7, l = mi / 16; W = (mat ? inp(7) : inp(5)) + (size_t)(l * 8 + n) * 16384; K = 128; N = 128; WT = F.ws + WS_WLRU + (size_t)mi * 16384 * 2; }
    const int k0 = fp8 ? 128 * kb + 16 * (F.lane >> 3) : 64 * kb + 16 * kq, nn = fp8 ? 32 * nb + 4 * (F.lane & 7) : 64 * nb + 4 * n4;
    const int drow = gu ? ((nn >> 7) * 256 + (nn & 127) + (gu - 1) * 128) : nn;
    CvDesc d; d.src = (const f32x4*)(W + (size_t)k0 * N + nn); d.N4 = N / 4; d.K = K; d.fp8 = fp8; d.dst = WT + ((size_t)drow * K + k0) * (fp8 ? 1 : 2); return d;
}
__device__ __forceinline__ void cv_load(const CvDesc& d, f32x4 (&x)[16]) {
#pragma unroll
    for (int j = 0; j < 16; ++j) x[j] = d.src[(size_t)j * d.N4];
}
__device__ __forceinline__ void cv_store(const CvDesc& d, const f32x4 (&x)[16]) {
    if (d.fp8) {
#pragma unroll
        for (int c = 0; c < 4; ++c) { u32x4 o;
            o.x = pg8::pk4_fp8(64.f * x[0][c], 64.f * x[1][c], 64.f * x[2][c], 64.f * x[3][c]); o.y = pg8::pk4_fp8(64.f * x[4][c], 64.f * x[5][c], 64.f * x[6][c], 64.f * x[7][c]);
            o.z = pg8::pk4_fp8(64.f * x[8][c], 64.f * x[9][c], 64.f * x[10][c], 64.f * x[11][c]); o.w = pg8::pk4_fp8(64.f * x[12][c], 64.f * x[13][c], 64.f * x[14][c], 64.f * x[15][c]);
            *(u32x4*)(d.dst + (size_t)c * d.K) = o; }
    } else {
#pragma unroll
        for (int c = 0; c < 4; ++c) { u32x4 o0, o1;
            o0.x = pk2(x[0][c], x[1][c]); o0.y = pk2(x[2][c], x[3][c]); o0.z = pk2(x[4][c], x[5][c]); o0.w = pk2(x[6][c], x[7][c]);
            o1.x = pk2(x[8][c], x[9][c]); o1.y = pk2(x[10][c], x[11][c]); o1.z = pk2(x[12][c], x[13][c]); o1.w = pk2(x[14][c], x[15][c]);
            u32x4* dst = (u32x4*)(d.dst + (size_t)c * d.K * 2); dst[0] = o0; dst[1] = o1; }
    }
}
__device__ __forceinline__ void convert_items(const Ctx& F, const float* const* in, int lo, int hi, int w0, int nw) {
    int it = lo + w0; if (it >= hi) return;
    CvDesc cur = cv_desc(F, in, it); f32x4 x[16]; cv_load(cur, x);
    for (;;) {
        const int nx = it + nw; const bool more = nx < hi;
        CvDesc nxt = cur; f32x4 y[16];
        if (more) { nxt = cv_desc(F, in, nx); cv_load(nxt, y); }
        cv_store(cur, x);
        if (!more) break;
#pragma unroll
        for (int j = 0; j < 16; ++j) x[j] = y[j];
        cur = nxt; it = nx;
    }
}
__device__ __forceinline__ void w_quant_item(const Ctx& F, const float* W, int N, int nb, float* SW, unsigned char* WT, int gu) {
    const int n4 = F.lane & 7, nn = 32 * nb + 4 * n4, k0 = 256 * F.wave + 32 * (F.lane >> 3);
    const f32x4* src = (const f32x4*)(W + (size_t)k0 * N + nn);
    f32x4 x[32];
#pragma unroll
    for (int j = 0; j < 32; ++j) x[j] = src[(size_t)j * (N / 4)];
    f32x4 mx = (f32x4){0.f, 0.f, 0.f, 0.f};
#pragma unroll
    for (int j = 0; j < 32; ++j) mx = __builtin_elementwise_max(mx, __builtin_elementwise_abs(x[j]));
#pragma unroll
    for (int c = 0; c < 4; ++c) { float v = mx[c]; v = fmaxf(v, shfl_idx(v, F.lane ^ 8)); v = fmaxf(v, shfl_idx(v, F.lane ^ 16)); v = fmaxf(v, shfl_idx(v, F.lane ^ 32)); mx[c] = v; }
    LAS f32x4* cmx = (LAS f32x4*)F.lds;
    if ((F.lane >> 3) == 0) cmx[F.wave * 8 + n4] = mx;
    __syncthreads();
    f32x4 m = cmx[n4];
#pragma unroll
    for (int w = 1; w < 8; ++w) m = __builtin_elementwise_max(m, cmx[w * 8 + n4]);
    __syncthreads();
    const int drow = gu ? ((nn >> 7) * 256 + (nn & 127) + (gu - 1) * 128) : nn;
#pragma unroll
    for (int c = 0; c < 4; ++c) { const float cm = fmaxf(m[c], 1e-30f), inv = 127.0f / cm; unsigned w[8];
#pragma unroll
        for (int q = 0; q < 8; ++q) { unsigned pk = 0;
#pragma unroll
            for (int b = 0; b < 4; ++b) { const int v = (int)rintf(x[4 * q + b][c] * inv); pk |= ((unsigned)v & 0xffu) << (8 * b); }
            w[q] = pk; }
        u32x4* dst = (u32x4*)(WT + (size_t)(drow + c) * D + k0);
        dst[0] = (u32x4){w[0], w[1], w[2], w[3]}; dst[1] = (u32x4){w[4], w[5], w[6], w[7]};
        if (F.wave == 0 && (F.lane >> 3) == 0) SW[nn + c] = cm * (1.0f / 127.0f); }
}
constexpr int QI_GU = D_FF / 32, QI_IN = D_IN / 32, QI_ALL = 2 * QI_GU + 2 * QI_IN;
__device__ __forceinline__ void i8_quantize_items(const Ctx& F, int first, int count, int c, int G) {
    float* SW = (float*)(F.ws + WS_SW);
    for (int it = first + c; it < first + count; it += G) {
        if (it < 2 * QI_GU) { const int up = it >= QI_GU, nb = it - up * QI_GU; w_quant_item(F, up ? inp(15) : inp(14), D_FF, nb, SW + up * D_FF, F.ws + WS_WGU_D, 1 + up); }
        else { const int q = it - 2 * QI_GU, l = q >= QI_IN, nb = q - l * QI_IN; w_quant_item(F, inp(2) + (size_t)l * D * D_IN, D_IN, nb, SW + 2 * D_FF + l * D_IN, F.ws + WS_WIN + (size_t)l * D_IN * D, 0); }
    }
}
__device__ __forceinline__ void p0_convert(const Ctx& F, const float* const* in, int c, int G) {
    i8_quantize_items(F, 0, 2 * QI_GU, c, G); i8_quantize_items(F, 2 * QI_GU + QI_IN, QI_IN, c, G);
    const int gw = c * 8 + F.wave, NGW = G * 8;
    convert_items(F, in, E0, E1, gw, NGW); convert_items(F, in, E3, E8, gw, NGW);
}
__device__ __forceinline__ void p0_prologue(const Ctx& F) {
    i8_quantize_items(F, 2 * QI_GU, QI_IN, F.vcu, F.G);
    f32x2* ROPE = (f32x2*)(F.ws + WS_ROPE);
    for (int i = (F.vcu * 512 + F.tid); i < SEQ * 32; i += F.G * 512) {
        const int s = i >> 5, j = i & 31;
        const float invf = exp2f(-(float)j * (13.287712379549449f / 32.0f));
        const float ang = (float)s * invf;
        const float nrev = rintf(ang * 0.15915494309189535f);
        float r = fmaf(-nrev, 6.28125f, ang); r = fmaf(-nrev, 0.0019353071795864769f, r);
        ROPE[i] = (f32x2){cosf(r), sinf(r)};
    }
}

template <bool BF> struct XSel;
template <> struct XSel<false> { typedef f32x4 type;
    static __device__ __forceinline__ f32x4 load(const void* X, size_t row, int i) { return ((const f32x4*)((const float*)X + row * D))[i]; }
    static __device__ __forceinline__ f32x4 cvt(f32x4 v) { return v; } };
template <> struct XSel<true> { typedef u32x2 type;
    static __device__ __forceinline__ u32x2 load(const void* X, size_t row, int i) { return ((const u32x2*)((const bf16*)X + row * D))[i]; }
    static __device__ __forceinline__ f32x4 cvt(u32x2 w) { return (f32x4){bflo(w.x), bfhi(w.x), bflo(w.y), bfhi(w.y)}; } };
template <bool ROUTE, bool OUTI8 = false, bool XBF = false>
__device__ __forceinline__ void norm_phase(const Ctx& F, const void* Xv, const float* gain, bf16* H, const float* router) {
    const float* X = (const float*)Xv; const bf16* Xb = (const bf16*)Xv; (void)X; (void)Xb;
    const int gw = F.vcu * 8 + F.wave, NGW = F.G * 8;
    f32x4 gv[8];
#pragma unroll
    for (int j = 0; j < 8; ++j) gv[j] = ((const f32x4*)gain)[F.lane + 64 * j];
    LAS float* RT = (LAS float*)F.lds;
    LAS unsigned* lst = (LAS unsigned*)(F.lds + 65536);
    unsigned* TOPE = (unsigned*)(F.ws + WS_ROUTE + RT_TOPE); float* TOPG = (float*)(F.ws + WS_ROUTE + RT_TOPG);
    unsigned* TOPR = (unsigned*)(F.ws + WS_ROUTE + RT_TOPR); unsigned* CNTB = (unsigned*)(F.ws + WS_ROUTE + RT_CNTB);
    if (ROUTE) {
        for (int i = F.tid; i < D * NE; i += 512) { const int c = i >> 3, e = i & 7; RT[e * D + c] = router[i]; }
        __syncthreads();
    }
    int it = 0;
    typedef typename XSel<XBF>::type xrow_t;
    xrow_t vv[8];
    if (gw < T) {
#pragma unroll
        for (int j = 0; j < 8; ++j) vv[j] = XSel<XBF>::load(Xv, (size_t)gw, F.lane + 64 * j); }
    for (int m = gw; m < T; m += NGW, ++it) {
        xrow_t vn[8];
        if (m + NGW < T) {
#pragma unroll
            for (int j = 0; j < 8; ++j) vn[j] = XSel<XBF>::load(Xv, (size_t)(m + NGW), F.lane + 64 * j); }
        else {
#pragma unroll
            for (int j = 0; j < 8; ++j) vn[j] = vv[j]; }
        f32x4 v[8];
#pragma unroll
        for (int j = 0; j < 8; ++j) v[j] = XSel<XBF>::cvt(vv[j]);
        float ss = 0.f;
#pragma unroll
        for (int j = 0; j < 8; ++j) ss += (v[j].x * v[j].x + v[j].y * v[j].y) + (v[j].z * v[j].z + v[j].w * v[j].w);
        ss = wave_sum(ss, F.lane);
        const float rstd = 1.0f / sqrtf(ss * (1.0f / D) + EPS);
        if (OUTI8) {
            float mx = 0.f;
#pragma unroll
            for (int j = 0; j < 8; ++j) { v[j] = v[j] * rstd * gv[j]; mx = fmaxf(mx, fmaxf(fmaxf(fabsf(v[j].x), fabsf(v[j].y)), fmaxf(fabsf(v[j].z), fabsf(v[j].w)))); }
#pragma unroll
            for (int o = 1; o < 64; o <<= 1) mx = fmaxf(mx, shfl_x(mx, o, F.lane));
            mx = fmaxf(mx, 1e-30f); const float inv = 127.0f / mx;
            if (F.lane == 0) ((float*)(F.ws + WS_SA))[m] = mx * (1.0f / 127.0f);
            unsigned* o4 = (unsigned*)((unsigned char*)H + (size_t)m * D) + F.lane;
#pragma unroll
            for (int j = 0; j < 8; ++j) { const int a = (int)rintf(v[j].x * inv), b2 = (int)rintf(v[j].y * inv), c = (int)rintf(v[j].z * inv), d = (int)rintf(v[j].w * inv);
                o4[64 * j] = ((unsigned)a & 0xffu) | (((unsigned)b2 & 0xffu) << 8) | (((unsigned)c & 0xffu) << 16) | (((unsigned)d & 0xffu) << 24); }
        } else if (ROUTE) {
            unsigned* o4 = (unsigned*)((unsigned char*)H + (size_t)m * D) + F.lane;
#pragma unroll
            for (int j = 0; j < 8; ++j) { v[j] = v[j] * rstd * gv[j]; o4[64 * j] = pg8::pk4_fp8(v[j].x, v[j].y, v[j].z, v[j].w); }
        } else {
            u32x2* o8 = (u32x2*)(H + (size_t)m * D) + F.lane;
#pragma unroll
            for (int j = 0; j < 8; ++j) { v[j] = v[j] * rstd * gv[j]; o8[64 * j] = (u32x2){pk2(v[j].x, v[j].y), pk2(v[j].z, v[j].w)}; }
        }
        if (ROUTE) {
            float lg[8];
#pragma unroll
            for (int e = 0; e < 8; ++e) { float a = 0.f;
#pragma unroll
                for (int j = 0; j < 8; ++j) { const f32x4 r = ((const LAS f32x4*)(RT + e * D))[F.lane + 64 * j]; a += (v[j].x * r.x + v[j].y * r.y) + (v[j].z * r.z + v[j].w * r.w); }
                lg[e] = wave_sum(a, F.lane); }
            float v1 = -3.0e38f, v2 = -3.0e38f; int e1 = 0, e2 = 0;
#pragma unroll
            for (int e = 0; e < 8; ++e) { const float x = lg[e]; if (x > v1) { v2 = v1; e2 = e1; v1 = x; e1 = e; } else if (x > v2) { v2 = x; e2 = e; } }
            const float g2 = 1.0f / (1.0f + expf(v1 - v2)), g1 = 1.0f - g2;
            if (F.lane == 0) { TOPE[m] = (unsigned)e1 | ((unsigned)e2 << 8); TOPG[2 * m] = g1; TOPG[2 * m + 1] = g2; lst[it * 8 + F.wave] = (unsigned)e1 | ((unsigned)e2 << 8); }
        }
#pragma unroll
        for (int j = 0; j < 8; ++j) vv[j] = vn[j];
    }
    if (ROUTE) {
        __syncthreads();
        if (F.tid < NE) {
            const unsigned e = F.tid; unsigned cnt = 0;
            const int niter = (T + NGW - 1) / NGW;
            for (int i = 0; i < niter; ++i)
                for (int w = 0; w < 8; ++w) { const int m = F.vcu * 8 + w + i * NGW; if (m < T) { const unsigned ent = lst[i * 8 + w];
                    if ((ent & 0xffu) == e) TOPR[2 * m] = cnt++;
                    if (((ent >> 8) & 0xffu) == e) TOPR[2 * m + 1] = cnt++; } }
            CNTB[F.vcu * 8 + e] = cnt;
        }
    }
}

__device__ __forceinline__ void moe_tables(const Ctx& F) {
    const unsigned* CNTB = (const unsigned*)(F.ws + WS_ROUTE + RT_CNTB);
    {
        const int e = F.wave; unsigned tot = 0, pre = 0;
        for (int b = F.lane; b < F.G; b += 64) { const unsigned c = CNTB[b * 8 + e]; tot += c; pre += (b < F.vcu) ? c : 0u; }
#pragma unroll
        for (int o = 1; o < 64; o <<= 1) { tot += shfl_u(tot, F.lane ^ o); pre += shfl_u(pre, F.lane ^ o); }
        if (F.lane == 0) { F.lctl[LC_PRE + e] = pre; F.lctl[LC_TOT + e] = tot; }
    }
    __syncthreads();
    if (F.tid == 0) { unsigned tb = 0; for (int e = 0; e < NE; ++e) { F.lctl[LC_TB + e] = tb; tb += (F.lctl[LC_TOT + e] + 255u) >> 8; }
        F.lctl[LC_TB + 8] = tb; F.lctl[LC_NMT] = tb; }
    __syncthreads();
    if (F.tid < MAXMT) { unsigned e = 0;
#pragma unroll
        for (int k = 1; k < NE; ++k) e += ((unsigned)F.tid >= F.lctl[LC_TB + k]) ? 1u : 0u;
        F.lctl[LC_TEXP + F.tid] = e; }
    __syncthreads();
}

__device__ __forceinline__ void slot_tables(const Ctx& F) {
    const int gw = F.vcu * 8 + F.wave, NGW = F.G * 8;
    const unsigned* TOPE = (const unsigned*)(F.ws + WS_ROUTE + RT_TOPE); const unsigned* TOPR = (const unsigned*)(F.ws + WS_ROUTE + RT_TOPR); unsigned* SLOT = (unsigned*)(F.ws + WS_ROUTE + RT_SLOT);
    unsigned* ROWOF = (unsigned*)(F.ws + WS_ROUTE + RT_ROWOF);
    for (int m0 = gw; m0 < T; m0 += 32 * NGW) {
        const int m = m0 + (F.lane >> 1) * NGW, k = F.lane & 1;
        if (m < T) { const unsigned e = (TOPE[m] >> (8 * k)) & 0xffu; const unsigned slot = F.lctl[LC_TB + e] * 256u + F.lctl[LC_PRE + e] + TOPR[2 * m + k];
            SLOT[2 * m + k] = slot; ROWOF[slot] = (unsigned)m; }
    }
    if (F.vcu == 0) {
        for (int e = 0; e < NE; ++e) { const unsigned lo = F.lctl[LC_TB + e] * 256u + F.lctl[LC_TOT + e], hi = F.lctl[LC_TB + e + 1] * 256u;
            for (unsigned i = lo + F.tid; i < hi; i += 512) ROWOF[i] = 0u; }
    }
}

__device__ __forceinline__ f32x4 fp8x4(unsigned w) {
    typedef float f2_ __attribute__((ext_vector_type(2)));
    const f2_ lo = __builtin_amdgcn_cvt_pk_f32_fp8((int)w, false), hi = __builtin_amdgcn_cvt_pk_f32_fp8((int)w, true);
    return (f32x4){lo[0], lo[1], hi[0], hi[1]};
}
__device__ __forceinline__ void final_phase(const Ctx& F, const float* gain) {
    const int gw = F.vcu * 8 + F.wave, NGW = F.G * 8;
    const float* TOPG = (const float*)(F.ws + WS_ROUTE + RT_TOPG); const unsigned* SLOT = (const unsigned*)(F.ws + WS_ROUTE + RT_SLOT);
    const unsigned char* OS = F.ws + WS_PROJ; const unsigned char* OS2 = F.ws + WS_H;
    LAS unsigned char* SPL = (LAS unsigned char*)(F.lctl + LC_SPLIT);
    { pg8::SplitOrder S; S.init((int)F.lctl[LC_NMT], D / 256, F.G, 0, nullptr); S.init2();
      for (int i = F.tid; i < MAXMT * 8; i += 512) SPL[i] = 0xffu;
      __syncthreads();
      if (F.tid < S.rem) { pg8::Unit u; if (S.unit_at((long)S.R * S.G + F.tid, u)) SPL[u.pm * 8 + u.pn] = (unsigned char)F.tid; }
      __syncthreads(); }
    f32x4 gv[8];
#pragma unroll
    for (int j = 0; j < 8; ++j) gv[j] = ((const f32x4*)gain)[F.lane + 64 * j];
    float g1 = 0.f, g2 = 0.f, ng1 = 0.f, ng2 = 0.f; unsigned s1 = 0, s2 = 0, ns1 = 0, ns2 = 0;
    const bf16* XR = (const bf16*)(F.ws + WS_XR);
    u32x2 xv[8]; unsigned av[8], bv[8];
    if (gw < T) { g1 = TOPG[2 * gw]; g2 = TOPG[2 * gw + 1]; s1 = SLOT[2 * gw]; s2 = SLOT[2 * gw + 1];
        const u32x2* xr0 = (const u32x2*)(XR + (size_t)gw * D) + F.lane; const unsigned* o1 = (const unsigned*)(OS + (size_t)s1 * D) + F.lane; const unsigned* o2 = (const unsigned*)(OS + (size_t)s2 * D) + F.lane;
#pragma unroll
        for (int j = 0; j < 8; ++j) { xv[j] = xr0[64 * j]; av[j] = o1[64 * j]; bv[j] = o2[64 * j]; } }
    if (gw + NGW < T) { const int mn = gw + NGW; ng1 = TOPG[2 * mn]; ng2 = TOPG[2 * mn + 1]; ns1 = SLOT[2 * mn]; ns2 = SLOT[2 * mn + 1]; }
    for (int m = gw; m < T; m += NGW) {
        f32x4* xr = (f32x4*)(F.out + (size_t)m * D) + F.lane;
        u32x2 xn[8]; unsigned an[8], bn[8]; float fg1 = 0.f, fg2 = 0.f; unsigned fs1 = 0, fs2 = 0;
        if (m + NGW < T) { const u32x2* xrn = (const u32x2*)(XR + (size_t)(m + NGW) * D) + F.lane; const unsigned* o1 = (const unsigned*)(OS + (size_t)ns1 * D) + F.lane; const unsigned* o2 = (const unsigned*)(OS + (size_t)ns2 * D) + F.lane;
#pragma unroll
            for (int j = 0; j < 8; ++j) { xn[j] = xrn[64 * j]; an[j] = o1[64 * j]; bn[j] = o2[64 * j]; } }
        else {
#pragma unroll
            for (int j = 0; j < 8; ++j) { xn[j] = xv[j]; an[j] = av[j]; bn[j] = bv[j]; } }
        if (m + 2 * NGW < T) { const int mf = m + 2 * NGW; fg1 = TOPG[2 * mf]; fg2 = TOPG[2 * mf + 1]; fs1 = SLOT[2 * mf]; fs2 = SLOT[2 * mf + 1]; }
        f32x4 v[8]; float ss = 0.f;
        const float h1 = g1 * 0.0625f, h2 = g2 * 0.0625f;
#pragma unroll
        for (int j = 0; j < 8; ++j) { v[j] = (f32x4){bflo(xv[j].x), bfhi(xv[j].x), bflo(xv[j].y), bfhi(xv[j].y)};
            f32x4 va = fp8x4(av[j]), vb = fp8x4(bv[j]);
            const unsigned q1 = SPL[(s1 >> 8) * 8 + j], q2 = SPL[(s2 >> 8) * 8 + j];
            if (q1 != 0xffu) va += fp8x4(((const unsigned*)(OS2 + ((size_t)q1 * 256 + (s1 & 255u)) * 256))[F.lane]);
            if (q2 != 0xffu) vb += fp8x4(((const unsigned*)(OS2 + ((size_t)q2 * 256 + (s2 & 255u)) * 256))[F.lane]);
            v[j] += h1 * va + h2 * vb;
            ss += (v[j].x * v[j].x + v[j].y * v[j].y) + (v[j].z * v[j].z + v[j].w * v[j].w); }
        ss = wave_sum(ss, F.lane);
        const float rstd = 1.0f / sqrtf(ss * (1.0f / D) + EPS);
#pragma unroll
        for (int j = 0; j < 8; ++j) xr[64 * j] = v[j] * rstd * gv[j];
#pragma unroll
        for (int j = 0; j < 8; ++j) { xv[j] = xn[j]; av[j] = an[j]; bv[j] = bn[j]; }
        g1 = ng1; g2 = ng2; s1 = ns1; s2 = ns2; ng1 = fg1; ng2 = fg2; ns1 = fs1; ns2 = fs2;
    }
}

__device__ __forceinline__ void lru_unit(const Ctx& F, int l, int b, int n, int hf, const float* const* in) {
    asm volatile("" : "+s"(l), "+s"(b), "+s"(n), "+s"(hf));
    const int tid = F.tid, wave = F.wave, lane = F.lane, fr = lane & 15, fq = lane >> 4, nt = wave & 3, mh = wave >> 2;
    LAS unsigned char* XC = F.lds; LAS float* EX = (LAS float*)(F.lds + 32768);
    LAS float* HS = EX + 256;
    static_assert(32768 + (256 + 128 * 68) * 4 <= LDSCTL_OFF, "RG-LRU LDS map");
    const bf16* PROJ = (const bf16*)(F.ws + WS_PROJ); bf16* Y = (bf16*)(F.ws + WS_H); float* SSP = (float*)(F.ws + WS_SSP);
    const bf16* WL = (const bf16*)(F.ws + WS_WLRU) + (size_t)l * 2 * 8 * 16384;
    const int os_g = tid & 7, os_tok = tid >> 3;
    float gn[8]; { const f32x4 a = *(const f32x4*)(inp(10) + (size_t)l * D_RNN + n * 128 + hf * 64 + 8 * os_g), c = *(const f32x4*)(inp(10) + (size_t)l * D_RNN + n * 128 + hf * 64 + 8 * os_g + 4);
        gn[0] = a.x; gn[1] = a.y; gn[2] = a.z; gn[3] = a.w; gn[4] = c.x; gn[5] = c.y; gn[6] = c.z; gn[7] = c.w; }
    const int cg = tid & 15, tl = tid >> 4, cch = n * 128 + cg * 8;
    const int prow0 = ((tl >> 4) << 6) | ((tl & 3) << 4) | (((tl >> 2) & 3) << 2);
    float cw[4][8], cb[8];
#pragma unroll
    for (int tap = 0; tap < 4; ++tap) { const f32x4 a = *(const f32x4*)(inp(3) + (size_t)(l * 4 + tap) * D_RNN + cch), c = *(const f32x4*)(inp(3) + (size_t)(l * 4 + tap) * D_RNN + cch + 4);
        cw[tap][0] = a.x; cw[tap][1] = a.y; cw[tap][2] = a.z; cw[tap][3] = a.w; cw[tap][4] = c.x; cw[tap][5] = c.y; cw[tap][6] = c.z; cw[tap][7] = c.w; }
    { const f32x4 a = *(const f32x4*)(inp(4) + (size_t)l * D_RNN + cch), c = *(const f32x4*)(inp(4) + (size_t)l * D_RNN + cch + 4);
        cb[0] = a.x; cb[1] = a.y; cb[2] = a.z; cb[3] = a.w; cb[4] = c.x; cb[5] = c.y; cb[6] = c.z; cb[7] = c.w; }
    const int lc = hf * 64 + nt * 16 + fr, gc = n * 128 + lc;
    const float ba_c = inp(6)[l * D_RNN + gc], bx_c = inp(8)[l * D_RNN + gc];
    const float sp8 = 8.0f * log1pf(expf(-inp(9)[l * D_RNN + gc]));
    bf16x8 Wa[4], Wx[4];
#pragma unroll
    for (int ks = 0; ks < 4; ++ks) { Wa[ks] = *(const bf16x8*)(WL + (size_t)((0 * 8 + n) * 128 + lc) * 128 + 32 * ks + 8 * fq);
                                     Wx[ks] = *(const bf16x8*)(WL + (size_t)((1 * 8 + n) * 128 + lc) * 128 + 32 * ks + 8 * fq); }
    float Hc = 0.f;
    u32x4 xr[7];
#pragma unroll
    for (int r = 0; r < 7; ++r) { const int t = 4 * tl - 3 + r; xr[r] = (u32x4){0u, 0u, 0u, 0u}; if (t >= 0) xr[r] = *(const u32x4*)(PROJ + (size_t)(b * SEQ + t) * D_IN + cch); }
    for (int ck = 0; ck < SEQ / 128; ++ck) {
        const int t0 = ck * 128;
        {
            float xv[7][8];
#pragma unroll
            for (int r = 0; r < 7; ++r) { const u32x4 w = xr[r];
                xv[r][0] = bflo(w.x); xv[r][1] = bfhi(w.x); xv[r][2] = bflo(w.y); xv[r][3] = bfhi(w.y); xv[r][4] = bflo(w.z); xv[r][5] = bfhi(w.z); xv[r][6] = bflo(w.w); xv[r][7] = bfhi(w.w); }
#pragma unroll
            for (int q = 0; q < 4; ++q) { float y[8];
#pragma unroll
                for (int c = 0; c < 8; ++c) { float a = cb[c];
#pragma unroll
                    for (int tap = 0; tap < 4; ++tap) a += cw[tap][c] * xv[q + tap][c];
                    y[c] = a; }
                *(LAS u32x4*)(XC + tile_off(prow0 + q, 8 * cg, 4)) = (u32x4){pk2(y[0], y[1]), pk2(y[2], y[3]), pk2(y[4], y[5]), pk2(y[6], y[7])}; }
        }
        __syncthreads();
        if (ck + 1 < SEQ / 128) {
#pragma unroll
            for (int r = 0; r < 7; ++r) xr[r] = *(const u32x4*)(PROJ + (size_t)(b * SEQ + t0 + 128 + 4 * tl - 3 + r) * D_IN + cch);
        }
        u32x4 gpre[2];
#pragma unroll
        for (int j = 0; j < 2; ++j) gpre[j] = *(const u32x4*)(PROJ + (size_t)(b * SEQ + t0 + os_tok + 64 * j) * D_IN + OFF_GATE + n * 128 + hf * 64 + 8 * os_g);
        float av[16], bv[16];
#pragma unroll
        for (int mi = 0; mi < 4; ++mi) {
            const int mt = 4 * mh + mi;
            f32x4 aa = (f32x4){0.f, 0.f, 0.f, 0.f}, ax = (f32x4){0.f, 0.f, 0.f, 0.f};
#pragma unroll
            for (int ks = 0; ks < 4; ++ks) { const bf16x8 xf = lds_frag(XC, tile_off(16 * mt + fr, 32 * ks + 8 * fq, 4)); aa = MFMA16(xf, Wa[ks], aa); ax = MFMA16(xf, Wx[ks], ax); }
#pragma unroll
            for (int i = 0; i < 4; ++i) { const int tok = 64 * mh + 16 * fq + 4 * mi + i;
                const float r = sigmoidf_(aa[i] + ba_c), ig = sigmoidf_(ax[i] + bx_c);
                const float a = __expf(-sp8 * r); float mult = sqrtf(fmaxf(1.0f - a * a, 0.f));
                if (ck == 0 && tok == 0) mult = 1.0f;
                const float xcv = __builtin_bit_cast(float, (unsigned)(*(const LAS unsigned short*)(XC + tile_off(16 * mt + 4 * fq + i, lc, 4))) << 16);
                av[4 * mi + i] = a; bv[4 * mi + i] = mult * ig * xcv; }
        }
        float P = av[0], Q = bv[0];
#pragma unroll
        for (int k = 1; k < 16; ++k) { P *= av[k]; Q = Q * av[k] + bv[k]; }
        { const float P1 = shfl_idx(P, lane - 16), Q1 = shfl_idx(Q, lane - 16); if (fq >= 1) { Q = P * Q1 + Q; P = P * P1; } }
        { const float P2 = shfl_idx(P, lane - 32), Q2 = shfl_idx(Q, lane - 32); if (fq >= 2) { Q = P * Q2 + Q; P = P * P2; } }
        float Pex = shfl_idx(P, lane - 16), Qex = shfl_idx(Q, lane - 16); if (fq == 0) { Pex = 1.0f; Qex = 0.f; }
        const float Pc = shfl_idx(P, fr + 48), Qc = shfl_idx(Q, fr + 48);
        if (fq == 0) { EX[((mh * 4 + nt) * 16 + fr) * 2] = Pc; EX[((mh * 4 + nt) * 16 + fr) * 2 + 1] = Qc; }
        __syncthreads();
        const float P0 = EX[((0 * 4 + nt) * 16 + fr) * 2], Q0 = EX[((0 * 4 + nt) * 16 + fr) * 2 + 1], P1h = EX[((1 * 4 + nt) * 16 + fr) * 2], Q1h = EX[((1 * 4 + nt) * 16 + fr) * 2 + 1];
        const float Hmid = P0 * Hc + Q0;
        const float Hw = (mh == 0) ? Hc : Hmid;
        Hc = P1h * Hmid + Q1h;
        {
            float h = Pex * Hw + Qex;
#pragma unroll
            for (int k = 0; k < 16; ++k) { h = av[k] * h + bv[k]; HS[(64 * mh + 16 * fq + k) * 68 + nt * 16 + fr] = h; }
        }
        __syncthreads();
#pragma unroll
        for (int j = 0; j < 2; ++j) { const int tk = os_tok + 64 * j; const size_t row = (size_t)(b * SEQ + t0 + tk);
            const u32x4 gw = gpre[j];
            const f32x4 h0 = *(const LAS f32x4*)(HS + tk * 68 + 8 * os_g), h1 = *(const LAS f32x4*)(HS + tk * 68 + 8 * os_g + 4);
            const float hh[8] = {h0.x, h0.y, h0.z, h0.w, h1.x, h1.y, h1.z, h1.w};
            {
                float ss = ((hh[0] * hh[0] + hh[1] * hh[1]) + (hh[2] * hh[2] + hh[3] * hh[3])) + ((hh[4] * hh[4] + hh[5] * hh[5]) + (hh[6] * hh[6] + hh[7] * hh[7]));
                ss += shfl_x(ss, 1, lane); ss += shfl_x(ss, 2, lane); ss += shfl_x(ss, 4, lane);
                if (os_g == 0) SSP[row * 16 + (n * 2 + hf)] = ss; }
            const float g[8] = {bflo(gw.x), bfhi(gw.x), bflo(gw.y), bfhi(gw.y), bflo(gw.z), bfhi(gw.z), bflo(gw.w), bfhi(gw.w)}; float y[8];
#pragma unroll
            for (int r = 0; r < 8; ++r) { const float x = g[r]; y[r] = hh[r] * gn[r] * (x * sigmoidf_(1.5957691216f * (x + 0.044715f * x * x * x))); }
            *(u32x4*)(Y + row * D + n * 128 + hf * 64 + 8 * os_g) = (u32x4){pk2(y[0], y[1]), pk2(y[2], y[3]), pk2(y[4], y[5]), pk2(y[6], y[7])}; }
    }
    __syncthreads();
}

typedef short s16x4 __attribute__((ext_vector_type(4)));
__device__ __forceinline__ bf16x8 tr_frag(LAS unsigned char* base, int stride, int krow0, int col0, int lane) {
    const int g = lane >> 4, i = lane & 15, q = i >> 2, p = i & 3;
    const s16x4 lo = __builtin_amdgcn_ds_read_tr16_b64_v4i16((LAS s16x4*)(base + (krow0 + 8 * g + q) * stride + (col0 + 4 * p) * 2));
    const s16x4 hi = __builtin_amdgcn_ds_read_tr16_b64_v4i16((LAS s16x4*)(base + (krow0 + 8 * g + 4 + q) * stride + (col0 + 4 * p) * 2));
    return __builtin_shufflevector(lo, hi, 0, 1, 2, 3, 4, 5, 6, 7);
}
constexpr int SKZ = 144, SVS = 288;
__device__ __forceinline__ void ret_unit(const Ctx& F, int l, int b, int h, int c0, int c1, const float* const* in) {
    asm volatile("" : "+s"(l), "+s"(b), "+s"(h), "+s"(c0), "+s"(c1));
    const int tid = F.tid, wave = F.wave, lane = F.lane, fr = lane & 15, fq = lane >> 4;
    LAS unsigned char* Qs = F.lds; LAS unsigned char* Ks = F.lds + 16384; LAS unsigned char* Kz = F.lds + 32768; LAS unsigned char* Vs = Kz + 128 * SKZ;
    LAS unsigned char* Ps = Vs + 128 * SVS; LAS unsigned char* STs = Ps + 32768;
    static_assert(32768 + 128 * SKZ + 128 * SVS + 32768 + 16384 <= LDSCTL_OFF, "retention LDS map");
    const bf16* PROJ = (const bf16*)(F.ws + WS_PROJ); bf16* Y = (bf16*)(F.ws + WS_H); const f32x2* ROPE = (const f32x2*)(F.ws + WS_ROPE);
    const float* rg = inp(11) + (size_t)l * 1024 + h * 128;
    const float lgm = log2f(1.0f - exp2f(-5.0f - (float)h));
    const float cdec = exp2f(128.0f * lgm);
    const int tok = tid >> 2, seg = tid & 3;
    const float zeta = exp2f((float)(127 - tok) * lgm);
    f32x4 accS[4];
#pragma unroll
    for (int dt = 0; dt < 4; ++dt) accS[dt] = (f32x4){0.f, 0.f, 0.f, 0.f};
    f32x4 pr_cs[4]; u32x4 pr_k[2], pr_v[4], pr_q[2];
#define RET_LOAD(ckk, want_q) do { const size_t ro_ = (size_t)(b * SEQ + (ckk) * 128 + tok) * D_IN; const f32x4* cs_ = (const f32x4*)(ROPE + (size_t)((ckk) * 128 + tok) * 32 + 8 * seg); \
        _Pragma("unroll") for (int i_ = 0; i_ < 4; ++i_) pr_cs[i_] = cs_[i_]; \
        pr_k[0] = *(const u32x4*)(PROJ + ro_ + OFF_K + h * 64 + 8 * seg); pr_k[1] = *(const u32x4*)(PROJ + ro_ + OFF_K + h * 64 + 32 + 8 * seg); \
        _Pragma("unroll") for (int q_ = 0; q_ < 4; ++q_) pr_v[q_] = *(const u32x4*)(PROJ + ro_ + OFF_V + h * 128 + 32 * seg + 8 * q_); \
        if (want_q) { pr_q[0] = *(const u32x4*)(PROJ + ro_ + OFF_Q + h * 64 + 8 * seg); pr_q[1] = *(const u32x4*)(PROJ + ro_ + OFF_Q + h * 64 + 32 + 8 * seg); } } while (0)
    pr_q[0] = pr_q[1] = (u32x4){0u, 0u, 0u, 0u};
    RET_LOAD(0, c0 == 0);
    for (int ck = 0; ck < c1; ++ck) {
        const int t0 = ck * 128; const bool full = ck >= c0;
        if (full) {
#pragma unroll
            for (int dt = 0; dt < 4; ++dt) *(LAS u32x2*)(STs + tile_off(16 * wave + fr, 16 * dt + 4 * fq, 2)) = (u32x2){pk2(accS[dt][0], accS[dt][1]), pk2(accS[dt][2], accS[dt][3])};
        }
        {
            float c[8], s[8];
#pragma unroll
            for (int i = 0; i < 4; ++i) { const f32x4 v = pr_cs[i]; c[2 * i] = v.x; s[2 * i] = v.y; c[2 * i + 1] = v.z; s[2 * i + 1] = v.w; }
            if (full) {
                const u32x4 w1 = pr_q[0], w2 = pr_q[1];
                const float x1[8] = {bflo(w1.x), bfhi(w1.x), bflo(w1.y), bfhi(w1.y), bflo(w1.z), bfhi(w1.z), bflo(w1.w), bfhi(w1.w)};
                const float x2[8] = {bflo(w2.x), bfhi(w2.x), bflo(w2.y), bfhi(w2.y), bflo(w2.z), bfhi(w2.z), bflo(w2.w), bfhi(w2.w)};
                float r1[8], r2[8];
#pragma unroll
                for (int i = 0; i < 8; ++i) { r1[i] = x1[i] * c[i] - x2[i] * s[i]; r2[i] = x1[i] * s[i] + x2[i] * c[i]; }
                *(LAS u32x4*)(Qs + tile_off(tok, 8 * seg, 2)) = (u32x4){pk2(r1[0], r1[1]), pk2(r1[2], r1[3]), pk2(r1[4], r1[5]), pk2(r1[6], r1[7])};
                *(LAS u32x4*)(Qs + tile_off(tok, 32 + 8 * seg, 2)) = (u32x4){pk2(r2[0], r2[1]), pk2(r2[2], r2[3]), pk2(r2[4], r2[5]), pk2(r2[6], r2[7])};
            }
            {
                const u32x4 w1 = pr_k[0], w2 = pr_k[1];
                const float x1[8] = {bflo(w1.x), bfhi(w1.x), bflo(w1.y), bfhi(w1.y), bflo(w1.z), bfhi(w1.z), bflo(w1.w), bfhi(w1.w)};
                const float x2[8] = {bflo(w2.x), bfhi(w2.x), bflo(w2.y), bfhi(w2.y), bflo(w2.z), bfhi(w2.z), bflo(w2.w), bfhi(w2.w)};
                float r1[8], r2[8];
#pragma unroll
                for (int i = 0; i < 8; ++i) { r1[i] = (x1[i] * c[i] - x2[i] * s[i]) * 0.125f; r2[i] = (x1[i] * s[i] + x2[i] * c[i]) * 0.125f; }
                if (full) {
                    *(LAS u32x4*)(Ks + tile_off(tok, 8 * seg, 2)) = (u32x4){pk2(r1[0], r1[1]), pk2(r1[2], r1[3]), pk2(r1[4], r1[5]), pk2(r1[6], r1[7])};
                    *(LAS u32x4*)(Ks + tile_off(tok, 32 + 8 * seg, 2)) = (u32x4){pk2(r2[0], r2[1]), pk2(r2[2], r2[3]), pk2(r2[4], r2[5]), pk2(r2[6], r2[7])};
                }
#pragma unroll
                for (int i = 0; i < 8; ++i) { r1[i] *= zeta; r2[i] *= zeta; }
                *(LAS u32x4*)(Kz + tok * SKZ + 16 * seg) = (u32x4){pk2(r1[0], r1[1]), pk2(r1[2], r1[3]), pk2(r1[4], r1[5]), pk2(r1[6], r1[7])};
                *(LAS u32x4*)(Kz + tok * SKZ + 64 + 16 * seg) = (u32x4){pk2(r2[0], r2[1]), pk2(r2[2], r2[3]), pk2(r2[4], r2[5]), pk2(r2[6], r2[7])};
            }
#pragma unroll
            for (int q = 0; q < 4; ++q) *(LAS u32x4*)(Vs + tok * SVS + 64 * seg + 16 * q) = pr_v[q];
        }
        __syncthreads();
        if (ck + 1 < c1) RET_LOAD(ck + 1, ck + 1 >= c0);
        if (full) {
            bf16x8 qf[2];
#pragma unroll
            for (int ks = 0; ks < 2; ++ks) qf[ks] = lds_frag(Qs, tile_off(16 * wave + fr, 32 * ks + 8 * fq, 2));
            int irow = 16 * wave + fr; float lgv = lgm; asm volatile("" : "+v"(irow), "+v"(lgv));
#pragma unroll
            for (int jt = 0; jt < 8; ++jt) {
                u32x2 pw = (u32x2){0u, 0u};
                if (jt <= wave) {
                    f32x4 sc = (f32x4){0.f, 0.f, 0.f, 0.f};
#pragma unroll
                    for (int ks = 0; ks < 2; ++ks) sc = MFMA16(lds_frag(Ks, tile_off(16 * jt + fr, 32 * ks + 8 * fq, 2)), qf[ks], sc);
                    float p[4];
#pragma unroll
                    for (int r = 0; r < 4; ++r) { const int dij = irow - (16 * jt + 4 * fq + r); p[r] = (dij >= 0) ? sc[r] * __builtin_amdgcn_exp2f((float)dij * lgv) : 0.f; }
                    pw = (u32x2){pk2(p[0], p[1]), pk2(p[2], p[3])};
                }
                *(LAS u32x2*)(Ps + tile_off(irow, 16 * jt + 4 * fq, 4)) = pw;
            }
            __syncthreads();
            bf16x8 pf[4];
#pragma unroll
            for (int ks = 0; ks < 4; ++ks) pf[ks] = lds_frag(Ps, tile_off(16 * wave + fr, 32 * ks + 8 * fq, 4));
            const float xi = __builtin_amdgcn_exp2f((float)(irow + 1) * lgv);
            float o[8][4]; float sum = 0.f;
#pragma unroll
            for (int et = 0; et < 8; ++et) {
                f32x4 ao = (f32x4){0.f, 0.f, 0.f, 0.f}, ac = (f32x4){0.f, 0.f, 0.f, 0.f};
#pragma unroll
                for (int ks = 0; ks < 4; ++ks) if (32 * ks <= 16 * wave + 15) ao = MFMA16(tr_frag(Vs, SVS, 32 * ks, 16 * et, lane), pf[ks], ao);
#pragma unroll
                for (int ks = 0; ks < 2; ++ks) ac = MFMA16(lds_frag(STs, tile_off(16 * et + fr, 32 * ks + 8 * fq, 2)), qf[ks], ac);
#pragma unroll
                for (int r = 0; r < 4; ++r) { o[et][r] = ao[r] + xi * ac[r]; sum += o[et][r]; }
            }
            sum += shfl_x(sum, 16, lane); sum += shfl_x(sum, 32, lane);
            const float mean = sum * (1.0f / 128.0f); float var = 0.f;
#pragma unroll
            for (int et = 0; et < 8; ++et)
#pragma unroll
                for (int r = 0; r < 4; ++r) { const float d = o[et][r] - mean; var += d * d; }
            var += shfl_x(var, 16, lane); var += shfl_x(var, 32, lane);
            const float rstd = 1.0f / sqrtf(var * (1.0f / 128.0f) + EPS);
            {
                const size_t rowo = (size_t)(b * SEQ + t0 + irow);
#pragma unroll
                for (int et = 0; et < 8; ++et) {
                    const u32x2 gw = *(const u32x2*)(PROJ + rowo * D_IN + OFF_G + h * 128 + 16 * et + 4 * fq);
                    const f32x4 gn = *(const f32x4*)(rg + 16 * et + 4 * fq);
                    const float g[4] = {bflo(gw.x), bfhi(gw.x), bflo(gw.y), bfhi(gw.y)};
                    float y[4];
#pragma unroll
                    for (int r = 0; r < 4; ++r) y[r] = (o[et][r] - mean) * rstd * gn[r] * (g[r] * sigmoidf_(g[r]));
                    *(u32x2*)(Y + rowo * D + 1024 + h * 128 + 16 * et + 4 * fq) = (u32x2){pk2(y[0], y[1]), pk2(y[2], y[3])};
                }
            }
        }
        {
            bf16x8 vf[4];
#pragma unroll
            for (int ks = 0; ks < 4; ++ks) vf[ks] = tr_frag(Vs, SVS, 32 * ks, 16 * wave, lane);
#pragma unroll
            for (int dt = 0; dt < 4; ++dt) { accS[dt] = accS[dt] * cdec;
#pragma unroll
                for (int ks = 0; ks < 4; ++ks) accS[dt] = MFMA16(tr_frag(Kz, SKZ, 32 * ks, 16 * dt, lane), vf[ks], accS[dt]); }
        }
        __syncthreads();
    }
#undef RET_LOAD
}

__device__ __forceinline__ void ylru_phase(const Ctx& F, int l, const float* gain) {
    const int gw = F.vcu * 8 + F.wave, NGW = F.G * 8;
    const float* HLRU = (const float*)(F.ws + WS_HID); const float* SSP = (const float*)(F.ws + WS_SSP); const bf16* PROJ = (const bf16*)(F.ws + WS_PROJ); bf16* Y = (bf16*)(F.ws + WS_H);
    f32x4 gv[4];
#pragma unroll
    for (int j = 0; j < 4; ++j) gv[j] = ((const f32x4*)(gain + (size_t)l * D_RNN))[F.lane + 64 * j];
    for (int m = gw; m < T; m += NGW) {
        float ss = 0.f;
#pragma unroll
        for (int n = 0; n < 16; ++n) ss += SSP[(size_t)n * T + m];
        const float rstd = 1.0f / sqrtf(ss * (1.0f / D_RNN) + EPS);
#pragma unroll
        for (int j = 0; j < 4; ++j) { const f32x4 hh = ((const f32x4*)(HLRU + (size_t)m * D_RNN))[F.lane + 64 * j];
            const u32x2 gw2 = ((const u32x2*)(PROJ + (size_t)m * D_IN + OFF_GATE))[F.lane + 64 * j];
            const float g[4] = {bflo(gw2.x), bfhi(gw2.x), bflo(gw2.y), bfhi(gw2.y)}; float y[4];
#pragma unroll
            for (int r = 0; r < 4; ++r) { const float x = g[r]; const float ge = x * sigmoidf_(1.5957691216f * (x + 0.044715f * x * x * x)); y[r] = hh[r] * rstd * gv[j][r] * ge; }
            ((u32x2*)(Y + (size_t)m * D))[F.lane + 64 * j] = (u32x2){pk2(y[0], y[1]), pk2(y[2], y[3])}; }
    }
}

constexpr int NPHASE = 20;
struct Args { const float* in[22]; float* out; unsigned char* ws; int ph_lo, ph_hi, li, pad; };
__global__ void __launch_bounds__(512, 2) fwd(Args args) {
    extern __shared__ __attribute__((aligned(16))) unsigned char lds_raw[];
    Ctx F;
    F.lds = (LAS unsigned char*)lds_raw; F.lctl = (LAS unsigned*)(F.lds + LDSCTL_OFF);
    F.tid = threadIdx.x; F.lane = F.tid & 63; F.wave = __builtin_amdgcn_readfirstlane(F.tid >> 6);
    F.G = gridDim.x; { const int bx = blockIdx.x; F.vcu = (F.G % 8 == 0) ? (bx % 8) * (F.G / 8) + bx / 8 : bx; }
    F.out = args.out; F.ws = args.ws;
    for (int u = F.tid; u < (LDS_BYTES - LDSCTL_OFF) / 4; u += 512) F.lctl[u] = 0u;
    __syncthreads();
    unsigned* ctl = (unsigned*)(args.ws + WS_CTL);
    XcdBarrier bar = xcd_barrier_post(ctl + CW_BAR + args.li * XCD_BAR_WORDS, (volatile LAS unsigned*)(F.lctl + LC_BAR));
    const int lo = args.ph_lo, hi = args.ph_hi;
#define IN(k) (lo <= (k) && (k) < hi)
#define SEAM(k) do { if ((k) + 1 < hi) xcd_barrier(bar); } while (0)
    bf16* Hb = (bf16*)(args.ws + WS_H); bf16* PROJ = (bf16*)(args.ws + WS_PROJ); bf16* HID = (bf16*)(args.ws + WS_HID);

    if (IN(0)) REPEAT(REP_P0) { const Ctx P = fresh(F); p0_prologue(P); norm_phase<false, true>(P, inp(0), inp(1), Hb, nullptr); SEAM(0); }

    for (int l = 0; l < 2; ++l) {
        const int pb = 1 + 9 * l;
        bf16* XR = (bf16*)(args.ws + WS_XR);
        if (IN(pb + 0) && l == 1) REPEAT(REP_NORM) { const Ctx P = fresh(F); norm_phase<false, true, true>(P, XR, inp(1) + (size_t)l * D, Hb, nullptr); SEAM(pb + 0); }
        if (IN(pb + 1)) REPEAT(REP_GIN) {
            const Ctx P = fresh(F);
            int Gv = F.G, cv = (int)blockIdx.x; bool gemm = true;
            if (l == 0) {
                const int xcd = (int)blockIdx.x % 8, idx = (int)blockIdx.x / 8, per = F.G / 8, nc = (F.G % 8 == 0 && per > GIN0_NC) ? GIN0_NC : 0;
                int cc = F.vcu, cg = F.G; bool conv = true;
                if (nc != 0) { if (idx >= per - nc) { cc = (idx - (per - nc)) * 8 + xcd; cg = nc * 8; gemm = false; } else { conv = false; Gv = (per - nc) * 8; cv = idx * 8 + xcd; } }
                if (conv) p0_convert(P, args.in, cc, cg);
            }
            if (gemm) {
                pg8::Gemm g{Hb, args.ws + WS_WIN + (size_t)l * D_IN * D, D}; pg8::ScaleOrder S; S.init(T / 256, D_IN / 256, Gv, cv, nullptr);
                S.SA = (const float*)(args.ws + WS_SA); S.SW = (const float*)(args.ws + WS_SW) + 2 * D_FF + (size_t)l * D_IN; S.cols = 0; S.st = (LAS float*)(P.lds + pg8::RS_OFF); S.tid = P.tid;
                pg8::EpiOut<true> E{nullptr, nullptr, PROJ, D_IN, 1, S.SA, S.SW, nullptr, S.st};
                pg8::gemm_phase<pg8::EpiOut<true>, pg8::ScaleOrder, true, true, 2>(P.lds, P.tid, g, S, E);
            }
            SEAM(pb + 1);
        }
        if (IN(pb + 2)) REPEAT(REP_MIX) {
            const Ctx P = fresh(F);
            for (int u = blockIdx.x; u < 128; u += F.G) REPEAT(REP_RET) { const int bh = u & 63, th = u >> 6; ret_unit(P, l, bh >> 3, bh & 7, th ? 9 : 0, th ? 16 : 9, args.in); }
            { int u0 = (int)blockIdx.x - 128; if (u0 < 0) u0 += F.G; for (int u = u0; u < 128; u += F.G) REPEAT(REP_LRU) { const int bn = u & 63; lru_unit(P, l, bn >> 3, bn & 7, u >> 6, args.in); } }
            SEAM(pb + 2);
        }
        if (IN(pb + 4)) {
            const Ctx P = fresh(F);
            pg8::Gemm g{Hb, (const bf16*)(args.ws + WS_WOUT) + (size_t)l * D * D, 2 * D}; pg8::RowScaleOrder S; S.init(T / 256, D / 256, F.G, (int)blockIdx.x, nullptr);
            S.ssp = (const float*)(args.ws + WS_SSP); S.rs = (LAS float*)(P.lds + pg8::RS_OFF); S.tid = P.tid;
            pg8::EpiOut<false> E{l == 0 ? (const void*)inp(0) : (const void*)XR, XR, nullptr, D, l == 0 ? 0 : 2, nullptr, nullptr};
            pg8::gemm_phase<pg8::EpiOut<false>, pg8::RowScaleOrder, true, true, 0, true>(P.lds, P.tid, g, S, E);
            SEAM(pb + 4);
        }
        if (IN(pb + 5)) REPEAT(REP_NORM) {
            const Ctx P = fresh(F);
            if (l == 0) { norm_phase<false, true, true>(P, XR, inp(13) + (size_t)l * D, Hb, nullptr); }
            else norm_phase<true, false, true>(P, XR, inp(13) + (size_t)l * D, Hb, inp(17));
            SEAM(pb + 5);
        }
        if (IN(pb + 6) && l == 1) REPEAT(REP_GATHER) { const Ctx P = fresh(F); moe_tables(P); slot_tables(P); SEAM(pb + 6); }
        if (IN(pb + 7)) REPEAT(REP_GGU) {
            const Ctx P = fresh(F);
            if (l == 0) {
                pg8::Gemm g{Hb, args.ws + WS_WGU_D, D}; pg8::ScaleOrder S; S.init(T / 256, 2 * D_FF / 256, F.G, (int)blockIdx.x, nullptr);
                S.SA = (const float*)(args.ws + WS_SA); S.SW = (const float*)(args.ws + WS_SW); S.cols = D_FF; S.st = (LAS float*)(P.lds + pg8::RS_OFF); S.tid = P.tid;
                pg8::EpiSwiglu<true, true> E{HID, D_FF, S.SA, S.SW, S.st};
                pg8::gemm_phase<pg8::EpiSwiglu<true, true>, pg8::ScaleOrder, true, true, 2>(P.lds, P.tid, g, S, E);
            } else {
                if (!MK_ONE_LAUNCH || lo > pb + 6) moe_tables(P);
                pg8::Gemm g{Hb, args.ws + WS_WGU_M, D, (const unsigned*)(args.ws + WS_ROUTE + RT_ROWOF)};
                pg8::GroupOrder S; S.init((int)P.lctl[LC_NMT], 2 * D_FF / 256, F.G, (int)blockIdx.x, (const LAS int*)(P.lctl + LC_TEXP));
                pg8::EpiSwiglu<true> E{HID, D_FF, nullptr, nullptr};
                pg8::gemm_phase<pg8::EpiSwiglu<true>, pg8::GroupOrder, true, true, 1, false, false, true>(P.lds, P.tid, g, S, E);
            }
            SEAM(pb + 7);
        }
        if (IN(pb + 8)) {
            const Ctx P = fresh(F);
            if (l == 0) {
                pg8::Gemm g{HID, args.ws + WS_WDN_D, D_FF}; pg8::GroupOrder S; S.init(T / 256, D / 256, F.G, (int)blockIdx.x, nullptr);
                pg8::EpiOut<false> E{XR, XR, nullptr, D, 2, nullptr, nullptr};
                pg8::gemm_phase<pg8::EpiOut<false>, pg8::GroupOrder, true, true, 1>(P.lds, P.tid, g, S, E);
            } else {
                if (!MK_ONE_LAUNCH || lo > pb + 6) moe_tables(P);
                static_assert((D_FF / 128 / 2) % 2 == 0, "half of K is a whole number of K-tile pairs");
                pg8::Gemm g{HID, args.ws + WS_WDN_M, D_FF}; pg8::SplitOrder S; S.init((int)P.lctl[LC_NMT], D / 256, F.G, (int)blockIdx.x, (const LAS int*)(P.lctl + LC_TEXP)); S.init2();
                pg8::EpiOut<false, true> E{nullptr, nullptr, PROJ, D, 1, nullptr, nullptr, (bf16*)(args.ws + WS_H)};
                pg8::gemm_phase<pg8::EpiOut<false, true>, pg8::SplitOrder, true, true, 1, false, true>(P.lds, P.tid, g, S, E);
            }
            SEAM(pb + 8);
        }
    }
    if (IN(19)) { const Ctx P = fresh(F); if (!MK_ONE_LAUNCH || lo > 16) moe_tables(P); final_phase(P, inp(21)); }
#undef IN
#undef SEAM
}

extern "C" void kernel_launch(void* const* d_in, const int* in_sizes, int n_in, void* d_out, int out_size, void* d_ws, size_t ws_size, hipStream_t stream) {
    static int grid = 0;
    if (grid == 0) {
        if (n_in != 22 || in_sizes[0] != T * D || out_size != T * D || ws_size < WS_END) { fprintf(stderr, "kernel_launch: unexpected shapes (n_in %d, in0 %d, out %d, ws %zu < %zu); nothing launched\n", n_in, n_in > 0 ? in_sizes[0] : -1, out_size, ws_size, (size_t)WS_END); grid = -1; return; }
        int dev = 0, cus = 0, per_cu = 0;
        if (hipGetDevice(&dev) != hipSuccess || hipDeviceGetAttribute(&cus, hipDeviceAttributeMultiprocessorCount, dev) != hipSuccess) { grid = -1; return; }
        if (hipFuncSetAttribute((const void*)fwd, hipFuncAttributeMaxDynamicSharedMemorySize, LDS_BYTES) != hipSuccess) { fprintf(stderr, "kernel_launch: hipFuncSetAttribute failed\n"); grid = -1; return; }
        if (hipOccupancyMaxActiveBlocksPerMultiprocessor(&per_cu, (const void*)fwd, 512, LDS_BYTES) != hipSuccess || per_cu < 1) fprintf(stderr, "kernel_launch: occupancy query reports %d\n", per_cu);
        (void)hipGetLastError();
        grid = cus < 256 ? cus : 256;
    }
    if (grid < 0) return;
    if (hipMemsetAsync((char*)d_ws + WS_CTL, 0, CTL_ZERO_BYTES, stream) != hipSuccess) return;
    Args a{};
    for (int i = 0; i < 22; ++i) a.in[i] = (const float*)d_in[i];
    a.out = (float*)d_out; a.ws = (unsigned char*)d_ws; a.pad = 0;
#if MK_ONE_LAUNCH
    a.ph_lo = 0; a.ph_hi = NPHASE; a.li = 0;
    hipLaunchKernelGGL(fwd, dim3(grid), dim3(512), LDS_BYTES, stream, a);
#else
    int li = 0;
    for (int p = 0; p < NPHASE; ++p) {
        if (p == 1 || p == 1 + 6 || p == 4 || p == 13) continue;
        a.ph_lo = p; a.ph_hi = p + 1; a.li = li++;
        hipLaunchKernelGGL(fwd, dim3(grid), dim3(512), LDS_BYTES, stream, a);
    }
#endif
}
```

```cpp
#include <hip/hip_runtime.h>
#include <cstdio>
#include <cstdint>

#ifndef MK_ONE_LAUNCH
#define MK_ONE_LAUNCH 1
#endif

#ifndef REP_P0
#define REP_P0 1
#endif
#ifndef REP_NORM
#define REP_NORM 1
#endif
#ifndef REP_GIN
#define REP_GIN 1
#endif
#ifndef REP_MIX
#define REP_MIX 1
#endif
#ifndef REP_YLRU
#define REP_YLRU 1
#endif
#ifndef REP_GATHER
#define REP_GATHER 1
#endif
#ifndef REP_GGU
#define REP_GGU 1
#endif
#ifndef REP_RET
#define REP_RET 1
#endif
#ifndef REP_LRU
#define REP_LRU 1
#endif
#define REPEAT(n) for (int rep_ = 0; rep_ < (n); ++rep_)
#ifndef GIN0_NC
#define GIN0_NC 20
#endif
#define LAS __attribute__((address_space(3)))
#define GAS __attribute__((address_space(1)))
typedef unsigned short bf16;
typedef short bf16x8 __attribute__((ext_vector_type(8)));
typedef float f32x4 __attribute__((ext_vector_type(4)));
typedef float f32x2 __attribute__((ext_vector_type(2)));
typedef unsigned u32x4 __attribute__((ext_vector_type(4)));
typedef unsigned u32x2 __attribute__((ext_vector_type(2)));

constexpr int BATCH = 8, SEQ = 2048, T = BATCH * SEQ, D = 2048, D_IN = 5120, D_RNN = 1024, NH = 8, DK = 64, DV = 128, D_FF = 5632, NE = 8;
constexpr int OFF_GATE = 1024, OFF_Q = 2048, OFF_K = 2560, OFF_V = 3072, OFF_G = 4096;
constexpr float EPS = 1e-6f;
constexpr int MAXMT = 136;
constexpr int MPAD = MAXMT * 256;

constexpr size_t MiB = 1u << 20;
constexpr size_t WS_CTL = 0, CTL_ZERO_BYTES = 1 * MiB;
constexpr size_t WS_ROPE = 1 * MiB;
constexpr size_t WS_WLRU = 2 * MiB;
constexpr size_t WS_SSP = 3 * MiB;
constexpr size_t WS_ROUTE = 4 * MiB;
constexpr size_t RT_TOPE = 0, RT_TOPG = 65536, RT_TOPR = 65536 * 3, RT_SLOT = 65536 * 5, RT_CNTB = 65536 * 7, RT_ROWOF = 65536 * 8;
constexpr size_t WS_SA = 5 * MiB;
constexpr size_t WS_SW = 6 * MiB;
constexpr size_t WS_WIN = 8 * MiB;
constexpr size_t WS_WOUT = 48 * MiB;
constexpr size_t WS_WGU_D = 64 * MiB;
constexpr size_t WS_WDN_D = 108 * MiB;
constexpr size_t WS_WGU_M = 130 * MiB;
constexpr size_t WS_WDN_M = 482 * MiB;
constexpr size_t WS_XR = 400 * MiB;
constexpr size_t WS_H = 658 * MiB;
constexpr size_t WS_PROJ = 722 * MiB;
constexpr size_t WS_HID = 882 * MiB;
constexpr size_t WS_END = 1256 * MiB;
static_assert(WS_WIN + (size_t)2 * D_IN * D * 2 <= WS_WOUT && WS_WOUT + (size_t)2 * D * D * 2 <= WS_WGU_D && WS_WGU_D + (size_t)2 * D_FF * D * 2 <= WS_WDN_D &&
              WS_WDN_D + (size_t)D * D_FF * 2 <= WS_WGU_M && WS_WGU_M + (size_t)NE * 2 * D_FF * D * 2 <= WS_WDN_M && WS_WDN_M + (size_t)NE * D * D_FF * 2 <= WS_H &&
              WS_H + (size_t)T * D * 2 <= WS_PROJ && WS_PROJ + (size_t)T * D_IN * 2 <= WS_HID && WS_PROJ + (size_t)MPAD * D * 2 <= WS_HID && WS_HID + (size_t)MPAD * D_FF * 2 <= WS_END, "d_ws map");
static_assert(WS_WGU_M + (size_t)NE * 2 * D_FF * D <= WS_XR && WS_XR + (size_t)T * D * 2 <= WS_WDN_M, "residual stream inside the free half of the expert gate/up region");
constexpr int CW_TMO = 0;
constexpr int CW_BAR = 4096;

constexpr int RING_BYTES = 131072;
constexpr int LDSCTL_OFF = 140 * 1024;
constexpr int LDS_BYTES = 147456;
constexpr int LC_BAR = 0, LC_TB = 16, LC_PRE = 32, LC_TOT = 40, LC_NMT = 48, LC_TEXP = 64, LC_SPLIT = 256;

#define RLX_AGENT __ATOMIC_RELAXED, __HIP_MEMORY_SCOPE_AGENT
__device__ __forceinline__ unsigned f2bf(float f) { unsigned u = __builtin_bit_cast(unsigned, f); return (u + 0x7fffu + ((u >> 16) & 1u)) >> 16; }
__device__ __forceinline__ unsigned pk2(float lo, float hi) { return f2bf(lo) | (f2bf(hi) << 16); }
__device__ __forceinline__ float bflo(unsigned w) { return __builtin_bit_cast(float, w << 16); }
__device__ __forceinline__ float bfhi(unsigned w) { return __builtin_bit_cast(float, w & 0xffff0000u); }
__device__ __forceinline__ void st_wt(void* p, unsigned v) { asm volatile("global_store_dword %0, %1, off sc0 sc1" :: "v"(p), "v"(v) : "memory"); }
__device__ __forceinline__ float shfl_idx(float v, int src) { return __builtin_bit_cast(float, __builtin_amdgcn_ds_bpermute(src << 2, __builtin_bit_cast(int, v))); }
__device__ __forceinline__ float shfl_x(float v, int o, int lane) { return shfl_idx(v, lane ^ o); }
__device__ __forceinline__ unsigned shfl_u(unsigned v, int src) { return (unsigned)__builtin_amdgcn_ds_bpermute(src << 2, (int)v); }
__device__ __forceinline__ float wave_sum(float v, int lane) {
#pragma unroll
    for (int o = 1; o < 64; o <<= 1) v += shfl_x(v, o, lane);
    return v;
}
__device__ __forceinline__ float sigmoidf_(float x) { return __builtin_amdgcn_rcpf(1.0f + __expf(-x)); }
__device__ __forceinline__ int tile_off(int r, int c, int kc32) { const int ob = (r & 15) * 64 + (c & 31) * 2; return ((r >> 4) * kc32 + (c >> 5)) * 1024 + (ob ^ (((ob >> 9) & 1) << 5)); }
__device__ __forceinline__ bf16x8 lds_frag(LAS unsigned char* base, int off) { return *(const LAS bf16x8*)(base + off); }
#define MFMA16(a, b, c) __builtin_amdgcn_mfma_f32_16x16x32_bf16((a), (b), (c), 0, 0, 0)

namespace pg8 {
constexpr int BM = 256, BK = 64, HALF = 128, HTB = HALF * BK * 2, STAGE_BYTES = 8 * HTB, NXCD = 8, WGM = 8;
__host__ __device__ __forceinline__ int lds_byte(int r, int c) { const int st = (r >> 4) * 2 + (c >> 5), rr = r & 15, cc = c & 31, ob = rr * 64 + cc * 2; return st * 1024 + (ob ^ (((ob >> 9) & 1) << 5)); }
__host__ __device__ __forceinline__ void stage_rc(int b, int& R, int& C) { const int st = b / 1024, sb = b % 1024, swz = sb ^ (((sb >> 9) & 1) << 5); R = (st >> 1) * 16 + swz / 64; C = (st & 1) * 32 + (swz % 64) / 2; }
__host__ __device__ __forceinline__ int perm32(int rho) { const int n = rho >> 4, i = rho & 15; return 8 * (i >> 2) + 4 * n + (i & 3); }

struct Unit { int pm, pn, pb, kh; };
struct Gemm { const void* A; const void* Bt; int Kb; const unsigned* arow; };

struct GroupOrder {
    int nM, nN, nwg, G, c; const LAS int* texp;
    __device__ void init(int nM_, int nN_, int G_, int c_, const LAS int* texp_) { nM = nM_; nN = nN_; nwg = nM * nN; G = G_; c = c_; texp = texp_; }
    __device__ bool next(int i, Unit& u) const { return unit_at((long)i * G + c, u); }
    __device__ bool unit_at(long L, Unit& u) const {
        if (L >= nwg) return false;
        int wgid = (int)L; { const int q = nwg / NXCD, r = nwg % NXCD, xcd = wgid % NXCD, off = wgid / NXCD; wgid = (xcd < r ? xcd * (q + 1) : r * (q + 1) + (xcd - r) * q) + off; }
        const int nig = WGM * nN, gid = wgid / nig, fm = gid * WGM, gsz = (nM - fm) < WGM ? (nM - fm) : WGM;
        u.pm = fm + ((wgid % nig) % gsz); u.pn = (wgid % nig) / gsz;
        u.pb = (texp ? __builtin_amdgcn_readfirstlane(texp[u.pm]) : 0) * nN + u.pn; return true;
    }
    struct Pre {};
    __device__ __forceinline__ void a_issue(const Unit&, Pre&) const {}
    __device__ __forceinline__ void a_finish(const Unit&, int, const Pre&) const {}
    __device__ __forceinline__ void done(const Unit&) const {}
};
struct SplitOrder : GroupOrder {
    int R, rem;
    __device__ void init2() { R = nwg / G; rem = nwg - R * G; if (2 * rem > G) rem = 0; }
    __device__ bool next(int i, Unit& u) const {
        if (rem == 0 || i < R) { const bool ok = GroupOrder::next(i, u); u.kh = 0; return ok; }
        if (i > R || c >= 2 * rem) return false;
        const bool ok = unit_at((long)R * G + (c >> 1), u); u.kh = ((c >> 1) << 2) | (1 + (c & 1)); return ok;
    }
};
constexpr int RS_OFF = 131072;
struct RowScaleOrder : GroupOrder {
    const float* ssp; LAS float* rs; int tid;
    struct Pre { f32x4 a, b; };
    __device__ __forceinline__ void a_issue(const Unit& u, Pre& p) const {
        const int r = tid & 255, h = tid >> 8; const f32x4* q = (const f32x4*)(ssp + (size_t)(u.pm * BM + r) * 16 + h * 8);
        p.a = q[0]; p.b = q[1];
    }
    __device__ __forceinline__ void a_finish(const Unit&, int par, const Pre& p) const {
        const int r = tid & 255, h = tid >> 8; const f32x4 t4 = p.a + p.b;
        rs[(par * 2 + h) * 256 + r] = (t4[0] + t4[1]) + (t4[2] + t4[3]);
    }
};
struct ScaleOrder : GroupOrder {
    const float* SA; const float* SW; int cols; LAS float* st; int tid;
    struct Pre { float v; };
    __device__ bool next(int i, Unit& u) const { const bool ok = GroupOrder::next(i, u); u.kh = i & 1; return ok; }
    __device__ __forceinline__ void a_issue(const Unit& u, Pre& p) const {
        const int t = tid;
        p.v = t < 256 ? SA[u.pm * BM + t] : (cols == 0 ? SW[u.pn * BM + t - 256] : (t < 384 ? SW[u.pn * HALF + t - 256] : SW[cols + u.pn * HALF + t - 384]));
    }
    __device__ __forceinline__ void a_finish(const Unit&, int par, const Pre& p) const { st[par * 512 + tid] = p.v; }
};
__device__ __forceinline__ float rs_scale(const LAS float* rs, int par, int r, float inv) { return 1.0f / sqrtf((rs[(par * 2) * 256 + r] + rs[(par * 2 + 1) * 256 + r]) * inv + EPS); }

__device__ __forceinline__ unsigned cvt_pk_bf16(float lo, float hi) { unsigned r; asm volatile("v_cvt_pk_bf16_f32 %0, %1, %2" : "=v"(r) : "v"(lo), "v"(hi)); return r; }

__device__ __forceinline__ float clamp448(float x) { return __builtin_amdgcn_fmed3f(x, -448.0f, 448.0f); }
__device__ __forceinline__ unsigned pk4_fp8(float a, float b, float c, float d) { unsigned w = 0; w = __builtin_amdgcn_cvt_pk_fp8_f32(clamp448(a), clamp448(b), w, false); w = __builtin_amdgcn_cvt_pk_fp8_f32(clamp448(c), clamp448(d), w, true); return w; }
template <bool INI8 = false, bool KS = false> struct EpiOut {
    static constexpr bool PERM = true;
    const void* base; bf16* C; bf16* O; int ldc; int mode; const float* SA; const float* SW;
    bf16* O2;
    const LAS float* st;
    __device__ __forceinline__ void operator()(const f32x4 (&acc)[2][2][4][2], const Unit& u, int wr, int wc, int fr, int fq) const {
        int row0 = u.pm * BM + wr * 64 + fr, col0 = u.pn * BM + wc * 32 + 8 * fq;
        if (mode == 1) {
            bf16* O = this->O; int ldc = this->ldc;
            if constexpr (KS) { if ((u.kh & 3) == 2) { O = (bf16*)((unsigned char*)O2 + (size_t)(u.kh >> 2) * (BM * BM)); ldc = BM; row0 = wr * 64 + fr; col0 = wc * 32 + 8 * fq; } }
            float sw[2][8];
            if constexpr (INI8) {
#pragma unroll
                for (int bj = 0; bj < 2; ++bj)
#pragma unroll
                    for (int j = 0; j < 8; ++j) sw[bj][j] = st ? st[512 * u.kh + 256 + wc * 32 + 8 * fq + bj * HALF + j] : SW[col0 + bj * HALF + j]; }
#pragma unroll
            for (int ai = 0; ai < 2; ++ai)
#pragma unroll
                for (int m = 0; m < 4; ++m) {
                    const size_t off = (size_t)(row0 + ai * HALF + m * 16) * ldc + col0;
                    float sa = 1.0f; if constexpr (INI8) sa = st ? st[512 * u.kh + wr * 64 + fr + ai * HALF + m * 16] : SA[row0 + ai * HALF + m * 16];
#pragma unroll
                    for (int bj = 0; bj < 2; ++bj) { float f[8];
#pragma unroll
                        for (int j = 0; j < 4; ++j) { const float a0 = acc[ai][bj][m][0][j], a1 = acc[ai][bj][m][1][j];
                            if constexpr (INI8) { f[j] = (float)__builtin_bit_cast(int, a0) * (sa * sw[bj][j]); f[4 + j] = (float)__builtin_bit_cast(int, a1) * (sa * sw[bj][4 + j]); }
                            else { f[j] = a0; f[4 + j] = a1; } }
                        if constexpr (KS) {
                            *(u32x2*)((unsigned char*)O + off + bj * HALF) = (u32x2){pk4_fp8(16.f * f[0], 16.f * f[1], 16.f * f[2], 16.f * f[3]), pk4_fp8(16.f * f[4], 16.f * f[5], 16.f * f[6], 16.f * f[7])}; }
                        else { u32x4 w; w.x = cvt_pk_bf16(f[0], f[1]); w.y = cvt_pk_bf16(f[2], f[3]); w.z = cvt_pk_bf16(f[4], f[5]); w.w = cvt_pk_bf16(f[6], f[7]);
                            *(u32x4*)(O + off + bj * HALF) = w; } }
                }
        } else if (mode == 0) {
            const float* bf = (const float*)base;
#pragma unroll
            for (int ai = 0; ai < 2; ++ai) {
                f32x4 bb[4][2][2];
#pragma unroll
                for (int m = 0; m < 4; ++m) { const size_t off = (size_t)(row0 + ai * HALF + m * 16) * ldc + col0;
#pragma unroll
                    for (int bj = 0; bj < 2; ++bj) { bb[m][bj][0] = *(const f32x4*)(bf + off + bj * HALF); bb[m][bj][1] = *(const f32x4*)(bf + off + bj * HALF + 4); } }
#pragma unroll
                for (int m = 0; m < 4; ++m) { const size_t off = (size_t)(row0 + ai * HALF + m * 16) * ldc + col0;
#pragma unroll
                    for (int bj = 0; bj < 2; ++bj) { const f32x4 lo = bb[m][bj][0] + acc[ai][bj][m][0], hi = bb[m][bj][1] + acc[ai][bj][m][1];
                        u32x4 w; w.x = cvt_pk_bf16(lo[0], lo[1]); w.y = cvt_pk_bf16(lo[2], lo[3]); w.z = cvt_pk_bf16(hi[0], hi[1]); w.w = cvt_pk_bf16(hi[2], hi[3]);
                        *(u32x4*)(C + off + bj * HALF) = w; } }
                asm volatile("" ::: "memory");
            }
        } else {
            const bf16* bb16 = (const bf16*)base;
#pragma unroll
            for (int ai = 0; ai < 2; ++ai) {
                u32x4 bw[4][2];
#pragma unroll
                for (int m = 0; m < 4; ++m) { const size_t off = (size_t)(row0 + ai * HALF + m * 16) * ldc + col0;
#pragma unroll
                    for (int bj = 0; bj < 2; ++bj) bw[m][bj] = *(const u32x4*)(bb16 + off + bj * HALF); }
#pragma unroll
                for (int m = 0; m < 4; ++m) { const size_t off = (size_t)(row0 + ai * HALF + m * 16) * ldc + col0;
#pragma unroll
                    for (int bj = 0; bj < 2; ++bj) { const u32x4 r = bw[m][bj]; const f32x4 a0 = acc[ai][bj][m][0], a1 = acc[ai][bj][m][1];
                        u32x4 w; w.x = cvt_pk_bf16(bflo(r.x) + a0[0], bfhi(r.x) + a0[1]); w.y = cvt_pk_bf16(bflo(r.y) + a0[2], bfhi(r.y) + a0[3]);
                        w.z = cvt_pk_bf16(bflo(r.z) + a1[0], bfhi(r.z) + a1[1]); w.w = cvt_pk_bf16(bflo(r.w) + a1[2], bfhi(r.w) + a1[3]);
                        *(u32x4*)(C + off + bj * HALF) = w; } }
                asm volatile("" ::: "memory");
            }
            {
                asm volatile("" ::: "memory");
            }
        }
    }
};
template <bool OUT8, bool INI8 = false> struct EpiSwiglu {
    static constexpr bool PERM = true;
    void* O; int ldc; const float* SA; const float* SW;
    const LAS float* st;
    __device__ __forceinline__ void operator()(const f32x4 (&acc)[2][2][4][2], const Unit& u, int wr, int wc, int fr, int fq) const {
        const int row0 = u.pm * BM + wr * 64 + fr, col0 = u.pn * HALF + wc * 32 + 8 * fq;
        float swg[8], swu[8];
        if constexpr (INI8) {
#pragma unroll
            for (int j = 0; j < 8; ++j) { swg[j] = st ? st[512 * u.kh + 256 + wc * 32 + 8 * fq + j] : SW[col0 + j]; swu[j] = st ? st[512 * u.kh + 384 + wc * 32 + 8 * fq + j] : SW[ldc + col0 + j]; } }
#pragma unroll
        for (int ai = 0; ai < 2; ++ai)
#pragma unroll
            for (int m = 0; m < 4; ++m) {
                float h[8]; float sa = 1.0f; if constexpr (INI8) sa = st ? st[512 * u.kh + wr * 64 + fr + ai * HALF + m * 16] : SA[row0 + ai * HALF + m * 16];
#pragma unroll
                for (int n = 0; n < 2; ++n)
#pragma unroll
                    for (int j = 0; j < 4; ++j) { float g = acc[ai][0][m][n][j], up = acc[ai][1][m][n][j];
                        if constexpr (INI8) { g = (float)__builtin_bit_cast(int, g) * (sa * swg[4 * n + j]); up = (float)__builtin_bit_cast(int, up) * (sa * swu[4 * n + j]); } h[n * 4 + j] = g * __builtin_amdgcn_rcpf(1.0f + __builtin_amdgcn_exp2f(-1.44269504f * g)) * up; }
                if constexpr (OUT8) { *(u32x2*)((unsigned char*)O + (size_t)(row0 + ai * HALF + m * 16) * ldc + col0) = (u32x2){pk4_fp8(h[0], h[1], h[2], h[3]), pk4_fp8(h[4], h[5], h[6], h[7])}; }
                else { u32x4 w; w.x = cvt_pk_bf16(h[0], h[1]); w.y = cvt_pk_bf16(h[2], h[3]); w.z = cvt_pk_bf16(h[4], h[5]); w.w = cvt_pk_bf16(h[6], h[7]);
                    *(u32x4*)((bf16*)O + (size_t)(row0 + ai * HALF + m * 16) * ldc + col0) = w; }
            }
    }
};

typedef int i32x4 __attribute__((ext_vector_type(4)));
typedef int i32x8 __attribute__((ext_vector_type(8)));
template <class Epi, class Sched, bool ALIGN_EPI, bool SP2, int KIND  , bool MIDK = false, bool KSPLIT = false, bool GA = false>
__device__ __forceinline__ void gemm_phase(LAS unsigned char* lds, const int tid, const Gemm g, const Sched& S, const Epi& E) {
    const int wid = __builtin_amdgcn_readfirstlane(tid >> 6), lane = tid & 63, wr = wid >> 2, wc = wid & 3, fr = lane & 15, fq = lane >> 4;
    const int K = g.Kb, nt = K / 128;
    unsigned voffA[2], voffB[2];
#pragma unroll
    for (int i = 0; i < 2; ++i) { int R, C; stage_rc(tid * 16 + i * 8192, R, C); const int Rb = Epi::PERM ? ((R & ~31) + perm32(R & 31)) : R;
        voffA[i] = (unsigned)(R * K + C * 2); voffB[i] = (unsigned)(Rb * K + C * 2); }
    int rA0 = 0; unsigned colA = 0; { int R, C; stage_rc(tid * 16, R, C); rA0 = R; colA = (unsigned)(C * 2); }
    unsigned gofC[2][2], gofN[2][2], gofX[2][2]; (void)gofC; (void)gofN; (void)gofX; (void)rA0; (void)colA;
    LAS unsigned* atab = (LAS unsigned*)(lds + RS_OFF);
    const size_t kstep = (size_t)(BK * 2);
    const size_t hstep = (size_t)HALF * K;
    const size_t tstep = 2 * hstep;
    const unsigned ldsw = (unsigned)wid * 1024u;
    const int aoff = lds_byte(wr * 64 + fr, fq * 8), boff = lds_byte(wc * 32 + fr, fq * 8);
#define PG8_SA(b, h) (((b) * 2 + (h)) * HTB)
#define PG8_SB(b, h) ((4 + (b) * 2 + (h)) * HTB)
#define PG8_STAGE(bufoff, gbase, voff) do { _Pragma("unroll") for (int _i = 0; _i < 2; ++_i) \
        __builtin_amdgcn_global_load_lds((const unsigned*)((const char*)(gbase) + (voff)[_i]), (LAS unsigned*)(lds + (bufoff) + ldsw + _i * 8192), 16, 0, 0); } while (0)
#define PG8_STAGE_A(b, h, base, offs) do { if constexpr (GA) { PG8_STAGE(PG8_SA(b, h), (base), (offs)[h]); } else { PG8_STAGE(PG8_SA(b, h), (base) + (h) * hstep, voffA); } } while (0)
#define PG8_LDA(dst, b, h) do { _Pragma("unroll") for (int m = 0; m < 4; ++m) _Pragma("unroll") for (int k = 0; k < 2; ++k) dst[m][k] = *(const LAS bf16x8*)(lds + PG8_SA(b, h) + aoff + m * 2048 + k * 1024); } while (0)
#define PG8_LDB(dst, b, h) do { _Pragma("unroll") for (int n = 0; n < 2; ++n) _Pragma("unroll") for (int k = 0; k < 2; ++k) dst[n][k] = *(const LAS bf16x8*)(lds + PG8_SB(b, h) + boff + n * 2048 + k * 1024); } while (0)
#define PG8_CAT(x) __builtin_shufflevector(__builtin_bit_cast(i32x4, (x)[0]), __builtin_bit_cast(i32x4, (x)[1]), 0, 1, 2, 3, 4, 5, 6, 7)
#define PG8_MMA(ai, bj, At, Bt) do { __builtin_amdgcn_s_setprio(1); _Pragma("unroll") for (int m = 0; m < 4; ++m) _Pragma("unroll") for (int n = 0; n < 2; ++n) { \
        if constexpr (KIND == 1) { const i32x8 bw_ = PG8_CAT(Bt[n]), aw_ = PG8_CAT(At[m]); \
            asm volatile("v_mfma_scale_f32_16x16x128_f8f6f4 %0, %1, %2, %0, %3, %4 op_sel_hi:[0,0,0]" : "+v"(acc[ai][bj][m][n]) : "v"(bw_), "v"(aw_), "v"(sc_w), "v"(sc_a)); } \
        else if constexpr (KIND == 2) { _Pragma("unroll") for (int k = 0; k < 2; ++k) acc[ai][bj][m][n] = __builtin_bit_cast(f32x4, __builtin_amdgcn_mfma_i32_16x16x64_i8( \
            __builtin_bit_cast(i32x4, Bt[n][k]), __builtin_bit_cast(i32x4, At[m][k]), __builtin_bit_cast(i32x4, acc[ai][bj][m][n]), 0, 0, 0)); } \
        else { _Pragma("unroll") for (int k = 0; k < 2; ++k) acc[ai][bj][m][n] = __builtin_amdgcn_mfma_f32_16x16x32_bf16(Bt[n][k], At[m][k], acc[ai][bj][m][n], 0, 0, 0); } } \
        __builtin_amdgcn_s_setprio(0); } while (0)
#define PG8_WAIT_V(n) asm volatile("s_waitcnt vmcnt(" #n ")" ::: "memory")
#define PG8_WAIT_L(n) asm volatile("s_waitcnt lgkmcnt(" #n ")" ::: "memory")
#define PG8_BAR __builtin_amdgcn_s_barrier()
#define PG8_SCHED __builtin_amdgcn_sched_barrier(0)
    Unit cur, nxt; int ui = 0;
    if (!S.next(0, cur)) return;
    const int sc_w = 0x79797979, sc_a = 0x7f7f7f7f; (void)sc_w; (void)sc_a;
    f32x4 acc[2][2][4][2];
#pragma unroll
    for (int a = 0; a < 2; ++a)
#pragma unroll
        for (int b = 0; b < 2; ++b)
#pragma unroll
            for (int m = 0; m < 4; ++m)
#pragma unroll
                for (int n = 0; n < 2; ++n) acc[a][b][m][n] = (f32x4){0.f, 0.f, 0.f, 0.f};
    bf16x8 At[4][2], B0[2][2], B1[2][2];
    const char* cA = (const char*)g.A + (GA ? (size_t)0 : (size_t)cur.pm * tstep); const char* cB = (const char*)g.Bt + (size_t)cur.pb * tstep;
    if constexpr (GA) {
        static_assert(SP2 && !KSPLIT && !MIDK, "gathered A: SP2 schedule only");
#pragma unroll
        for (int h = 0; h < 2; ++h)
#pragma unroll
            for (int i = 0; i < 2; ++i) { gofC[h][i] = g.arow[cur.pm * BM + h * HALF + rA0 + 64 * i] * (unsigned)K + colA; gofN[h][i] = gofC[h][i]; }
    }
    if constexpr (KSPLIT) { if ((cur.kh & 3) == 2) { cA += (size_t)(nt / 2) * kstep; cB += (size_t)(nt / 2) * kstep; } }
    { typename Sched::Pre pre0; S.a_issue(cur, pre0); S.a_finish(cur, 0, pre0); }
    if constexpr (SP2) {
        PG8_STAGE(PG8_SB(0, 0), cB, voffB); PG8_STAGE(PG8_SB(0, 1), cB + hstep, voffB); PG8_STAGE_A(0, 0, cA, gofC); PG8_STAGE_A(0, 1, cA, gofC);
        if (wr == 1) PG8_BAR;
        PG8_WAIT_V(2); PG8_BAR;
        PG8_STAGE(PG8_SB(1, 0), cB + kstep, voffB); PG8_STAGE_A(1, 0, cA + kstep, gofC); PG8_STAGE(PG8_SB(1, 1), cB + hstep + kstep, voffB);
        PG8_WAIT_V(6); PG8_BAR;
    } else {
        PG8_STAGE(PG8_SB(0, 0), cB, voffB); PG8_STAGE(PG8_SA(0, 0), cA, voffA); PG8_STAGE(PG8_SB(0, 1), cB + hstep, voffB); PG8_STAGE(PG8_SA(0, 1), cA + hstep, voffA);
        if (wr == 1) PG8_BAR;
        PG8_WAIT_V(4); PG8_BAR;
        PG8_STAGE(PG8_SB(1, 0), cB + kstep, voffB); PG8_STAGE(PG8_SA(1, 0), cA + kstep, voffA); PG8_STAGE(PG8_SB(1, 1), cB + hstep + kstep, voffB);
        PG8_WAIT_V(6); PG8_BAR;
    }
    for (;;) {
        const bool has_next = S.next(ui + 1, nxt);
        const char* nA = (has_next && !GA) ? (const char*)g.A + (size_t)nxt.pm * tstep : cA; const char* nB = has_next ? (const char*)g.Bt + (size_t)nxt.pb * tstep : cB;
        if constexpr (GA) { if (has_next && wid == 0)
            __builtin_amdgcn_global_load_lds(g.arow + (size_t)nxt.pm * BM + lane * 4, atab + ((ui + 1) & 1) * BM, 16, 0, 0); }
        int unt = nt;
        if constexpr (KSPLIT) { if (has_next && (nxt.kh & 3) == 2) { nA += (size_t)(nt / 2) * kstep; nB += (size_t)(nt / 2) * kstep; } if (cur.kh & 3) unt = nt / 2; }
        for (int t = 0; t < unt; t += 2) {
            const bool last = (t == unt - 2);
            const char* a1 = cA + (size_t)(t + 1) * kstep;
            const char* a2 = last ? nA : cA + (size_t)(t + 2) * kstep; const char* b2 = last ? nB : cB + (size_t)(t + 2) * kstep;
            const char* a3 = a2 + kstep; const char* b3 = b2 + kstep;
            if constexpr (GA) {
                if (t == 2 && has_next) {
#pragma unroll
                    for (int h = 0; h < 2; ++h)
#pragma unroll
                        for (int i = 0; i < 2; ++i) gofN[h][i] = atab[((ui + 1) & 1) * BM + h * HALF + rA0 + 64 * i] * (unsigned)K + colA; }
#pragma unroll
                for (int h = 0; h < 2; ++h)
#pragma unroll
                    for (int i = 0; i < 2; ++i) gofX[h][i] = last ? gofN[h][i] : gofC[h][i];
            }
            if constexpr (MIDK) { if (t == nt / 2) {
                const LAS float* rs = (const LAS float*)(lds + RS_OFF);
#pragma unroll
                for (int ai = 0; ai < 2; ++ai)
#pragma unroll
                    for (int m = 0; m < 4; ++m) { const float sc = rs_scale(rs, ui & 1, ai * HALF + wr * 64 + m * 16 + fr, 1.0f / D_RNN);
#pragma unroll
                        for (int bj = 0; bj < 2; ++bj)
#pragma unroll
                            for (int n = 0; n < 2; ++n) acc[ai][bj][m][n] = acc[ai][bj][m][n] * sc; } } }
            if constexpr (SP2) {
            PG8_LDB(B0, 0, 0); PG8_LDB(B1, 0, 1); PG8_SCHED; PG8_LDA(At, 0, 0); PG8_STAGE_A(1, 1, a1, gofC);
            PG8_WAIT_V(8); PG8_WAIT_L(0); PG8_BAR; PG8_MMA(0, 0, At, B0); PG8_MMA(0, 1, At, B1); PG8_BAR; PG8_SCHED;
            PG8_LDA(At, 0, 1); PG8_STAGE(PG8_SB(0, 0), b2, voffB); PG8_STAGE(PG8_SB(0, 1), b2 + hstep, voffB); PG8_STAGE_A(0, 0, a2, gofX);
            PG8_WAIT_V(8); PG8_WAIT_L(0); PG8_BAR; PG8_MMA(1, 0, At, B0); PG8_MMA(1, 1, At, B1); PG8_BAR; PG8_SCHED;
            PG8_LDB(B0, 1, 0); PG8_LDB(B1, 1, 1); PG8_SCHED; PG8_LDA(At, 1, 0); PG8_STAGE_A(0, 1, a2, gofX);
            PG8_WAIT_V(8); PG8_WAIT_L(0); PG8_BAR; PG8_MMA(0, 0, At, B0); PG8_MMA(0, 1, At, B1); PG8_BAR; PG8_SCHED;
            PG8_LDA(At, 1, 1); PG8_STAGE(PG8_SB(1, 0), b3, voffB); PG8_STAGE(PG8_SB(1, 1), b3 + hstep, voffB); PG8_STAGE_A(1, 0, a3, gofX);
            PG8_WAIT_V(8); PG8_WAIT_L(0); PG8_BAR; PG8_MMA(1, 0, At, B0); PG8_MMA(1, 1, At, B1); PG8_BAR; PG8_SCHED;
            } else {
            PG8_LDB(B0, 0, 0); PG8_SCHED; PG8_LDA(At, 0, 0); PG8_STAGE(PG8_SA(1, 1), a1 + hstep, voffA);
            PG8_WAIT_L(8); PG8_BAR; PG8_WAIT_L(0); PG8_MMA(0, 0, At, B0); PG8_BAR; PG8_SCHED;
            PG8_LDB(B1, 0, 1); PG8_STAGE(PG8_SB(0, 0), b2, voffB);
            PG8_BAR; PG8_WAIT_L(0); PG8_MMA(0, 1, At, B1); PG8_BAR;
            PG8_LDA(At, 0, 1); PG8_STAGE(PG8_SA(0, 0), a2, voffA);
            PG8_BAR; PG8_WAIT_L(0); PG8_MMA(1, 0, At, B0); PG8_BAR; PG8_SCHED;
            PG8_STAGE(PG8_SB(0, 1), b2 + hstep, voffB);
            PG8_WAIT_V(6); PG8_BAR; PG8_MMA(1, 1, At, B1); PG8_BAR;
            PG8_LDB(B0, 1, 0); PG8_SCHED; PG8_LDA(At, 1, 0); PG8_STAGE(PG8_SA(0, 1), a2 + hstep, voffA);
            PG8_WAIT_L(8); PG8_BAR; PG8_WAIT_L(0); PG8_MMA(0, 0, At, B0); PG8_BAR; PG8_SCHED;
            PG8_LDB(B1, 1, 1); PG8_STAGE(PG8_SB(1, 0), b3, voffB);
            PG8_BAR; PG8_WAIT_L(0); PG8_MMA(0, 1, At, B1); PG8_BAR;
            PG8_LDA(At, 1, 1); PG8_STAGE(PG8_SA(1, 0), a3, voffA);
            PG8_BAR; PG8_WAIT_L(0); PG8_MMA(1, 0, At, B0); PG8_BAR; PG8_SCHED;
            PG8_STAGE(PG8_SB(1, 1), b3 + hstep, voffB);
            PG8_WAIT_V(6); PG8_BAR; PG8_MMA(1, 1, At, B1); PG8_BAR;
            }
        }
        if constexpr (ALIGN_EPI) { if (wr == 0) PG8_BAR; }
        if constexpr (KIND == 1) asm volatile("s_nop 15\n\ts_nop 15" ::: "memory");
        typename Sched::Pre pre; if (has_next) S.a_issue(nxt, pre);
        E(acc, cur, wr, wc, fr, fq); S.done(cur);
        if (has_next) S.a_finish(nxt, (ui + 1) & 1, pre);
        if (!has_next) break;
#pragma unroll
        for (int a = 0; a < 2; ++a)
#pragma unroll
            for (int b = 0; b < 2; ++b)
#pragma unroll
                for (int m = 0; m < 4; ++m)
#pragma unroll
                    for (int n = 0; n < 2; ++n) acc[a][b][m][n] = (f32x4){0.f, 0.f, 0.f, 0.f};
        cur = nxt; cA = nA; cB = nB; ++ui;
        if constexpr (GA) {
#pragma unroll
            for (int h = 0; h < 2; ++h)
#pragma unroll
                for (int i = 0; i < 2; ++i) gofC[h][i] = gofN[h][i]; }
        if constexpr (ALIGN_EPI) { if (wr == 1) PG8_BAR; }
    }
    PG8_WAIT_V(0);
    if constexpr (!ALIGN_EPI) { if (wr == 0) PG8_BAR; }
    PG8_BAR;
#undef PG8_SA
#undef PG8_SB
#undef PG8_STAGE
#undef PG8_LDA
#undef PG8_STAGE_A
#undef PG8_LDB
#undef PG8_MMA
#undef PG8_CAT
#undef PG8_WAIT_V
#undef PG8_WAIT_L
#undef PG8_BAR
#undef PG8_SCHED
}
}

#define XB_TMO      128
#define XB_XCNT(j)  (256  + 64 * (j))
#define XB_XSUB(j)  (1280 + 64 * (j))
#define XB_XGEN(j)  (2304 + 64 * (j))
#define XB_TOP      3328
#define XB_TOPGEN   3392
#define XCD_BAR_WORDS 3456
#define XB_SPIN_CAP (1u << 18)
__device__ __forceinline__ unsigned xb_ld(unsigned* p)              { return __hip_atomic_load(p, __ATOMIC_RELAXED, __HIP_MEMORY_SCOPE_AGENT); }
__device__ __forceinline__ unsigned xb_add(unsigned* p, unsigned v) { return __hip_atomic_fetch_add(p, v, __ATOMIC_RELAXED, __HIP_MEMORY_SCOPE_AGENT); }
__device__ __forceinline__ unsigned xb_xcc_id() { return (unsigned)__builtin_amdgcn_s_getreg((3 << 11) | 20) & 0xFu; }
#define XB_SPIN(cond, bar) do { unsigned _sp = 0; while (cond) { __builtin_amdgcn_s_sleep(1); \
    if ((++_sp & 255u) == 0u) { if (xb_ld(&(bar)[XB_TMO])) break; if (_sp > XB_SPIN_CAP) { atomicAdd(&(bar)[XB_TMO], 1u); break; } } } } while (0)
struct XcdBarrier { unsigned* bar; unsigned x; volatile LAS unsigned* st; };
__device__ __forceinline__ XcdBarrier xcd_barrier_post(unsigned* bar, volatile LAS unsigned* st) {
    XcdBarrier b; b.bar = bar; b.x = xb_xcc_id(); b.st = st;
    if (threadIdx.x == 0) (void)xb_add(&bar[XB_XCNT(b.x)], 1u);
    return b;
}
__device__ __forceinline__ void xcd_barrier_complete(unsigned* bar, unsigned x, unsigned& nloc, unsigned& nx) {
    const unsigned G = gridDim.x * gridDim.y * gridDim.z;
    unsigned sum, cnt, mine, sp = 0u;
    for (;;) {
        sum = 0u; cnt = 0u; mine = 0u;
#pragma unroll
        for (unsigned j = 0; j < 16; ++j) { const unsigned c = xb_ld(&bar[XB_XCNT(j)]); sum += c; cnt += (c > 0u) ? 1u : 0u; mine = (j == x) ? c : mine; }
        if (sum == G) break;
        __builtin_amdgcn_s_sleep(1);
        if ((++sp & 255u) == 0u) { if (xb_ld(&bar[XB_TMO])) break; if (sp > XB_SPIN_CAP) { atomicAdd(&bar[XB_TMO], 1u); break; } }
    }
    nloc = mine > 0u ? mine : 1u; nx = cnt > 0u ? cnt : 1u;
}
__device__ __forceinline__ void xcd_barrier(const XcdBarrier& b) {
    asm volatile("s_waitcnt vmcnt(0)" ::: "memory");
    __syncthreads();
    if (threadIdx.x == 0) {
        unsigned* bar = b.bar;
        __builtin_amdgcn_s_waitcnt(0);
        unsigned nloc = b.st[0], nx = b.st[1];
        if (nloc == 0u) { xcd_barrier_complete(bar, b.x, nloc, nx); b.st[0] = nloc; b.st[1] = nx; }
        const unsigned old = xb_add(&bar[XB_XSUB(b.x)], 1u);
        const unsigned gen = old / nloc;
        if (old + 1u == (gen + 1u) * nloc) {
            __builtin_amdgcn_fence(__ATOMIC_RELEASE, "agent");
            asm volatile("s_waitcnt vmcnt(0)" ::: "memory");
            const unsigned og = xb_add(&bar[XB_TOP], 1u);
            const unsigned tg = og / nx;
            if (og + 1u == (tg + 1u) * nx) xb_add(&bar[XB_TOPGEN], 1u);
            else XB_SPIN(xb_ld(&bar[XB_TOPGEN]) == tg, bar);
            __builtin_amdgcn_fence(__ATOMIC_ACQUIRE, "agent");
            xb_add(&bar[XB_XGEN(b.x)], 1u);
            asm volatile("s_waitcnt vmcnt(0)" ::: "memory");
        } else {
            XB_SPIN(xb_ld(&bar[XB_XGEN(b.x)]) == gen, bar);
            __builtin_amdgcn_fence(__ATOMIC_ACQUIRE, "agent");
            asm volatile("s_waitcnt vmcnt(0)" ::: "memory");
        }
    }
    __syncthreads();
}

__device__ __forceinline__ void p0_transpose_item(const float* W, int K, int N, bf16* WT, int kb, int nb, int drow0, LAS float* scr, int lane) {
    const int k0 = 64 * kb, n0 = 32 * nb;
#pragma unroll 8
    for (int i = 0; i < 32; ++i) { const int kk = 2 * i + (lane >> 5); scr[kk * 33 + (lane & 31)] = W[(size_t)(k0 + kk) * N + n0 + (lane & 31)]; }
    asm volatile("s_waitcnt lgkmcnt(0)" ::: "memory");
    const int c = lane & 7;
#pragma unroll
    for (int j = 0; j < 4; ++j) { const int n = (lane >> 3) + 8 * j; const LAS float* s = scr + (8 * c) * 33 + n;
        u32x4 o; o.x = pk2(s[0 * 33], s[1 * 33]); o.y = pk2(s[2 * 33], s[3 * 33]); o.z = pk2(s[4 * 33], s[5 * 33]); o.w = pk2(s[6 * 33], s[7 * 33]);
        *(u32x4*)(WT + (size_t)(drow0 + n) * K + k0 + 8 * c) = o; }
    asm volatile("s_waitcnt lgkmcnt(0)" ::: "memory");
}

__device__ __forceinline__ void p0_transpose_item_fp8(const float* W, int K, int N, unsigned char* WT, int kb, int nb, int drow0, LAS float* scr, int lane) {
    const int k0 = 64 * kb, n0 = 32 * nb;
#pragma unroll 8
    for (int i = 0; i < 32; ++i) { const int kk = 2 * i + (lane >> 5); scr[kk * 33 + (lane & 31)] = W[(size_t)(k0 + kk) * N + n0 + (lane & 31)]; }
    asm volatile("s_waitcnt lgkmcnt(0)" ::: "memory");
    const int c = lane & 3;
#pragma unroll
    for (int j = 0; j < 2; ++j) { const int n = (lane >> 2) + 16 * j; const LAS float* s = scr + (16 * c) * 33 + n;
        u32x4 o; o.x = pg8::pk4_fp8(64.f * s[0 * 33], 64.f * s[1 * 33], 64.f * s[2 * 33], 64.f * s[3 * 33]); o.y = pg8::pk4_fp8(64.f * s[4 * 33], 64.f * s[5 * 33], 64.f * s[6 * 33], 64.f * s[7 * 33]);
        o.z = pg8::pk4_fp8(64.f * s[8 * 33], 64.f * s[9 * 33], 64.f * s[10 * 33], 64.f * s[11 * 33]); o.w = pg8::pk4_fp8(64.f * s[12 * 33], 64.f * s[13 * 33], 64.f * s[14 * 33], 64.f * s[15 * 33]);
        *(u32x4*)(WT + (size_t)(drow0 + n) * K + k0 + 16 * c) = o; }
    asm volatile("s_waitcnt lgkmcnt(0)" ::: "memory");
}

__device__ __forceinline__ const float* inp(int i) {
    int off = i * 8; asm volatile("" : "+s"(off));
    const __attribute__((address_space(4))) char* ka = (const __attribute__((address_space(4))) char*)__builtin_amdgcn_kernarg_segment_ptr();
    return *(const float* const __attribute__((address_space(4)))*)(ka + off);
}

struct Ctx {
    LAS unsigned char* lds; LAS unsigned* lctl;
    int tid, lane, wave, vcu, G;
    float* out; unsigned char* ws;
};

__device__ __forceinline__ Ctx fresh(const Ctx& F) { Ctx R = F; int ln, wv = F.wave; asm volatile("v_mbcnt_lo_u32_b32 %0, -1, 0\n\tv_mbcnt_hi_u32_b32 %0, -1, %0" : "=v"(ln)); asm volatile("" : "+s"(wv));
    R.lane = ln; R.wave = wv; R.tid = wv * 64 + ln; return R; }

constexpr int I_IN = (D / 64) * (D_IN / 64), I_OUT = (D / 64) * (D / 64), I_GU = (D / 64) * (D_FF / 64), I_DN = (D_FF / 64) * (D / 64), I_LRU = 2 * 2;
constexpr int E0 = 2 * I_IN, E1 = E0 + 2 * I_OUT, E2 = E1 + I_GU, E3 = E2 + I_GU, E4 = E3 + I_DN, E5 = E4 + NE * I_GU, E6 = E5 + NE * I_GU, E7 = E6 + NE * I_DN, E8 = E7 + 32 * I_LRU;
struct CvDesc { const f32x4* src; unsigned char* dst; int N4, K, fp8; };
__device__ __forceinline__ CvDesc cv_desc(const Ctx& F, const float* const* in, int it) {
    const int n4 = F.lane & 15, kq = F.lane >> 4;
    const float* W; unsigned char* WT; int K, N, kb, nb, gu = 0, fp8 = 0;
    if (it < E0) { const int l = it / I_IN, r = it % I_IN, nblk = D_IN / 64; kb = r / nblk; nb = r % nblk; W = inp(2) + (size_t)l * D * D_IN; K = D; N = D_IN; WT = F.ws + WS_WIN + (size_t)l * D_IN * D * 2; }
    else if (it < E1) { const int q = it - E0, l = q / I_OUT, r = q % I_OUT, nblk = D / 64; kb = r / nblk; nb = r % nblk; W = inp(12) + (size_t)l * D * D; K = D; N = D; WT = F.ws + WS_WOUT + (size_t)l * D * D * 2; }
    else if (it < E3) { const int q = it - E1, up = q / I_GU, r = q % I_GU, nblk = D_FF / 64; kb = r / nblk; nb = r % nblk; W = up ? inp(15) : inp(14); K = D; N = D_FF; WT = F.ws + WS_WGU_D; gu = 1 + up; }
    else if (it < E4) { const int r = it - E3, nblk = D / 32; kb = r / nblk; nb = r % nblk; W = inp(16); K = D_FF; N = D; WT = F.ws + WS_WDN_D; fp8 = 1; }
    else if (it < E6) { const int q = it - E4, up = q / (NE * I_GU), q2 = q % (NE * I_GU), e = q2 / I_GU, r = q2 % I_GU, nblk = D_FF / 32; kb = r / nblk; nb = r % nblk;
        W = (up ? inp(19) : inp(18)) + (size_t)e * D * D_FF; K = D; N = D_FF; WT = F.ws + WS_WGU_M + (size_t)e * 2 * D_FF * D; gu = 1 + up; fp8 = 1; }
    else if (it < E7) { const int q = it - E6, e = q / I_DN, r = q % I_DN, nblk = D / 32; kb = r / nblk; nb = r % nblk; W = inp(20) + (size_t)e * D_FF * D; K = D_FF; N = D; WT = F.ws + WS_WDN_M + (size_t)e * D * D_FF; fp8 = 1; }
    else { const int q = it - E7, mi = q / I_LRU, r = q % I_LRU; kb = r / 2; nb = r % 2;
        const int mat = (mi / 8) & 1, n = mi & 7, l = mi / 16; W = (mat ? inp(7) : inp(5)) + (size_t)(l * 8 + n) * 16384; K = 128; N = 128; WT = F.ws + WS_WLRU + (size_t)mi * 16384 * 2; }
    const int k0 = fp8 ? 128 * kb + 16 * (F.lane >> 3) : 64 * kb + 16 * kq, nn = fp8 ? 32 * nb + 4 * (F.lane & 7) : 64 * nb + 4 * n4;
    const int drow = gu ? ((nn >> 7) * 256 + (nn & 127) + (gu - 1) * 128) : nn;
    CvDesc d; d.src = (const f32x4*)(W + (size_t)k0 * N + nn); d.N4 = N / 4; d.K = K; d.fp8 = fp8; d.dst = WT + ((size_t)drow * K + k0) * (fp8 ? 1 : 2); return d;
}
__device__ __forceinline__ void cv_load(const CvDesc& d, f32x4 (&x)[16]) {
#pragma unroll
    for (int j = 0; j < 16; ++j) x[j] = d.src[(size_t)j * d.N4];
}
__device__ __forceinline__ void cv_store(const CvDesc& d, const f32x4 (&x)[16]) {
    if (d.fp8) {
#pragma unroll
        for (int c = 0; c < 4; ++c) { u32x4 o;
            o.x = pg8::pk4_fp8(64.f * x[0][c], 64.f * x[1][c], 64.f * x[2][c], 64.f * x[3][c]); o.y = pg8::pk4_fp8(64.f * x[4][c], 64.f * x[5][c], 64.f * x[6][c], 64.f * x[7][c]);
            o.z = pg8::pk4_fp8(64.f * x[8][c], 64.f * x[9][c], 64.f * x[10][c], 64.f * x[11][c]); o.w = pg8::pk4_fp8(64.f * x[12][c], 64.f * x[13][c], 64.f * x[14][c], 64.f * x[15][c]);
            *(u32x4*)(d.dst + (size_t)c * d.K) = o; }
    } else {
#pragma unroll
        for (int c = 0; c < 4; ++c) { u32x4 o0, o1;
            o0.x = pk2(x[0][c], x[1][c]); o0.y = pk2(x[2][c], x[3][c]); o0.z = pk2(x[4][c], x[5][c]); o0.w = pk2(x[6][c], x[7][c]);
            o1.x = pk2(x[8][c], x[9][c]); o1.y = pk2(x[10][c], x[11][c]); o1.z = pk2(x[12][c], x[13][c]); o1.w = pk2(x[14][c], x[15][c]);
            u32x4* dst = (u32x4*)(d.dst + (size_t)c * d.K * 2); dst[0] = o0; dst[1] = o1; }
    }
}
__device__ __forceinline__ void convert_items(const Ctx& F, const float* const* in, int lo, int hi, int w0, int nw) {
    int it = lo + w0; if (it >= hi) return;
    CvDesc cur = cv_desc(F, in, it); f32x4 x[16]; cv_load(cur, x);
    for (;;) {
        const int nx = it + nw; const bool more = nx < hi;
        CvDesc nxt = cur; f32x4 y[16];
        if (more) { nxt = cv_desc(F, in, nx); cv_load(nxt, y); }
        cv_store(cur, x);
        if (!more) break;
#pragma unroll
        for (int j = 0; j < 16; ++j) x[j] = y[j];
        cur = nxt; it = nx;
    }
}
__device__ __forceinline__ void w_quant_item(const Ctx& F, const float* W, int N, int nb, float* SW, unsigned char* WT, int gu) {
    const int n4 = F.lane & 7, nn = 32 * nb + 4 * n4, k0 = 256 * F.wave + 32 * (F.lane >> 3);
    const f32x4* src = (const f32x4*)(W + (size_t)k0 * N + nn);
    f32x4 x[32];
#pragma unroll
    for (int j = 0; j < 32; ++j) x[j] = src[(size_t)j * (N / 4)];
    f32x4 mx = (f32x4){0.f, 0.f, 0.f, 0.f};
#pragma unroll
    for (int j = 0; j < 32; ++j) mx = __builtin_elementwise_max(mx, __builtin_elementwise_abs(x[j]));
#pragma unroll
    for (int c = 0; c < 4; ++c) { float v = mx[c]; v = fmaxf(v, shfl_idx(v, F.lane ^ 8)); v = fmaxf(v, shfl_idx(v, F.lane ^ 16)); v = fmaxf(v, shfl_idx(v, F.lane ^ 32)); mx[c] = v; }
    LAS f32x4* cmx = (LAS f32x4*)F.lds;
    if ((F.lane >> 3) == 0) cmx[F.wave * 8 + n4] = mx;
    __syncthreads();
    f32x4 m = cmx[n4];
#pragma unroll
    for (int w = 1; w < 8; ++w) m = __builtin_elementwise_max(m, cmx[w * 8 + n4]);
    __syncthreads();
    const int drow = gu ? ((nn >> 7) * 256 + (nn & 127) + (gu - 1) * 128) : nn;
#pragma unroll
    for (int c = 0; c < 4; ++c) { const float cm = fmaxf(m[c], 1e-30f), inv = 127.0f / cm; unsigned w[8];
#pragma unroll
        for (int q = 0; q < 8; ++q) { unsigned pk = 0;
#pragma unroll
            for (int b = 0; b < 4; ++b) { const int v = (int)rintf(x[4 * q + b][c] * inv); pk |= ((unsigned)v & 0xffu) << (8 * b); }
            w[q] = pk; }
        u32x4* dst = (u32x4*)(WT + (size_t)(drow + c) * D + k0);
        dst[0] = (u32x4){w[0], w[1], w[2], w[3]}; dst[1] = (u32x4){w[4], w[5], w[6], w[7]};
        if (F.wave == 0 && (F.lane >> 3) == 0) SW[nn + c] = cm * (1.0f / 127.0f); }
}
constexpr int QI_GU = D_FF / 32, QI_IN = D_IN / 32, QI_ALL = 2 * QI_GU + 2 * QI_IN;
__device__ __forceinline__ void i8_quantize_items(const Ctx& F, int first, int count, int c, int G) {
    float* SW = (float*)(F.ws + WS_SW);
    for (int it = first + c; it < first + count; it += G) {
        if (it < 2 * QI_GU) { const int up = it >= QI_GU, nb = it - up * QI_GU; w_quant_item(F, up ? inp(15) : inp(14), D_FF, nb, SW + up * D_FF, F.ws + WS_WGU_D, 1 + up); }
        else { const int q = it - 2 * QI_GU, l = q >= QI_IN, nb = q - l * QI_IN; w_quant_item(F, inp(2) + (size_t)l * D * D_IN, D_IN, nb, SW + 2 * D_FF + l * D_IN, F.ws + WS_WIN + (size_t)l * D_IN * D, 0); }
    }
}
__device__ __forceinline__ void p0_convert(const Ctx& F, const float* const* in, int c, int G) {
    i8_quantize_items(F, 0, 2 * QI_GU, c, G); i8_quantize_items(F, 2 * QI_GU + QI_IN, QI_IN, c, G);
    const int gw = c * 8 + F.wave, NGW = G * 8;
    convert_items(F, in, E0, E1, gw, NGW); convert_items(F, in, E3, E8, gw, NGW);
}
__device__ __forceinline__ void p0_prologue(const Ctx& F) {
    i8_quantize_items(F, 2 * QI_GU, QI_IN, F.vcu, F.G);
    f32x2* ROPE = (f32x2*)(F.ws + WS_ROPE);
    for (int i = (F.vcu * 512 + F.tid); i < SEQ * 32; i += F.G * 512) {
        const int s = i >> 5, j = i & 31;
        const float invf = exp2f(-(float)j * (13.287712379549449f / 32.0f));
        const float ang = (float)s * invf;
        const float nrev = rintf(ang * 0.15915494309189535f);
        float r = fmaf(-nrev, 6.28125f, ang); r = fmaf(-nrev, 0.0019353071795864769f, r);
        ROPE[i] = (f32x2){cosf(r), sinf(r)};
    }
}

template <bool BF> struct XSel;
template <> struct XSel<false> { typedef f32x4 type;
    static __device__ __forceinline__ f32x4 load(const void* X, size_t row, int i) { return ((const f32x4*)((const float*)X + row * D))[i]; }
    static __device__ __forceinline__ f32x4 cvt(f32x4 v) { return v; } };
template <> struct XSel<true> { typedef u32x2 type;
    static __device__ __forceinline__ u32x2 load(const void* X, size_t row, int i) { return ((const u32x2*)((const bf16*)X + row * D))[i]; }
    static __device__ __forceinline__ f32x4 cvt(u32x2 w) { return (f32x4){bflo(w.x), bfhi(w.x), bflo(w.y), bfhi(w.y)}; } };
template <bool ROUTE, bool OUTI8 = false, bool XBF = false>
__device__ __forceinline__ void norm_phase(const Ctx& F, const void* Xv, const float* gain, bf16* H, const float* router) {
    const float* X = (const float*)Xv; const bf16* Xb = (const bf16*)Xv; (void)X; (void)Xb;
    const int gw = F.vcu * 8 + F.wave, NGW = F.G * 8;
    f32x4 gv[8];
#pragma unroll
    for (int j = 0; j < 8; ++j) gv[j] = ((const f32x4*)gain)[F.lane + 64 * j];
    LAS float* RT = (LAS float*)F.lds;
    LAS unsigned* lst = (LAS unsigned*)(F.lds + 65536);
    unsigned* TOPE = (unsigned*)(F.ws + WS_ROUTE + RT_TOPE); float* TOPG = (float*)(F.ws + WS_ROUTE + RT_TOPG);
    unsigned* TOPR = (unsigned*)(F.ws + WS_ROUTE + RT_TOPR); unsigned* CNTB = (unsigned*)(F.ws + WS_ROUTE + RT_CNTB);
    if (ROUTE) {
        for (int i = F.tid; i < D * NE; i += 512) { const int c = i >> 3, e = i & 7; RT[e * D + c] = router[i]; }
        __syncthreads();
    }
    int it = 0;
    typedef typename XSel<XBF>::type xrow_t;
    xrow_t vv[8];
    if (gw < T) {
#pragma unroll
        for (int j = 0; j < 8; ++j) vv[j] = XSel<XBF>::load(Xv, (size_t)gw, F.lane + 64 * j); }
    for (int m = gw; m < T; m += NGW, ++it) {
        xrow_t vn[8];
        if (m + NGW < T) {
#pragma unroll
            for (int j = 0; j < 8; ++j) vn[j] = XSel<XBF>::load(Xv, (size_t)(m + NGW), F.lane + 64 * j); }
        else {
#pragma unroll
            for (int j = 0; j < 8; ++j) vn[j] = vv[j]; }
        f32x4 v[8];
#pragma unroll
        for (int j = 0; j < 8; ++j) v[j] = XSel<XBF>::cvt(vv[j]);
        float ss = 0.f;
#pragma unroll
        for (int j = 0; j < 8; ++j) ss += (v[j].x * v[j].x + v[j].y * v[j].y) + (v[j].z * v[j].z + v[j].w * v[j].w);
        ss = wave_sum(ss, F.lane);
        const float rstd = 1.0f / sqrtf(ss * (1.0f / D) + EPS);
        if (OUTI8) {
            float mx = 0.f;
#pragma unroll
            for (int j = 0; j < 8; ++j) { v[j] = v[j] * rstd * gv[j]; mx = fmaxf(mx, fmaxf(fmaxf(fabsf(v[j].x), fabsf(v[j].y)), fmaxf(fabsf(v[j].z), fabsf(v[j].w)))); }
#pragma unroll
            for (int o = 1; o < 64; o <<= 1) mx = fmaxf(mx, shfl_x(mx, o, F.lane));
            mx = fmaxf(mx, 1e-30f); const float inv = 127.0f / mx;
            if (F.lane == 0) ((float*)(F.ws + WS_SA))[m] = mx * (1.0f / 127.0f);
            unsigned* o4 = (unsigned*)((unsigned char*)H + (size_t)m * D) + F.lane;
#pragma unroll
            for (int j = 0; j < 8; ++j) { const int a = (int)rintf(v[j].x * inv), b2 = (int)rintf(v[j].y * inv), c = (int)rintf(v[j].z * inv), d = (int)rintf(v[j].w * inv);
                st_wt(o4 + 64 * j, ((unsigned)a & 0xffu) | (((unsigned)b2 & 0xffu) << 8) | (((unsigned)c & 0xffu) << 16) | (((unsigned)d & 0xffu) << 24)); }
        } else if (ROUTE) {
            unsigned* o4 = (unsigned*)((unsigned char*)H + (size_t)m * D) + F.lane;
#pragma unroll
            for (int j = 0; j < 8; ++j) { v[j] = v[j] * rstd * gv[j]; st_wt(o4 + 64 * j, pg8::pk4_fp8(v[j].x, v[j].y, v[j].z, v[j].w)); }
        } else {
            u32x2* o8 = (u32x2*)(H + (size_t)m * D) + F.lane;
#pragma unroll
            for (int j = 0; j < 8; ++j) { v[j] = v[j] * rstd * gv[j]; o8[64 * j] = (u32x2){pk2(v[j].x, v[j].y), pk2(v[j].z, v[j].w)}; }
        }
        if (ROUTE) {
            float lg[8];
#pragma unroll
            for (int e = 0; e < 8; ++e) { float a = 0.f;
#pragma unroll
                for (int j = 0; j < 8; ++j) { const f32x4 r = ((const LAS f32x4*)(RT + e * D))[F.lane + 64 * j]; a += (v[j].x * r.x + v[j].y * r.y) + (v[j].z * r.z + v[j].w * r.w); }
                lg[e] = wave_sum(a, F.lane); }
            float v1 = -3.0e38f, v2 = -3.0e38f; int e1 = 0, e2 = 0;
#pragma unroll
            for (int e = 0; e < 8; ++e) { const float x = lg[e]; if (x > v1) { v2 = v1; e2 = e1; v1 = x; e1 = e; } else if (x > v2) { v2 = x; e2 = e; } }
            const float g2 = 1.0f / (1.0f + expf(v1 - v2)), g1 = 1.0f - g2;
            if (F.lane == 0) { TOPE[m] = (unsigned)e1 | ((unsigned)e2 << 8); TOPG[2 * m] = g1; TOPG[2 * m + 1] = g2; lst[it * 8 + F.wave] = (unsigned)e1 | ((unsigned)e2 << 8); }
        }
#pragma unroll
        for (int j = 0; j < 8; ++j) vv[j] = vn[j];
    }
    if (ROUTE) {
        __syncthreads();
        if (F.tid < NE) {
            const unsigned e = F.tid; unsigned cnt = 0;
            const int niter = (T + NGW - 1) / NGW;
            for (int i = 0; i < niter; ++i)
                for (int w = 0; w < 8; ++w) { const int m = F.vcu * 8 + w + i * NGW; if (m < T) { const unsigned ent = lst[i * 8 + w];
                    if ((ent & 0xffu) == e) TOPR[2 * m] = cnt++;
                    if (((ent >> 8) & 0xffu) == e) TOPR[2 * m + 1] = cnt++; } }
            CNTB[F.vcu * 8 + e] = cnt;
        }
    }
}

__device__ __forceinline__ void moe_tables(const Ctx& F) {
    const unsigned* CNTB = (const unsigned*)(F.ws + WS_ROUTE + RT_CNTB);
    {
        const int e = F.wave; unsigned tot = 0, pre = 0;
        for (int b = F.lane; b < F.G; b += 64) { const unsigned c = CNTB[b * 8 + e]; tot += c; pre += (b < F.vcu) ? c : 0u; }
#pragma unroll
        for (int o = 1; o < 64; o <<= 1) { tot += shfl_u(tot, F.lane ^ o); pre += shfl_u(pre, F.lane ^ o); }
        if (F.lane == 0) { F.lctl[LC_PRE + e] = pre; F.lctl[LC_TOT + e] = tot; }
    }
    __syncthreads();
    if (F.tid == 0) { unsigned tb = 0; for (int e = 0; e < NE; ++e) { F.lctl[LC_TB + e] = tb; tb += (F.lctl[LC_TOT + e] + 255u) >> 8; }
        F.lctl[LC_TB + 8] = tb; F.lctl[LC_NMT] = tb; }
    __syncthreads();
    if (F.tid < MAXMT) { unsigned e = 0;
#pragma unroll
        for (int k = 1; k < NE; ++k) e += ((unsigned)F.tid >= F.lctl[LC_TB + k]) ? 1u : 0u;
        F.lctl[LC_TEXP + F.tid] = e; }
    __syncthreads();
}

__device__ __forceinline__ void slot_tables(const Ctx& F) {
    const int gw = F.vcu * 8 + F.wave, NGW = F.G * 8;
    const unsigned* TOPE = (const unsigned*)(F.ws + WS_ROUTE + RT_TOPE); const unsigned* TOPR = (const unsigned*)(F.ws + WS_ROUTE + RT_TOPR); unsigned* SLOT = (unsigned*)(F.ws + WS_ROUTE + RT_SLOT);
    unsigned* ROWOF = (unsigned*)(F.ws + WS_ROUTE + RT_ROWOF);
    for (int m0 = gw; m0 < T; m0 += 32 * NGW) {
        const int m = m0 + (F.lane >> 1) * NGW, k = F.lane & 1;
        if (m < T) { const unsigned e = (TOPE[m] >> (8 * k)) & 0xffu; const unsigned slot = F.lctl[LC_TB + e] * 256u + F.lctl[LC_PRE + e] + TOPR[2 * m + k];
            SLOT[2 * m + k] = slot; ROWOF[slot] = (unsigned)m; }
    }
    if (F.vcu == 0) {
        for (int e = 0; e < NE; ++e) { const unsigned lo = F.lctl[LC_TB + e] * 256u + F.lctl[LC_TOT + e], hi = F.lctl[LC_TB + e + 1] * 256u;
            for (unsigned i = lo + F.tid; i < hi; i += 512) ROWOF[i] = 0u; }
    }
}

__device__ __forceinline__ f32x4 fp8x4(unsigned w) {
    typedef float f2_ __attribute__((ext_vector_type(2)));
    const f2_ lo = __builtin_amdgcn_cvt_pk_f32_fp8((int)w, false), hi = __builtin_amdgcn_cvt_pk_f32_fp8((int)w, true);
    return (f32x4){lo[0], lo[1], hi[0], hi[1]};
}
__device__ __forceinline__ void final_phase(const Ctx& F, const float* gain) {
    const int gw = F.vcu * 8 + F.wave, NGW = F.G * 8;
    const float* TOPG = (const float*)(F.ws + WS_ROUTE + RT_TOPG); const unsigned* SLOT = (const unsigned*)(F.ws + WS_ROUTE + RT_SLOT);
    const unsigned char* OS = F.ws + WS_PROJ; const unsigned char* OS2 = F.ws + WS_H;
    LAS unsigned char* SPL = (LAS unsigned char*)(F.lctl + LC_SPLIT);
    { pg8::SplitOrder S; S.init((int)F.lctl[LC_NMT], D / 256, F.G, 0, nullptr); S.init2();
      for (int i = F.tid; i < MAXMT * 8; i += 512) SPL[i] = 0xffu;
      __syncthreads();
      if (F.tid < S.rem) { pg8::Unit u; if (S.unit_at((long)S.R * S.G + F.tid, u)) SPL[u.pm * 8 + u.pn] = (unsigned char)F.tid; }
      __syncthreads(); }
    f32x4 gv[8];
#pragma unroll
    for (int j = 0; j < 8; ++j) gv[j] = ((const f32x4*)gain)[F.lane + 64 * j];
    float g1 = 0.f, g2 = 0.f, ng1 = 0.f, ng2 = 0.f; unsigned s1 = 0, s2 = 0, ns1 = 0, ns2 = 0;
    const bf16* XR = (const bf16*)(F.ws + WS_XR);
    u32x2 xv[8]; unsigned av[8], bv[8];
    if (gw < T) { g1 = TOPG[2 * gw]; g2 = TOPG[2 * gw + 1]; s1 = SLOT[2 * gw]; s2 = SLOT[2 * gw + 1];
        const u32x2* xr0 = (const u32x2*)(XR + (size_t)gw * D) + F.lane; const unsigned* o1 = (const unsigned*)(OS + (size_t)s1 * D) + F.lane; const unsigned* o2 = (const unsigned*)(OS + (size_t)s2 * D) + F.lane;
#pragma unroll
        for (int j = 0; j < 8; ++j) { xv[j] = xr0[64 * j]; av[j] = o1[64 * j]; bv[j] = o2[64 * j]; } }
    if (gw + NGW < T) { const int mn = gw + NGW; ng1 = TOPG[2 * mn]; ng2 = TOPG[2 * mn + 1]; ns1 = SLOT[2 * mn]; ns2 = SLOT[2 * mn + 1]; }
    for (int m = gw; m < T; m += NGW) {
        f32x4* xr = (f32x4*)(F.out + (size_t)m * D) + F.lane;
        u32x2 xn[8]; unsigned an[8], bn[8]; float fg1 = 0.f, fg2 = 0.f; unsigned fs1 = 0, fs2 = 0;
        if (m + NGW < T) { const u32x2* xrn = (const u32x2*)(XR + (size_t)(m + NGW) * D) + F.lane; const unsigned* o1 = (const unsigned*)(OS + (size_t)ns1 * D) + F.lane; const unsigned* o2 = (const unsigned*)(OS + (size_t)ns2 * D) + F.lane;
#pragma unroll
            for (int j = 0; j < 8; ++j) { xn[j] = xrn[64 * j]; an[j] = o1[64 * j]; bn[j] = o2[64 * j]; } }
        else {
#pragma unroll
            for (int j = 0; j < 8; ++j) { xn[j] = xv[j]; an[j] = av[j]; bn[j] = bv[j]; } }
        if (m + 2 * NGW < T) { const int mf = m + 2 * NGW; fg1 = TOPG[2 * mf]; fg2 = TOPG[2 * mf + 1]; fs1 = SLOT[2 * mf]; fs2 = SLOT[2 * mf + 1]; }
        f32x4 v[8]; float ss = 0.f;
        const float h1 = g1 * 0.0625f, h2 = g2 * 0.0625f;
#pragma unroll
        for (int j = 0; j < 8; ++j) { v[j] = (f32x4){bflo(xv[j].x), bfhi(xv[j].x), bflo(xv[j].y), bfhi(xv[j].y)};
            f32x4 va = fp8x4(av[j]), vb = fp8x4(bv[j]);
            const unsigned q1 = SPL[(s1 >> 8) * 8 + j], q2 = SPL[(s2 >> 8) * 8 + j];
            if (q1 != 0xffu) va += fp8x4(((const unsigned*)(OS2 + ((size_t)q1 * 256 + (s1 & 255u)) * 256))[F.lane]);
            if (q2 != 0xffu) vb += fp8x4(((const unsigned*)(OS2 + ((size_t)q2 * 256 + (s2 & 255u)) * 256))[F.lane]);
            v[j] += h1 * va + h2 * vb;
            ss += (v[j].x * v[j].x + v[j].y * v[j].y) + (v[j].z * v[j].z + v[j].w * v[j].w); }
        ss = wave_sum(ss, F.lane);
        const float rstd = 1.0f / sqrtf(ss * (1.0f / D) + EPS);
#pragma unroll
        for (int j = 0; j < 8; ++j) xr[64 * j] = v[j] * rstd * gv[j];
#pragma unroll
        for (int j = 0; j < 8; ++j) { xv[j] = xn[j]; av[j] = an[j]; bv[j] = bn[j]; }
        g1 = ng1; g2 = ng2; s1 = ns1; s2 = ns2; ng1 = fg1; ng2 = fg2; ns1 = fs1; ns2 = fs2;
    }
}

__device__ __forceinline__ void lru_unit(const Ctx& F, int l, int b, int n, int hf, const float* const* in) {
    asm volatile("" : "+s"(l), "+s"(b), "+s"(n), "+s"(hf));
    const int tid = F.tid, wave = F.wave, lane = F.lane, fr = lane & 15, fq = lane >> 4, nt = wave & 3, mh = wave >> 2;
    LAS unsigned char* XC = F.lds; LAS float* EX = (LAS float*)(F.lds + 32768);
    LAS float* HS = EX + 256;
    static_assert(32768 + (256 + 128 * 68) * 4 <= LDSCTL_OFF, "RG-LRU LDS map");
    const bf16* PROJ = (const bf16*)(F.ws + WS_PROJ); bf16* Y = (bf16*)(F.ws + WS_H); float* SSP = (float*)(F.ws + WS_SSP);
    const bf16* WL = (const bf16*)(F.ws + WS_WLRU) + (size_t)l * 2 * 8 * 16384;
    const int os_g = tid & 7, os_tok = tid >> 3;
    float gn[8]; { const f32x4 a = *(const f32x4*)(inp(10) + (size_t)l * D_RNN + n * 128 + hf * 64 + 8 * os_g), c = *(const f32x4*)(inp(10) + (size_t)l * D_RNN + n * 128 + hf * 64 + 8 * os_g + 4);
        gn[0] = a.x; gn[1] = a.y; gn[2] = a.z; gn[3] = a.w; gn[4] = c.x; gn[5] = c.y; gn[6] = c.z; gn[7] = c.w; }
    const int cg = tid & 15, tl = tid >> 4, cch = n * 128 + cg * 8;
    const int prow0 = ((tl >> 4) << 6) | ((tl & 3) << 4) | (((tl >> 2) & 3) << 2);
    float cw[4][8], cb[8];
#pragma unroll
    for (int tap = 0; tap < 4; ++tap) { const f32x4 a = *(const f32x4*)(inp(3) + (size_t)(l * 4 + tap) * D_RNN + cch), c = *(const f32x4*)(inp(3) + (size_t)(l * 4 + tap) * D_RNN + cch + 4);
        cw[tap][0] = a.x; cw[tap][1] = a.y; cw[tap][2] = a.z; cw[tap][3] = a.w; cw[tap][4] = c.x; cw[tap][5] = c.y; cw[tap][6] = c.z; cw[tap][7] = c.w; }
    { const f32x4 a = *(const f32x4*)(inp(4) + (size_t)l * D_RNN + cch), c = *(const f32x4*)(inp(4) + (size_t)l * D_RNN + cch + 4);
        cb[0] = a.x; cb[1] = a.y; cb[2] = a.z; cb[3] = a.w; cb[4] = c.x; cb[5] = c.y; cb[6] = c.z; cb[7] = c.w; }
    const int lc = hf * 64 + nt * 16 + fr, gc = n * 128 + lc;
    const float ba_c = inp(6)[l * D_RNN + gc], bx_c = inp(8)[l * D_RNN + gc];
    const float sp8 = 8.0f * log1pf(expf(-inp(9)[l * D_RNN + gc]));
    bf16x8 Wa[4], Wx[4];
#pragma unroll
    for (int ks = 0; ks < 4; ++ks) { Wa[ks] = *(const bf16x8*)(WL + (size_t)((0 * 8 + n) * 128 + lc) * 128 + 32 * ks + 8 * fq);
                                     Wx[ks] = *(const bf16x8*)(WL + (size_t)((1 * 8 + n) * 128 + lc) * 128 + 32 * ks + 8 * fq); }
    float Hc = 0.f;
    u32x4 xr[7];
#pragma unroll
    for (int r = 0; r < 7; ++r) { const int t = 4 * tl - 3 + r; xr[r] = (u32x4){0u, 0u, 0u, 0u}; if (t >= 0) xr[r] = *(const u32x4*)(PROJ + (size_t)(b * SEQ + t) * D_IN + cch); }
    for (int ck = 0; ck < SEQ / 128; ++ck) {
        const int t0 = ck * 128;
        {
            float xv[7][8];
#pragma unroll
            for (int r = 0; r < 7; ++r) { const u32x4 w = xr[r];
                xv[r][0] = bflo(w.x); xv[r][1] = bfhi(w.x); xv[r][2] = bflo(w.y); xv[r][3] = bfhi(w.y); xv[r][4] = bflo(w.z); xv[r][5] = bfhi(w.z); xv[r][6] = bflo(w.w); xv[r][7] = bfhi(w.w); }
#pragma unroll
            for (int q = 0; q < 4; ++q) { float y[8];
#pragma unroll
                for (int c = 0; c < 8; ++c) { float a = cb[c];
#pragma unroll
                    for (int tap = 0; tap < 4; ++tap) a += cw[tap][c] * xv[q + tap][c];
                    y[c] = a; }
                *(LAS u32x4*)(XC + tile_off(prow0 + q, 8 * cg, 4)) = (u32x4){pk2(y[0], y[1]), pk2(y[2], y[3]), pk2(y[4], y[5]), pk2(y[6], y[7])}; }
        }
        __syncthreads();
        if (ck + 1 < SEQ / 128) {
#pragma unroll
            for (int r = 0; r < 7; ++r) xr[r] = *(const u32x4*)(PROJ + (size_t)(b * SEQ + t0 + 128 + 4 * tl - 3 + r) * D_IN + cch);
        }
        u32x4 gpre[2];
#pragma unroll
        for (int j = 0; j < 2; ++j) gpre[j] = *(const u32x4*)(PROJ + (size_t)(b * SEQ + t0 + os_tok + 64 * j) * D_IN + OFF_GATE + n * 128 + hf * 64 + 8 * os_g);
        float av[16], bv[16];
#pragma unroll
        for (int mi = 0; mi < 4; ++mi) {
            const int mt = 4 * mh + mi;
            f32x4 aa = (f32x4){0.f, 0.f, 0.f, 0.f}, ax = (f32x4){0.f, 0.f, 0.f, 0.f};
#pragma unroll
            for (int ks = 0; ks < 4; ++ks) { const bf16x8 xf = lds_frag(XC, tile_off(16 * mt + fr, 32 * ks + 8 * fq, 4)); aa = MFMA16(xf, Wa[ks], aa); ax = MFMA16(xf, Wx[ks], ax); }
#pragma unroll
            for (int i = 0; i < 4; ++i) { const int tok = 64 * mh + 16 * fq + 4 * mi + i;
                const float r = sigmoidf_(aa[i] + ba_c), ig = sigmoidf_(ax[i] + bx_c);
                const float a = __expf(-sp8 * r); float mult = sqrtf(fmaxf(1.0f - a * a, 0.f));
                if (ck == 0 && tok == 0) mult = 1.0f;
                const float xcv = __builtin_bit_cast(float, (unsigned)(*(const LAS unsigned short*)(XC + tile_off(16 * mt + 4 * fq + i, lc, 4))) << 16);
                av[4 * mi + i] = a; bv[4 * mi + i] = mult * ig * xcv; }
        }
        float P = av[0], Q = bv[0];
#pragma unroll
        for (int k = 1; k < 16; ++k) { P *= av[k]; Q = Q * av[k] + bv[k]; }
        { const float P1 = shfl_idx(P, lane - 16), Q1 = shfl_idx(Q, lane - 16); if (fq >= 1) { Q = P * Q1 + Q; P = P * P1; } }
        { const float P2 = shfl_idx(P, lane - 32), Q2 = shfl_idx(Q, lane - 32); if (fq >= 2) { Q = P * Q2 + Q; P = P * P2; } }
        float Pex = shfl_idx(P, lane - 16), Qex = shfl_idx(Q, lane - 16); if (fq == 0) { Pex = 1.0f; Qex = 0.f; }
        const float Pc = shfl_idx(P, fr + 48), Qc = shfl_idx(Q, fr + 48);
        if (fq == 0) { EX[((mh * 4 + nt) * 16 + fr) * 2] = Pc; EX[((mh * 4 + nt) * 16 + fr) * 2 + 1] = Qc; }
        __syncthreads();
        const float P0 = EX[((0 * 4 + nt) * 16 + fr) * 2], Q0 = EX[((0 * 4 + nt) * 16 + fr) * 2 + 1], P1h = EX[((1 * 4 + nt) * 16 + fr) * 2], Q1h = EX[((1 * 4 + nt) * 16 + fr) * 2 + 1];
        const float Hmid = P0 * Hc + Q0;
        const float Hw = (mh == 0) ? Hc : Hmid;
        Hc = P1h * Hmid + Q1h;
        {
            float h = Pex * Hw + Qex;
#pragma unroll
            for (int k = 0; k < 16; ++k) { h = av[k] * h + bv[k]; HS[(64 * mh + 16 * fq + k) * 68 + nt * 16 + fr] = h; }
        }
        __syncthreads();
#pragma unroll
        for (int j = 0; j < 2; ++j) { const int tk = os_tok + 64 * j; const size_t row = (size_t)(b * SEQ + t0 + tk);
            const u32x4 gw = gpre[j];
            const f32x4 h0 = *(const LAS f32x4*)(HS + tk * 68 + 8 * os_g), h1 = *(const LAS f32x4*)(HS + tk * 68 + 8 * os_g + 4);
            const float hh[8] = {h0.x, h0.y, h0.z, h0.w, h1.x, h1.y, h1.z, h1.w};
            {
                float ss = ((hh[0] * hh[0] + hh[1] * hh[1]) + (hh[2] * hh[2] + hh[3] * hh[3])) + ((hh[4] * hh[4] + hh[5] * hh[5]) + (hh[6] * hh[6] + hh[7] * hh[7]));
                ss += shfl_x(ss, 1, lane); ss += shfl_x(ss, 2, lane); ss += shfl_x(ss, 4, lane);
                if (os_g == 0) SSP[row * 16 + (n * 2 + hf)] = ss; }
            const float g[8] = {bflo(gw.x), bfhi(gw.x), bflo(gw.y), bfhi(gw.y), bflo(gw.z), bfhi(gw.z), bflo(gw.w), bfhi(gw.w)}; float y[8];
#pragma unroll
            for (int r = 0; r < 8; ++r) { const float x = g[r]; y[r] = hh[r] * gn[r] * (x * sigmoidf_(1.5957691216f * (x + 0.044715f * x * x * x))); }
            *(u32x4*)(Y + row * D + n * 128 + hf * 64 + 8 * os_g) = (u32x4){pk2(y[0], y[1]), pk2(y[2], y[3]), pk2(y[4], y[5]), pk2(y[6], y[7])}; }
    }
    __syncthreads();
}

typedef short s16x4 __attribute__((ext_vector_type(4)));
__device__ __forceinline__ bf16x8 tr_frag(LAS unsigned char* base, int stride, int krow0, int col0, int lane) {
    const int g = lane >> 4, i = lane & 15, q = i >> 2, p = i & 3;
    const s16x4 lo = __builtin_amdgcn_ds_read_tr16_b64_v4i16((LAS s16x4*)(base + (krow0 + 8 * g + q) * stride + (col0 + 4 * p) * 2));
    const s16x4 hi = __builtin_amdgcn_ds_read_tr16_b64_v4i16((LAS s16x4*)(base + (krow0 + 8 * g + 4 + q) * stride + (col0 + 4 * p) * 2));
    return __builtin_shufflevector(lo, hi, 0, 1, 2, 3, 4, 5, 6, 7);
}
constexpr int SKZ = 144, SVS = 288;
__device__ __forceinline__ void ret_unit(const Ctx& F, int l, int b, int h, int c0, int c1, const float* const* in) {
    asm volatile("" : "+s"(l), "+s"(b), "+s"(h), "+s"(c0), "+s"(c1));
    const int tid = F.tid, wave = F.wave, lane = F.lane, fr = lane & 15, fq = lane >> 4;
    LAS unsigned char* Qs = F.lds; LAS unsigned char* Ks = F.lds + 16384; LAS unsigned char* Kz = F.lds + 32768; LAS unsigned char* Vs = Kz + 128 * SKZ;
    LAS unsigned char* Ps = Vs + 128 * SVS; LAS unsigned char* STs = Ps + 32768;
    static_assert(32768 + 128 * SKZ + 128 * SVS + 32768 + 16384 <= LDSCTL_OFF, "retention LDS map");
    const bf16* PROJ = (const bf16*)(F.ws + WS_PROJ); bf16* Y = (bf16*)(F.ws + WS_H); const f32x2* ROPE = (const f32x2*)(F.ws + WS_ROPE);
    const float* rg = inp(11) + (size_t)l * 1024 + h * 128;
    const float lgm = log2f(1.0f - exp2f(-5.0f - (float)h));
    const float cdec = exp2f(128.0f * lgm);
    const int tok = tid >> 2, seg = tid & 3;
    const float zeta = exp2f((float)(127 - tok) * lgm);
    f32x4 accS[4];
#pragma unroll
    for (int dt = 0; dt < 4; ++dt) accS[dt] = (f32x4){0.f, 0.f, 0.f, 0.f};
    f32x4 pr_cs[4]; u32x4 pr_k[2], pr_v[4], pr_q[2];
#define RET_LOAD(ckk, want_q) do { const size_t ro_ = (size_t)(b * SEQ + (ckk) * 128 + tok) * D_IN; const f32x4* cs_ = (const f32x4*)(ROPE + (size_t)((ckk) * 128 + tok) * 32 + 8 * seg); \
        _Pragma("unroll") for (int i_ = 0; i_ < 4; ++i_) pr_cs[i_] = cs_[i_]; \
        pr_k[0] = *(const u32x4*)(PROJ + ro_ + OFF_K + h * 64 + 8 * seg); pr_k[1] = *(const u32x4*)(PROJ + ro_ + OFF_K + h * 64 + 32 + 8 * seg); \
        _Pragma("unroll") for (int q_ = 0; q_ < 4; ++q_) pr_v[q_] = *(const u32x4*)(PROJ + ro_ + OFF_V + h * 128 + 32 * seg + 8 * q_); \
        if (want_q) { pr_q[0] = *(const u32x4*)(PROJ + ro_ + OFF_Q + h * 64 + 8 * seg); pr_q[1] = *(const u32x4*)(PROJ + ro_ + OFF_Q + h * 64 + 32 + 8 * seg); } } while (0)
    pr_q[0] = pr_q[1] = (u32x4){0u, 0u, 0u, 0u};
    RET_LOAD(0, c0 == 0);
    for (int ck = 0; ck < c1; ++ck) {
        const int t0 = ck * 128; const bool full = ck >= c0;
        if (full) {
#pragma unroll
            for (int dt = 0; dt < 4; ++dt) *(LAS u32x2*)(STs + tile_off(16 * wave + fr, 16 * dt + 4 * fq, 2)) = (u32x2){pk2(accS[dt][0], accS[dt][1]), pk2(accS[dt][2], accS[dt][3])};
        }
        {
            float c[8], s[8];
#pragma unroll
            for (int i = 0; i < 4; ++i) { const f32x4 v = pr_cs[i]; c[2 * i] = v.x; s[2 * i] = v.y; c[2 * i + 1] = v.z; s[2 * i + 1] = v.w; }
            if (full) {
                const u32x4 w1 = pr_q[0], w2 = pr_q[1];
                const float x1[8] = {bflo(w1.x), bfhi(w1.x), bflo(w1.y), bfhi(w1.y), bflo(w1.z), bfhi(w1.z), bflo(w1.w), bfhi(w1.w)};
                const float x2[8] = {bflo(w2.x), bfhi(w2.x), bflo(w2.y), bfhi(w2.y), bflo(w2.z), bfhi(w2.z), bflo(w2.w), bfhi(w2.w)};
                float r1[8], r2[8];
#pragma unroll
                for (int i = 0; i < 8; ++i) { r1[i] = x1[i] * c[i] - x2[i] * s[i]; r2[i] = x1[i] * s[i] + x2[i] * c[i]; }
                *(LAS u32x4*)(Qs + tile_off(tok, 8 * seg, 2)) = (u32x4){pk2(r1[0], r1[1]), pk2(r1[2], r1[3]), pk2(r1[4], r1[5]), pk2(r1[6], r1[7])};
                *(LAS u32x4*)(Qs + tile_off(tok, 32 + 8 * seg, 2)) = (u32x4){pk2(r2[0], r2[1]), pk2(r2[2], r2[3]), pk2(r2[4], r2[5]), pk2(r2[6], r2[7])};
            }
            {
                const u32x4 w1 = pr_k[0], w2 = pr_k[1];
                const float x1[8] = {bflo(w1.x), bfhi(w1.x), bflo(w1.y), bfhi(w1.y), bflo(w1.z), bfhi(w1.z), bflo(w1.w), bfhi(w1.w)};
                const float x2[8] = {bflo(w2.x), bfhi(w2.x), bflo(w2.y), bfhi(w2.y), bflo(w2.z), bfhi(w2.z), bflo(w2.w), bfhi(w2.w)};
                float r1[8], r2[8];
#pragma unroll
                for (int i = 0; i < 8; ++i) { r1[i] = (x1[i] * c[i] - x2[i] * s[i]) * 0.125f; r2[i] = (x1[i] * s[i] + x2[i] * c[i]) * 0.125f; }
                if (full) {
                    *(LAS u32x4*)(Ks + tile_off(tok, 8 * seg, 2)) = (u32x4){pk2(r1[0], r1[1]), pk2(r1[2], r1[3]), pk2(r1[4], r1[5]), pk2(r1[6], r1[7])};
                    *(LAS u32x4*)(Ks + tile_off(tok, 32 + 8 * seg, 2)) = (u32x4){pk2(r2[0], r2[1]), pk2(r2[2], r2[3]), pk2(r2[4], r2[5]), pk2(r2[6], r2[7])};
                }
#pragma unroll
                for (int i = 0; i < 8; ++i) { r1[i] *= zeta; r2[i] *= zeta; }
                *(LAS u32x4*)(Kz + tok * SKZ + 16 * seg) = (u32x4){pk2(r1[0], r1[1]), pk2(r1[2], r1[3]), pk2(r1[4], r1[5]), pk2(r1[6], r1[7])};
                *(LAS u32x4*)(Kz + tok * SKZ + 64 + 16 * seg) = (u32x4){pk2(r2[0], r2[1]), pk2(r2[2], r2[3]), pk2(r2[4], r2[5]), pk2(r2[6], r2[7])};
            }
#pragma unroll
            for (int q = 0; q < 4; ++q) *(LAS u32x4*)(Vs + tok * SVS + 64 * seg + 16 * q) = pr_v[q];
        }
        __syncthreads();
        if (ck + 1 < c1) RET_LOAD(ck + 1, ck + 1 >= c0);
        if (full) {
            bf16x8 qf[2];
#pragma unroll
            for (int ks = 0; ks < 2; ++ks) qf[ks] = lds_frag(Qs, tile_off(16 * wave + fr, 32 * ks + 8 * fq, 2));
            int irow = 16 * wave + fr; float lgv = lgm; asm volatile("" : "+v"(irow), "+v"(lgv));
#pragma unroll
            for (int jt = 0; jt < 8; ++jt) {
                u32x2 pw = (u32x2){0u, 0u};
                if (jt <= wave) {
                    f32x4 sc = (f32x4){0.f, 0.f, 0.f, 0.f};
#pragma unroll
                    for (int ks = 0; ks < 2; ++ks) sc = MFMA16(lds_frag(Ks, tile_off(16 * jt + fr, 32 * ks + 8 * fq, 2)), qf[ks], sc);
                    float p[4];
#pragma unroll
                    for (int r = 0; r < 4; ++r) { const int dij = irow - (16 * jt + 4 * fq + r); p[r] = (dij >= 0) ? sc[r] * __builtin_amdgcn_exp2f((float)dij * lgv) : 0.f; }
                    pw = (u32x2){pk2(p[0], p[1]), pk2(p[2], p[3])};
                }
                *(LAS u32x2*)(Ps + tile_off(irow, 16 * jt + 4 * fq, 4)) = pw;
            }
            __syncthreads();
            bf16x8 pf[4];
#pragma unroll
            for (int ks = 0; ks < 4; ++ks) pf[ks] = lds_frag(Ps, tile_off(16 * wave + fr, 32 * ks + 8 * fq, 4));
            const float xi = __builtin_amdgcn_exp2f((float)(irow + 1) * lgv);
            float o[8][4]; float sum = 0.f;
#pragma unroll
            for (int et = 0; et < 8; ++et) {
                f32x4 ao = (f32x4){0.f, 0.f, 0.f, 0.f}, ac = (f32x4){0.f, 0.f, 0.f, 0.f};
#pragma unroll
                for (int ks = 0; ks < 4; ++ks) if (32 * ks <= 16 * wave + 15) ao = MFMA16(tr_frag(Vs, SVS, 32 * ks, 16 * et, lane), pf[ks], ao);
#pragma unroll
                for (int ks = 0; ks < 2; ++ks) ac = MFMA16(lds_frag(STs, tile_off(16 * et + fr, 32 * ks + 8 * fq, 2)), qf[ks], ac);
#pragma unroll
                for (int r = 0; r < 4; ++r) { o[et][r] = ao[r] + xi * ac[r]; sum += o[et][r]; }
            }
            sum += shfl_x(sum, 16, lane); sum += shfl_x(sum, 32, lane);
            const float mean = sum * (1.0f / 128.0f); float var = 0.f;
#pragma unroll
            for (int et = 0; et < 8; ++et)
#pragma unroll
                for (int r = 0; r < 4; ++r) { const float d = o[et][r] - mean; var += d * d; }
            var += shfl_x(var, 16, lane); var += shfl_x(var, 32, lane);
            const float rstd = 1.0f / sqrtf(var * (1.0f / 128.0f) + EPS);
            {
                const size_t rowo = (size_t)(b * SEQ + t0 + irow);
#pragma unroll
                for (int et = 0; et < 8; ++et) {
                    const u32x2 gw = *(const u32x2*)(PROJ + rowo * D_IN + OFF_G + h * 128 + 16 * et + 4 * fq);
                    const f32x4 gn = *(const f32x4*)(rg + 16 * et + 4 * fq);
                    const float g[4] = {bflo(gw.x), bfhi(gw.x), bflo(gw.y), bfhi(gw.y)};
                    float y[4];
#pragma unroll
                    for (int r = 0; r < 4; ++r) y[r] = (o[et][r] - mean) * rstd * gn[r] * (g[r] * sigmoidf_(g[r]));
                    *(u32x2*)(Y + rowo * D + 1024 + h * 128 + 16 * et + 4 * fq) = (u32x2){pk2(y[0], y[1]), pk2(y[2], y[3])};
                }
            }
        }
        {
            bf16x8 vf[4];
#pragma unroll
            for (int ks = 0; ks < 4; ++ks) vf[ks] = tr_frag(Vs, SVS, 32 * ks, 16 * wave, lane);
#pragma unroll
            for (int dt = 0; dt < 4; ++dt) { accS[dt] = accS[dt] * cdec;
#pragma unroll
                for (int ks = 0; ks < 4; ++ks) accS[dt] = MFMA16(tr_frag(Kz, SKZ, 32 * ks, 16 * dt, lane), vf[ks], accS[dt]); }
        }
        __syncthreads();
    }
#undef RET_LOAD
}

__device__ __forceinline__ void ylru_phase(const Ctx& F, int l, const float* gain) {
    const int gw = F.vcu * 8 + F.wave, NGW = F.G * 8;
    const float* HLRU = (const float*)(F.ws + WS_HID); const float* SSP = (const float*)(F.ws + WS_SSP); const bf16* PROJ = (const bf16*)(F.ws + WS_PROJ); bf16* Y = (bf16*)(F.ws + WS_H);
    f32x4 gv[4];
#pragma unroll
    for (int j = 0; j < 4; ++j) gv[j] = ((const f32x4*)(gain + (size_t)l * D_RNN))[F.lane + 64 * j];
    for (int m = gw; m < T; m += NGW) {
        float ss = 0.f;
#pragma unroll
        for (int n = 0; n < 16; ++n) ss += SSP[(size_t)n * T + m];
        const float rstd = 1.0f / sqrtf(ss * (1.0f / D_RNN) + EPS);
#pragma unroll
        for (int j = 0; j < 4; ++j) { const f32x4 hh = ((const f32x4*)(HLRU + (size_t)m * D_RNN))[F.lane + 64 * j];
            const u32x2 gw2 = ((const u32x2*)(PROJ + (size_t)m * D_IN + OFF_GATE))[F.lane + 64 * j];
            const float g[4] = {bflo(gw2.x), bfhi(gw2.x), bflo(gw2.y), bfhi(gw2.y)}; float y[4];
#pragma unroll
            for (int r = 0; r < 4; ++r) { const float x = g[r]; const float ge = x * sigmoidf_(1.5957691216f * (x + 0.044715f * x * x * x)); y[r] = hh[r] * rstd * gv[j][r] * ge; }
            ((u32x2*)(Y + (size_t)m * D))[F.lane + 64 * j] = (u32x2){pk2(y[0], y[1]), pk2(y[2], y[3])}; }
    }
}

constexpr int NPHASE = 20;
struct Args { const float* in[22]; float* out; unsigned char* ws; int ph_lo, ph_hi, li, pad; };
__global__ void __launch_bounds__(512, 2) fwd(Args args) {
    extern __shared__ __attribute__((aligned(16))) unsigned char lds_raw[];
    Ctx F;
    F.lds = (LAS unsigned char*)lds_raw; F.lctl = (LAS unsigned*)(F.lds + LDSCTL_OFF);
    F.tid = threadIdx.x; F.lane = F.tid & 63; F.wave = __builtin_amdgcn_readfirstlane(F.tid >> 6);
    F.G = gridDim.x; { const int bx = blockIdx.x; F.vcu = (F.G % 8 == 0) ? (bx % 8) * (F.G / 8) + bx / 8 : bx; }
    F.out = args.out; F.ws = args.ws;
    for (int u = F.tid; u < (LDS_BYTES - LDSCTL_OFF) / 4; u += 512) F.lctl[u] = 0u;
    __syncthreads();
    unsigned* ctl = (unsigned*)(args.ws + WS_CTL);
    XcdBarrier bar = xcd_barrier_post(ctl + CW_BAR + args.li * XCD_BAR_WORDS, (volatile LAS unsigned*)(F.lctl + LC_BAR));
    const int lo = args.ph_lo, hi = args.ph_hi;
#define IN(k) (lo <= (k) && (k) < hi)
#define SEAM(k) do { if ((k) + 1 < hi) xcd_barrier(bar); } while (0)
    bf16* Hb = (bf16*)(args.ws + WS_H); bf16* PROJ = (bf16*)(args.ws + WS_PROJ); bf16* HID = (bf16*)(args.ws + WS_HID);

    if (IN(0)) REPEAT(REP_P0) { const Ctx P = fresh(F); p0_prologue(P); norm_phase<false, true>(P, inp(0), inp(1), Hb, nullptr); SEAM(0); }

    for (int l = 0; l < 2; ++l) {
        const int pb = 1 + 9 * l;
        bf16* XR = (bf16*)(args.ws + WS_XR);
        if (IN(pb + 0) && l == 1) REPEAT(REP_NORM) { const Ctx P = fresh(F); norm_phase<false, true, true>(P, XR, inp(1) + (size_t)l * D, Hb, nullptr); SEAM(pb + 0); }
        if (IN(pb + 1)) REPEAT(REP_GIN) {
            const Ctx P = fresh(F);
            int Gv = F.G, cv = (int)blockIdx.x; bool gemm = true;
            if (l == 0) {
                const int xcd = (int)blockIdx.x % 8, idx = (int)blockIdx.x / 8, per = F.G / 8, nc = (F.G % 8 == 0 && per > GIN0_NC) ? GIN0_NC : 0;
                int cc = F.vcu, cg = F.G; bool conv = true;
                if (nc != 0) { if (idx >= per - nc) { cc = (idx - (per - nc)) * 8 + xcd; cg = nc * 8; gemm = false; } else { conv = false; Gv = (per - nc) * 8; cv = idx * 8 + xcd; } }
                if (conv) p0_convert(P, args.in, cc, cg);
            }
            if (gemm) {
                pg8::Gemm g{Hb, args.ws + WS_WIN + (size_t)l * D_IN * D, D}; pg8::ScaleOrder S; S.init(T / 256, D_IN / 256, Gv, cv, nullptr);
                S.SA = (const float*)(args.ws + WS_SA); S.SW = (const float*)(args.ws + WS_SW) + 2 * D_FF + (size_t)l * D_IN; S.cols = 0; S.st = (LAS float*)(P.lds + pg8::RS_OFF); S.tid = P.tid;
                pg8::EpiOut<true> E{nullptr, nullptr, PROJ, D_IN, 1, S.SA, S.SW, nullptr, S.st};
                pg8::gemm_phase<pg8::EpiOut<true>, pg8::ScaleOrder, true, true, 2>(P.lds, P.tid, g, S, E);
            }
            SEAM(pb + 1);
        }
        if (IN(pb + 2)) REPEAT(REP_MIX) {
            const Ctx P = fresh(F);
            for (int u = blockIdx.x; u < 128; u += F.G) REPEAT(REP_RET) { const int bh = u & 63, th = u >> 6; ret_unit(P, l, bh >> 3, bh & 7, th ? 9 : 0, th ? 16 : 9, args.in); }
            { int u0 = (int)blockIdx.x - 128; if (u0 < 0) u0 += F.G; for (int u = u0; u < 128; u += F.G) REPEAT(REP_LRU) { const int bn = u & 63; lru_unit(P, l, bn >> 3, bn & 7, u >> 6, args.in); } }
            SEAM(pb + 2);
        }
        if (IN(pb + 4)) {
            const Ctx P = fresh(F);
            pg8::Gemm g{Hb, (const bf16*)(args.ws + WS_WOUT) + (size_t)l * D * D, 2 * D}; pg8::RowScaleOrder S; S.init(T / 256, D / 256, F.G, (int)blockIdx.x, nullptr);
            S.ssp = (const float*)(args.ws + WS_SSP); S.rs = (LAS float*)(P.lds + pg8::RS_OFF); S.tid = P.tid;
            pg8::EpiOut<false> E{l == 0 ? (const void*)inp(0) : (const void*)XR, XR, nullptr, D, l == 0 ? 0 : 2, nullptr, nullptr};
            pg8::gemm_phase<pg8::EpiOut<false>, pg8::RowScaleOrder, true, true, 0, true>(P.lds, P.tid, g, S, E);
            SEAM(pb + 4);
        }
        if (IN(pb + 5)) REPEAT(REP_NORM) {
            const Ctx P = fresh(F);
            if (l == 0) { norm_phase<false, true, true>(P, XR, inp(13) + (size_t)l * D, Hb, nullptr); }
            else norm_phase<true, false, true>(P, XR, inp(13) + (size_t)l * D, Hb, inp(17));
            SEAM(pb + 5);
        }
        if (IN(pb + 6) && l == 1) REPEAT(REP_GATHER) { const Ctx P = fresh(F); moe_tables(P); slot_tables(P); SEAM(pb + 6); }
        if (IN(pb + 7)) REPEAT(REP_GGU) {
            const Ctx P = fresh(F);
            if (l == 0) {
                pg8::Gemm g{Hb, args.ws + WS_WGU_D, D}; pg8::ScaleOrder S; S.init(T / 256, 2 * D_FF / 256, F.G, (int)blockIdx.x, nullptr);
                S.SA = (const float*)(args.ws + WS_SA); S.SW = (const float*)(args.ws + WS_SW); S.cols = D_FF; S.st = (LAS float*)(P.lds + pg8::RS_OFF); S.tid = P.tid;
                pg8::EpiSwiglu<true, true> E{HID, D_FF, S.SA, S.SW, S.st};
                pg8::gemm_phase<pg8::EpiSwiglu<true, true>, pg8::ScaleOrder, true, true, 2>(P.lds, P.tid, g, S, E);
            } else {
                if (!MK_ONE_LAUNCH || lo > pb + 6) moe_tables(P);
                pg8::Gemm g{Hb, args.ws + WS_WGU_M, D, (const unsigned*)(args.ws + WS_ROUTE + RT_ROWOF)};
                pg8::GroupOrder S; S.init((int)P.lctl[LC_NMT], 2 * D_FF / 256, F.G, (int)blockIdx.x, (const LAS int*)(P.lctl + LC_TEXP));
                pg8::EpiSwiglu<true> E{HID, D_FF, nullptr, nullptr};
                pg8::gemm_phase<pg8::EpiSwiglu<true>, pg8::GroupOrder, true, true, 1, false, false, true>(P.lds, P.tid, g, S, E);
            }
            SEAM(pb + 7);
        }
        if (IN(pb + 8)) {
            const Ctx P = fresh(F);
            if (l == 0) {
                pg8::Gemm g{HID, args.ws + WS_WDN_D, D_FF}; pg8::GroupOrder S; S.init(T / 256, D / 256, F.G, (int)blockIdx.x, nullptr);
                pg8::EpiOut<false> E{XR, XR, nullptr, D, 2, nullptr, nullptr};
                pg8::gemm_phase<pg8::EpiOut<false>, pg8::GroupOrder, true, true, 1>(P.lds, P.tid, g, S, E);
            } else {
                if (!MK_ONE_LAUNCH || lo > pb + 6) moe_tables(P);
                static_assert((D_FF / 128 / 2) % 2 == 0, "half of K is a whole number of K-tile pairs");
                pg8::Gemm g{HID, args.ws + WS_WDN_M, D_FF}; pg8::SplitOrder S; S.init((int)P.lctl[LC_NMT], D / 256, F.G, (int)blockIdx.x, (const LAS int*)(P.lctl + LC_TEXP)); S.init2();
                pg8::EpiOut<false, true> E{nullptr, nullptr, PROJ, D, 1, nullptr, nullptr, (bf16*)(args.ws + WS_H)};
                pg8::gemm_phase<pg8::EpiOut<false, true>, pg8::SplitOrder, true, true, 1, false, true>(P.lds, P.tid, g, S, E);
            }
            SEAM(pb + 8);
        }
    }
    if (IN(19)) { const Ctx P = fresh(F); if (!MK_ONE_LAUNCH || lo > 16) moe_tables(P); final_phase(P, inp(21)); }
#undef IN
#undef SEAM
}

extern "C" void kernel_launch(void* const* d_in, const int* in_sizes, int n_in, void* d_out, int out_size, void* d_ws, size_t ws_size, hipStream_t stream) {
    static int grid = 0;
    if (grid == 0) {
        if (n_in != 22 || in_sizes[0] != T * D || out_size != T * D || ws_size < WS_END) { fprintf(stderr, "kernel_launch: unexpected shapes (n_in %d, in0 %d, out %d, ws %zu < %zu); nothing launched\n", n_in, n_in > 0 ? in_sizes[0] : -1, out_size, ws_size, (size_t)WS_END); grid = -1; return; }
        int dev = 0, cus = 0, per_cu = 0;
        if (hipGetDevice(&dev) != hipSuccess || hipDeviceGetAttribute(&cus, hipDeviceAttributeMultiprocessorCount, dev) != hipSuccess) { grid = -1; return; }
        if (hipFuncSetAttribute((const void*)fwd, hipFuncAttributeMaxDynamicSharedMemorySize, LDS_BYTES) != hipSuccess) { fprintf(stderr, "kernel_launch: hipFuncSetAttribute failed\n"); grid = -1; return; }
        if (hipOccupancyMaxActiveBlocksPerMultiprocessor(&per_cu, (const void*)fwd, 512, LDS_BYTES) != hipSuccess || per_cu < 1) fprintf(stderr, "kernel_launch: occupancy query reports %d\n", per_cu);
        (void)hipGetLastError();
        grid = cus < 256 ? cus : 256;
    }
    if (grid < 0) return;
    if (hipMemsetAsync((char*)d_ws + WS_CTL, 0, CTL_ZERO_BYTES, stream) != hipSuccess) return;
    Args a{};
    for (int i = 0; i < 22; ++i) a.in[i] = (const float*)d_in[i];
    a.out = (float*)d_out; a.ws = (unsigned char*)d_ws; a.pad = 0;
#if MK_ONE_LAUNCH
    a.ph_lo = 0; a.ph_hi = NPHASE; a.li = 0;
    hipLaunchKernelGGL(fwd, dim3(grid), dim3(512), LDS_BYTES, stream, a);
#else
    int li = 0;
    for (int p = 0; p < NPHASE; ++p) {
        if (p == 1 || p == 1 + 6 || p == 4 || p == 13) continue;
        a.ph_lo = p; a.ph_hi = p + 1; a.li = li++;
        hipLaunchKernelGGL(fwd, dim3(grid), dim3(512), LDS_BYTES, stream, a);
    }
#endif
}
```
